# Optimizing an MI355X kernel written in HIP

```python
import math
import jax, jax.numpy as jnp
from jax import lax
import numpy as np

D_MODEL = 1024
BATCH = 1
SEQ = 16384
DEPTH = 4

N_EVEN = (DEPTH + 1) // 2
N_ODD = DEPTH // 2
A_GROUPS = 4
A_CHUNK = 128
A_WIDTH = D_MODEL // 2
A_GROUP_CH = A_WIDTH // A_GROUPS
B_HEADS = 8
B_HEAD_DIM = 64
B_WIDTH = B_HEADS * B_HEAD_DIM
Q_BLOCK = 128
MIX_WIDTH = A_WIDTH + B_WIDTH
IN_COLS = 2 * A_WIDTH + 3 * B_WIDTH + B_HEADS
S5_GROUP_CH = 16
S5_GROUPS = D_MODEL // S5_GROUP_CH
S5_STATE = 64
D_FF = 2816
CONV_W = 3
PLE_DIM = 256
EPS = 1e-6
NEG_INF = -1e30

kernel_name = "hybrid_gmlp_fox_s5_convffn_ple"


def rms_norm(x, g=None):
    xf = x.astype(jnp.float32)
    y = xf * lax.rsqrt(jnp.mean(xf * xf, axis=-1, keepdims=True) + EPS)
    if g is not None:
        y = y * g.astype(jnp.float32)
    return y.astype(x.dtype)


def gmlp_mixer(u, v, v_gain, w_s, b_s):
    bsz, seq = u.shape[0], u.shape[1]
    u = jax.nn.gelu(u)
    v = jax.nn.gelu(v).reshape(bsz, seq, A_GROUPS, A_GROUP_CH)
    v = rms_norm(v, v_gain.reshape(A_GROUPS, A_GROUP_CH))
    v = v.reshape(bsz, seq // A_CHUNK, A_CHUNK, A_GROUPS, A_GROUP_CH)
    tri = jnp.tril(jnp.ones((A_CHUNK, A_CHUNK), dtype=bool))
    w = jnp.where(tri[None], w_s, jnp.zeros_like(w_s))
    sv = jnp.einsum('gts,bnsgc->bntgc', w, v) + b_s.T[None, None, :, :, None]
    return u * sv.reshape(bsz, seq, A_WIDTH)


def fox_attention(q, k, v, f_logit, q_gain, k_gain):
    bsz, seq = q.shape[0], q.shape[1]
    q = rms_norm(q, q_gain)
    k = rms_norm(k, k_gain)
    c = jnp.cumsum(jax.nn.log_sigmoid(f_logit.astype(jnp.float32)), axis=1)
    nb = seq // Q_BLOCK
    qb = q.reshape(bsz, nb, Q_BLOCK, B_HEADS, B_HEAD_DIM).transpose(1, 0, 2, 3, 4)
    cb = c.reshape(bsz, nb, Q_BLOCK, B_HEADS).transpose(1, 0, 2, 3)
    pos_b = jnp.arange(seq, dtype=jnp.int32).reshape(nb, Q_BLOCK)
    kpos = jnp.arange(seq, dtype=jnp.int32)
    ck = c.transpose(0, 2, 1)
    scale = B_HEAD_DIM ** -0.5

    def block(args):
        qi, ci, pi = args
        s = jnp.einsum('bqhd,bkhd->bhqk', qi, k).astype(jnp.float32) * scale
        s = s + ci.transpose(0, 2, 1)[..., None] - ck[:, :, None, :]
        s = jnp.where(kpos[None, :] <= pi[:, None], s, NEG_INF)
        pr = jax.nn.softmax(s, axis=-1)
        return jnp.einsum('bhqk,bkhd->bqhd', pr.astype(v.dtype), v)

    o = lax.map(block, (qb, cb, pos_b))
    return o.transpose(1, 0, 2, 3, 4).reshape(bsz, seq, B_WIDTH)


def _complex_affine_combine(e1, e2):
    a1r, a1i, b1r, b1i = e1
    a2r, a2i, b2r, b2i = e2
    ar = a2r * a1r - a2i * a1i
    ai = a2r * a1i + a2i * a1r
    br = a2r * b1r - a2i * b1i + b2r
    bi = a2r * b1i + a2i * b1r + b2i
    return (ar, ai, br, bi)


def s5_mixer(u, a_re, a_im, log_dt, b_re, b_im, c_re, c_im, d):
    bsz, seq, _ = u.shape
    f32 = jnp.float32
    uf = u.astype(f32).reshape(bsz, seq, S5_GROUPS, S5_GROUP_CH)
    dt = jnp.exp(log_dt.astype(f32))[:, None]
    lr, li = a_re.astype(f32), a_im.astype(f32)
    mag = jnp.exp(lr * dt)
    ab_re, ab_im = mag * jnp.cos(li * dt), mag * jnp.sin(li * dt)
    den = lr * lr + li * li
    nr, ni = ab_re - 1.0, ab_im
    cr = (nr * lr + ni * li) / den
    ci = (ni * lr - nr * li) / den
    br, bi = b_re.astype(f32), b_im.astype(f32)
    bb_re = cr[..., None] * br - ci[..., None] * bi
    bb_im = cr[..., None] * bi + ci[..., None] * br
    bu_re = jnp.einsum('gpc,bsgc->bsgp', bb_re, uf)
    bu_im = jnp.einsum('gpc,bsgc->bsgp', bb_im, uf)
    a_r = jnp.broadcast_to(ab_re, bu_re.shape)
    a_i = jnp.broadcast_to(ab_im, bu_im.shape)
    _, _, xr, xi = lax.associative_scan(_complex_affine_combine, (a_r, a_i, bu_re, bu_im), axis=1)
    y = (jnp.einsum('gcp,bsgp->bsgc', c_re.astype(f32), xr)
         - jnp.einsum('gcp,bsgp->bsgc', c_im.astype(f32), xi)
         + d.astype(f32).reshape(S5_GROUPS, S5_GROUP_CH) * uf)
    return y.reshape(bsz, seq, D_MODEL).astype(u.dtype)


def conv_ffn(x, w_up, conv_w, conv_b, w_down):
    seq = x.shape[1]
    h = x @ w_up
    hp = jnp.pad(h, ((0, 0), (CONV_W - 1, 0), (0, 0)))
    hc = conv_b + conv_w[0] * hp[:, 0:seq]
    for j in range(1, CONV_W):
        hc = hc + conv_w[j] * hp[:, j:j + seq]
    g, up = jnp.split(hc, 2, axis=-1)
    return (jax.nn.silu(g) * up) @ w_down


def setup_inputs(seed: int = 0) -> dict:
    key = jax.random.key(seed)
    ks = jax.random.split(key, 32)
    f32 = jnp.float32

    def nrm(k, shape, scale):
        return scale * jax.random.normal(k, shape, f32)

    a_im_base = jnp.broadcast_to(math.pi * jnp.arange(S5_STATE, dtype=f32), (N_ODD, S5_GROUPS, S5_STATE))
    return {
        "x": nrm(ks[0], (BATCH, SEQ, D_MODEL), 1.0),
        "p": nrm(ks[1], (DEPTH, BATCH, SEQ, PLE_DIM), 1.0),
        "norm_mix": 1.0 + nrm(ks[2], (DEPTH, D_MODEL), 0.05),
        "norm_ffn": 1.0 + nrm(ks[3], (DEPTH, D_MODEL), 0.05),
        "ev_w_in": nrm(ks[4], (N_EVEN, D_MODEL, IN_COLS), D_MODEL ** -0.5),
        "ev_b_fgate": 4.0 + nrm(ks[5], (N_EVEN, B_HEADS), 0.5),
        "ev_q_norm": 1.0 + nrm(ks[6], (N_EVEN, B_HEAD_DIM), 0.05),
        "ev_k_norm": 1.0 + nrm(ks[7], (N_EVEN, B_HEAD_DIM), 0.05),
        "ev_v_norm": 1.0 + nrm(ks[8], (N_EVEN, A_WIDTH), 0.05),
        "ev_w_spatial": nrm(ks[9], (N_EVEN, A_GROUPS, A_CHUNK, A_CHUNK), A_CHUNK ** -0.5),
        "ev_b_spatial": 1.0 + nrm(ks[10], (N_EVEN, A_GROUPS, A_CHUNK), 0.1),
        "ev_w_out": nrm(ks[11], (N_EVEN, MIX_WIDTH, D_MODEL), MIX_WIDTH ** -0.5),
        "od_a_re": -0.5 + nrm(ks[12], (N_ODD, S5_GROUPS, S5_STATE), 0.01),
        "od_a_im": a_im_base + nrm(ks[13], (N_ODD, S5_GROUPS, S5_STATE), 0.01),
        "od_log_dt": jax.random.uniform(ks[14], (N_ODD, S5_GROUPS), f32, math.log(1e-3), math.log(1e-1)),
        "od_b_re": nrm(ks[15], (N_ODD, S5_GROUPS, S5_STATE, S5_GROUP_CH), (2 * S5_GROUP_CH) ** -0.5),
        "od_b_im": nrm(ks[16], (N_ODD, S5_GROUPS, S5_STATE, S5_GROUP_CH), (2 * S5_GROUP_CH) ** -0.5),
        "od_c_re": nrm(ks[17], (N_ODD, S5_GROUPS, S5_GROUP_CH, S5_STATE), S5_STATE ** -0.5),
        "od_c_im": nrm(ks[18], (N_ODD, S5_GROUPS, S5_GROUP_CH, S5_STATE), S5_STATE ** -0.5),
        "od_d": nrm(ks[19], (N_ODD, D_MODEL), 1.0),
        "od_w_glu": nrm(ks[20], (N_ODD, D_MODEL, 2 * D_MODEL), D_MODEL ** -0.5),
        "ffn_w_up": nrm(ks[21], (DEPTH, D_MODEL, 2 * D_FF), D_MODEL ** -0.5),
        "ffn_conv_w": nrm(ks[22], (DEPTH, CONV_W, 2 * D_FF), CONV_W ** -0.5),
        "ffn_conv_b": nrm(ks[23], (DEPTH, 2 * D_FF), 0.02),
        "ffn_w_down": nrm(ks[24], (DEPTH, D_FF, D_MODEL), D_FF ** -0.5),
        "ple_w_proj": nrm(ks[25], (DEPTH, PLE_DIM, D_MODEL), PLE_DIM ** -0.5),
        "ple_w_gate": nrm(ks[26], (DEPTH, D_MODEL, D_MODEL), D_MODEL ** -0.5),
    }


def reference(x, p, norm_mix, norm_ffn, ev_w_in, ev_b_fgate, ev_q_norm, ev_k_norm, ev_v_norm,
              ev_w_spatial, ev_b_spatial, ev_w_out, od_a_re, od_a_im, od_log_dt, od_b_re, od_b_im,
              od_c_re, od_c_im, od_d, od_w_glu, ffn_w_up, ffn_conv_w, ffn_conv_b, ffn_w_down,
              ple_w_proj, ple_w_gate):
    bsz, seq = x.shape[0], x.shape[1]
    splits = [A_WIDTH, 2 * A_WIDTH, 2 * A_WIDTH + B_WIDTH, 2 * A_WIDTH + 2 * B_WIDTH,
              2 * A_WIDTH + 3 * B_WIDTH]
    for i in range(DEPTH):
        h = rms_norm(x, norm_mix[i])
        if i % 2 == 0:
            e = i // 2
            z = h @ ev_w_in[e]
            u_a, v_a, q, k, v_b, f = jnp.split(z, splits, axis=-1)
            y_a = gmlp_mixer(u_a, v_a, ev_v_norm[e], ev_w_spatial[e], ev_b_spatial[e])
            shp = (bsz, seq, B_HEADS, B_HEAD_DIM)
            y_b = fox_attention(q.reshape(shp), k.reshape(shp), v_b.reshape(shp),
                                f + ev_b_fgate[e], ev_q_norm[e], ev_k_norm[e])
            x = x + jnp.concatenate([y_a, y_b], axis=-1) @ ev_w_out[e]
        else:
            o = i // 2
            y = s5_mixer(h, od_a_re[o], od_a_im[o], od_log_dt[o], od_b_re[o], od_b_im[o],
                         od_c_re[o], od_c_im[o], od_d[o])
            g_a, g_b = jnp.split(jax.nn.gelu(y) @ od_w_glu[o], 2, axis=-1)
            x = x + g_a * jax.nn.sigmoid(g_b)
        x = x + conv_ffn(rms_norm(x, norm_ffn[i]), ffn_w_up[i], ffn_conv_w[i], ffn_conv_b[i], ffn_w_down[i])
        gate = jax.nn.sigmoid(rms_norm(x) @ ple_w_gate[i])
        x = x + gate * (p[i] @ ple_w_proj[i])
    return x
```

```cpp
#include <hip/hip_runtime.h>
#include <hip/hip_cooperative_groups.h>
#include <cstdio>
#include <cstdint>
namespace cg = cooperative_groups;

#define LAS __attribute__((address_space(3)))
typedef unsigned short bf16_t;
typedef short bf16x8 __attribute__((ext_vector_type(8)));
typedef float f32x4 __attribute__((ext_vector_type(4)));
typedef unsigned u32x4 __attribute__((ext_vector_type(4)));
typedef unsigned u32x2 __attribute__((ext_vector_type(2)));

constexpr int S = 16384, D = 1024, FF = 2816, ZW = 2560;
constexpr float EPS = 1e-6f;
constexpr float LOG2E = 1.4426950408889634f;

__device__ __forceinline__ unsigned cvt_pk_bf16(float lo, float hi) { unsigned r; asm volatile("v_cvt_pk_bf16_f32 %0, %1, %2" : "=v"(r) : "v"(lo), "v"(hi)); return r; }
__device__ __forceinline__ float bf2f(unsigned b) { return __uint_as_float(b << 16); }
__device__ __forceinline__ float sigm(float z) { return __builtin_amdgcn_rcpf(1.f + __builtin_amdgcn_exp2f(-LOG2E * z)); }
__device__ __forceinline__ float gelu_t(float x) { const float z = 1.5957691216057308f * (x + 0.044715f * x * x * x); return x * sigm(z); }
__device__ __forceinline__ u32x2 pack4(f32x4 v) { u32x2 w; w.x = cvt_pk_bf16(v[0], v[1]); w.y = cvt_pk_bf16(v[2], v[3]); return w; }
__device__ __forceinline__ f32x4 unpack4(u32x2 w) { return (f32x4){bf2f(w.x & 0xffffu), bf2f(w.x >> 16), bf2f(w.y & 0xffffu), bf2f(w.y >> 16)}; }
__device__ __forceinline__ float wave_sum(float v) {
#pragma unroll
    for (int o = 1; o < 64; o <<= 1) v += __shfl_xor(v, o);
    return v;
}
__device__ __forceinline__ float wave_max(float v) {
#pragma unroll
    for (int o = 1; o < 64; o <<= 1) v = fmaxf(v, __shfl_xor(v, o));
    return v;
}

namespace pg8 {
constexpr int BM = 256, BK = 64, HALF = 128, HTB = HALF * BK * 2, STAGE_BYTES = 8 * HTB, NXCD = 8, WGM = 8;
__host__ __device__ __forceinline__ int lds_byte(int r, int c) { const int st = (r >> 4) * 2 + (c >> 5), rr = r & 15, cc = c & 31, ob = rr * 64 + cc * 2; return st * 1024 + (ob ^ (((ob >> 9) & 1) << 5)); }
__host__ __device__ __forceinline__ void stage_rc(int b, int& R, int& C) { const int st = b / 1024, sb = b % 1024, swz = sb ^ (((sb >> 9) & 1) << 5); R = (st >> 1) * 16 + swz / 64; C = (st & 1) * 32 + (swz % 64) / 2; }
struct Unit { int pm, pn; };
struct Gemm { const bf16_t* A; const bf16_t* Bt; int K, lda, arows; };

struct StaticOrder {
    int nM, nN, nwg, G, c;
    __device__ void init(int nM_, int nN_, int G_, int c_) { nM = nM_; nN = nN_; nwg = nM * nN; G = G_; c = c_; }
    __device__ bool next(int i, Unit& u) const {
        const long L = (long)i * G + c; if (L >= nwg) return false;
        int wgid = (int)L; { const int q = nwg / NXCD, r = nwg % NXCD, xcd = wgid % NXCD, off = wgid / NXCD; wgid = (xcd < r ? xcd * (q + 1) : r * (q + 1) + (xcd - r) * q) + off; }
        const int nig = WGM * nN, gid = wgid / nig, fm = gid * WGM, gsz = (nM - fm) < WGM ? (nM - fm) : WGM;
        u.pm = fm + ((wgid % nig) % gsz); u.pn = (wgid % nig) / gsz; return true;
    }
};
struct OrderS5E { int G, c; __device__ bool next(int i, Unit& u) const { const int L = i * G + c; if (L >= 128) return false; u.pm = L; u.pn = L >> 1; return true; } };
struct OrderS5Y { int G, c; __device__ bool next(int i, Unit& u) const { const int L = i * G + c; if (L >= 256) return false; const int g = L >> 2; u.pm = 2 * g + ((L >> 1) & 1); u.pn = 2 * g + (L & 1); return true; } };

template <class Epi, class Sched>
__device__ __forceinline__ void gemm_phase(LAS unsigned char* lds, const Gemm g, const Sched& S, const Epi& E) {
    int tid_ = threadIdx.x; asm volatile("" : "+v"(tid_));
    const int tid = tid_, wid = __builtin_amdgcn_readfirstlane(tid >> 6), lane = tid & 63, wr = wid >> 2, wc = wid & 3, fr = lane & 15, fq = lane >> 4;
    const int K = g.K, nt = K / BK, lda = g.lda;
    unsigned voffA[2], voffB[2];
#pragma unroll
    for (int i = 0; i < 2; ++i) { int R, C; stage_rc(tid * 16 + i * 8192, R, C); voffA[i] = (unsigned)(R * lda + C) * 2u; voffB[i] = (unsigned)(R * K + C) * 2u; }
    const size_t kstep = (size_t)(BK * 2);
    const size_t hstepA = (size_t)HALF * lda * 2, hstepB = (size_t)HALF * K * 2;
    const size_t tstepA = (size_t)g.arows * lda * 2, tstepB = 2 * hstepB;
    const unsigned ldsw = (unsigned)wid * 1024u;
    const int aoff = lds_byte(wr * 64 + fr, fq * 8), boff = lds_byte(wc * 32 + fr, fq * 8);
#define PG8_SA(b, h) (((b) * 2 + (h)) * HTB)
#define PG8_SB(b, h) ((4 + (b) * 2 + (h)) * HTB)
#define PG8_STAGE(bufoff, gbase, voff) do { _Pragma("unroll") for (int _i = 0; _i < 2; ++_i) \
        __builtin_amdgcn_global_load_lds((const unsigned*)((const char*)(gbase) + (voff)[_i]), (LAS unsigned*)(lds + (bufoff) + ldsw + _i * 8192), 16, 0, 0); } while (0)
#define PG8_LDA(dst, b, h) do { _Pragma("unroll") for (int m = 0; m < 4; ++m) _Pragma("unroll") for (int k = 0; k < 2; ++k) dst[m][k] = *(const LAS bf16x8*)(lds + PG8_SA(b, h) + aoff + m * 2048 + k * 1024); } while (0)
#define PG8_LDB(dst, b, h) do { _Pragma("unroll") for (int n = 0; n < 2; ++n) _Pragma("unroll") for (int k = 0; k < 2; ++k) dst[n][k] = *(const LAS bf16x8*)(lds + PG8_SB(b, h) + boff + n * 2048 + k * 1024); } while (0)
#define PG8_MMA(ai, bj, At, Bt) do { __builtin_amdgcn_s_setprio(1); _Pragma("unroll") for (int m = 0; m < 4; ++m) _Pragma("unroll") for (int n = 0; n < 2; ++n) _Pragma("unroll") for (int k = 0; k < 2; ++k) \
        acc[ai][bj][m][n] = __builtin_amdgcn_mfma_f32_16x16x32_bf16(Bt[n][k], At[m][k], acc[ai][bj][m][n], 0, 0, 0); __builtin_amdgcn_s_setprio(0); } while (0)
#define PG8_WAIT_V(n) asm volatile("s_waitcnt vmcnt(" #n ")" ::: "memory")
#define PG8_WAIT_L(n) asm volatile("s_waitcnt lgkmcnt(" #n ")" ::: "memory")
#define PG8_BAR __builtin_amdgcn_s_barrier()
#define PG8_SCHED __builtin_amdgcn_sched_barrier(0)
    Unit cur, nxt; int ui = 0;
    if (!S.next(0, cur)) return;
    f32x4 acc[2][2][4][2];
#pragma unroll
    for (int a = 0; a < 2; ++a)
#pragma unroll
        for (int b = 0; b < 2; ++b)
#pragma unroll
            for (int m = 0; m < 4; ++m)
#pragma unroll
                for (int n = 0; n < 2; ++n) acc[a][b][m][n] = (f32x4){0.f, 0.f, 0.f, 0.f};
    bf16x8 At[4][2], B0[2][2], B1[2][2];
    const char* cA = (const char*)g.A + (size_t)cur.pm * tstepA; const char* cB = (const char*)g.Bt + (size_t)cur.pn * tstepB;
    PG8_STAGE(PG8_SB(0, 0), cB, voffB); PG8_STAGE(PG8_SB(0, 1), cB + hstepB, voffB); PG8_STAGE(PG8_SA(0, 0), cA, voffA); PG8_STAGE(PG8_SA(0, 1), cA + hstepA, voffA);
    if (wr == 1) PG8_BAR;
    PG8_WAIT_V(2); PG8_BAR;
    PG8_STAGE(PG8_SB(1, 0), cB + kstep, voffB); PG8_STAGE(PG8_SA(1, 0), cA + kstep, voffA); PG8_STAGE(PG8_SB(1, 1), cB + hstepB + kstep, voffB);
    PG8_WAIT_V(6); PG8_BAR;
    for (;;) {
        const bool has_next = S.next(ui + 1, nxt);
        const char* nA = has_next ? (const char*)g.A + (size_t)nxt.pm * tstepA : cA; const char* nB = has_next ? (const char*)g.Bt + (size_t)nxt.pn * tstepB : cB;
        for (int t = 0; t < nt; t += 2) {
            const bool last = (t == nt - 2);
            const char* a1 = cA + (size_t)(t + 1) * kstep;
            const char* a2 = last ? nA : cA + (size_t)(t + 2) * kstep; const char* b2 = last ? nB : cB + (size_t)(t + 2) * kstep;
            const char* a3 = a2 + kstep; const char* b3 = b2 + kstep;
            PG8_LDB(B0, 0, 0); PG8_LDB(B1, 0, 1); PG8_SCHED; PG8_LDA(At, 0, 0); PG8_STAGE(PG8_SA(1, 1), a1 + hstepA, voffA);
            PG8_WAIT_V(8); PG8_WAIT_L(0); PG8_BAR; PG8_MMA(0, 0, At, B0); PG8_MMA(0, 1, At, B1); PG8_BAR; PG8_SCHED;
            PG8_LDA(At, 0, 1); PG8_STAGE(PG8_SB(0, 0), b2, voffB); PG8_STAGE(PG8_SB(0, 1), b2 + hstepB, voffB); PG8_STAGE(PG8_SA(0, 0), a2, voffA);
            PG8_WAIT_V(8); PG8_WAIT_L(0); PG8_BAR; PG8_MMA(1, 0, At, B0); PG8_MMA(1, 1, At, B1); PG8_BAR; PG8_SCHED;
            PG8_LDB(B0, 1, 0); PG8_LDB(B1, 1, 1); PG8_SCHED; PG8_LDA(At, 1, 0); PG8_STAGE(PG8_SA(0, 1), a2 + hstepA, voffA);
            PG8_WAIT_V(8); PG8_WAIT_L(0); PG8_BAR; PG8_MMA(0, 0, At, B0); PG8_MMA(0, 1, At, B1); PG8_BAR; PG8_SCHED;
            PG8_LDA(At, 1, 1); PG8_STAGE(PG8_SB(1, 0), b3, voffB); PG8_STAGE(PG8_SB(1, 1), b3 + hstepB, voffB); PG8_STAGE(PG8_SA(1, 0), a3, voffA);
            PG8_WAIT_V(8); PG8_WAIT_L(0); PG8_BAR; PG8_MMA(1, 0, At, B0); PG8_MMA(1, 1, At, B1); PG8_BAR; PG8_SCHED;
        }
        if (wr == 0) PG8_BAR;
        E(acc, cur, wr, wc, fr, fq);
        if (!has_next) break;
#pragma unroll
        for (int a = 0; a < 2; ++a)
#pragma unroll
            for (int b = 0; b < 2; ++b)
#pragma unroll
                for (int m = 0; m < 4; ++m)
#pragma unroll
                    for (int n = 0; n < 2; ++n) acc[a][b][m][n] = (f32x4){0.f, 0.f, 0.f, 0.f};
        cur = nxt; cA = nA; cB = nB; ++ui;
        if (wr == 1) PG8_BAR;
    }
    PG8_WAIT_V(0);
    PG8_BAR;
#undef PG8_SA
#undef PG8_SB
#undef PG8_STAGE
#undef PG8_LDA
#undef PG8_LDB
#undef PG8_MMA
#undef PG8_WAIT_V
#undef PG8_WAIT_L
#undef PG8_BAR
#undef PG8_SCHED
}

typedef f32x4 Acc[2][2][4][2];
struct EpiRes {
    float* X;
    __device__ __forceinline__ void operator()(const Acc& acc, const Unit& u, int wr, int wc, int fr, int fq) const {
#pragma unroll
        for (int ai = 0; ai < 2; ++ai)
#pragma unroll
            for (int m = 0; m < 4; ++m) { float* rp = X + (size_t)(u.pm * 256 + ai * 128 + wr * 64 + m * 16 + fr) * D + u.pn * 256 + wc * 32 + 4 * fq;
#pragma unroll
                for (int bj = 0; bj < 2; ++bj)
#pragma unroll
                    for (int n = 0; n < 2; ++n) { f32x4* q = (f32x4*)(rp + bj * 128 + n * 16); *q = *q + acc[ai][bj][m][n]; } }
    }
};
struct EpiStore {
    bf16_t* O; int ld; int mode;
    __device__ __forceinline__ void operator()(const Acc& acc, const Unit& u, int wr, int wc, int fr, int fq) const {
        const bool act = mode == 1 && (u.pn < 2 || u.pn == 4 || u.pn == 5);
#pragma unroll
        for (int ai = 0; ai < 2; ++ai)
#pragma unroll
            for (int m = 0; m < 4; ++m) { bf16_t* rp = O + (size_t)(u.pm * 256 + ai * 128 + wr * 64 + m * 16 + fr) * ld + u.pn * 256 + wc * 32 + 4 * fq;
#pragma unroll
                for (int bj = 0; bj < 2; ++bj)
#pragma unroll
                    for (int n = 0; n < 2; ++n) { f32x4 v = acc[ai][bj][m][n];
                        if (act) { v[0] = gelu_t(v[0]); v[1] = gelu_t(v[1]); v[2] = gelu_t(v[2]); v[3] = gelu_t(v[3]); }
                        *(u32x2*)(rp + bj * 128 + n * 16) = pack4(v); } }
    }
};
struct EpiGate {
    float* X; const bf16_t* PP;
    __device__ __forceinline__ void operator()(const Acc& acc, const Unit& u, int wr, int wc, int fr, int fq) const {
#pragma unroll
        for (int ai = 0; ai < 2; ++ai)
#pragma unroll
            for (int m = 0; m < 4; ++m) { const size_t off = (size_t)(u.pm * 256 + ai * 128 + wr * 64 + m * 16 + fr) * D + u.pn * 256 + wc * 32 + 4 * fq;
#pragma unroll
                for (int bj = 0; bj < 2; ++bj)
#pragma unroll
                    for (int n = 0; n < 2; ++n) { const f32x4 a = acc[ai][bj][m][n]; const f32x4 pp = unpack4(*(const u32x2*)(PP + off + bj * 128 + n * 16));
                        f32x4* q = (f32x4*)(X + off + bj * 128 + n * 16); f32x4 x = *q;
                        x[0] += sigm(a[0]) * pp[0]; x[1] += sigm(a[1]) * pp[1]; x[2] += sigm(a[2]) * pp[2]; x[3] += sigm(a[3]) * pp[3]; *q = x; } }
    }
};
struct EpiGlu {
    float* X;
    __device__ __forceinline__ void operator()(const Acc& acc, const Unit& u, int wr, int wc, int fr, int fq) const {
#pragma unroll
        for (int ai = 0; ai < 2; ++ai)
#pragma unroll
            for (int m = 0; m < 4; ++m) { float* rp = X + (size_t)(u.pm * 256 + ai * 128 + wr * 64 + m * 16 + fr) * D + u.pn * 128 + wc * 32 + 4 * fq;
#pragma unroll
                for (int n = 0; n < 2; ++n) { const f32x4 a = acc[ai][0][m][n], b = acc[ai][1][m][n]; f32x4* q = (f32x4*)(rp + n * 16); f32x4 x = *q;
                    x[0] += a[0] * sigm(b[0]); x[1] += a[1] * sigm(b[1]); x[2] += a[2] * sigm(b[2]); x[3] += a[3] * sigm(b[3]); *q = x; } }
    }
};
struct EpiE {
    float* Eo;
    __device__ __forceinline__ void operator()(const Acc& acc, const Unit& u, int wr, int wc, int fr, int fq) const {
#pragma unroll
        for (int ai = 0; ai < 2; ++ai)
#pragma unroll
            for (int m = 0; m < 4; ++m) { float* rp = Eo + (size_t)(u.pm * 256 + ai * 128 + wr * 64 + m * 16 + fr) * 128 + wc * 32 + 4 * fq;
#pragma unroll
                for (int n = 0; n < 2; ++n) *(f32x4*)(rp + n * 16) = acc[ai][0][m][n]; }
    }
};
struct EpiY {
    const bf16_t* AG; const float* Dv; bf16_t* Gm;
    __device__ __forceinline__ void operator()(const Acc& acc, const Unit& u, int wr, int wc, int fr, int fq) const {
        const int g = u.pm >> 1, jj = u.pn & 1; const f32x4 d4 = *(const f32x4*)(Dv + g * 16 + 4 * fq);
#pragma unroll
        for (int ai = 0; ai < 2; ++ai)
#pragma unroll
            for (int m = 0; m < 4; ++m) { const int rowA = u.pm * 256 + ai * 128 + wr * 64 + m * 16 + fr; const int nchunk = rowA - g * 512;
#pragma unroll
                for (int bj = 0; bj < 2; ++bj)
#pragma unroll
                    for (int n = 0; n < 2; ++n) { const int sp = 16 * jj + 8 * bj + 2 * wc + n; const int t = nchunk * 32 + sp;
                        const f32x4 uu = unpack4(*(const u32x2*)(AG + (size_t)rowA * 640 + sp * 16 + 4 * fq));
                        f32x4 y = acc[ai][bj][m][n] + d4 * uu; y[0] = gelu_t(y[0]); y[1] = gelu_t(y[1]); y[2] = gelu_t(y[2]); y[3] = gelu_t(y[3]);
                        *(u32x2*)(Gm + (size_t)t * D + g * 16 + 4 * fq) = pack4(y); } }
    }
};
__device__ __forceinline__ float dpp_ror1(float v) { return __int_as_float(__builtin_amdgcn_update_dpp(0, __float_as_int(v), 0x121, 0xf, 0xf, false)); }
__device__ __forceinline__ float dpp_ror2(float v) { return __int_as_float(__builtin_amdgcn_update_dpp(0, __float_as_int(v), 0x122, 0xf, 0xf, false)); }
struct EpiConv {
    bf16_t* ACT; const float* cw; const float* cb; LAS unsigned char* xl;
    __device__ __forceinline__ void operator()(const Acc& acc, const Unit& u, int wr, int wc, int fr, int fq) const {
        LAS f32x4* X4 = (LAS f32x4*)xl;
        if (fr >= 14) {
#pragma unroll
            for (int ai = 0; ai < 2; ++ai) { const int s = 2 * ai + wr;
                if (s <= 2) {
#pragma unroll
                    for (int bj = 0; bj < 2; ++bj)
#pragma unroll
                        for (int n = 0; n < 2; ++n) X4[(((((s * 2 + bj) * 2 + n) * 4 + wc) * 4 + fq) * 2) + (fr - 14)] = acc[ai][bj][3][n]; } }
        }
        asm volatile("s_waitcnt lgkmcnt(0)" ::: "memory"); __builtin_amdgcn_s_barrier(); asm volatile("" ::: "memory");
#pragma unroll
        for (int ai = 0; ai < 2; ++ai) { const int s = 2 * ai + wr;
#pragma unroll
            for (int n = 0; n < 2; ++n) {
                const int ch = 128 * u.pn + 32 * wc + 16 * n + 4 * fq;
                const f32x4 wg0 = *(const f32x4*)(cw + ch), wg1 = *(const f32x4*)(cw + 2 * FF + ch), wg2 = *(const f32x4*)(cw + 4 * FF + ch), bg = *(const f32x4*)(cb + ch);
                const f32x4 wu0 = *(const f32x4*)(cw + FF + ch), wu1 = *(const f32x4*)(cw + 3 * FF + ch), wu2 = *(const f32x4*)(cw + 5 * FF + ch), bu = *(const f32x4*)(cb + FF + ch);
                f32x4 pg = (f32x4){0.f, 0.f, 0.f, 0.f}, pu = pg;
                if (s >= 1 && fr >= 14) { pg = X4[((((((s - 1) * 2 + 0) * 2 + n) * 4 + wc) * 4 + fq) * 2) + (fr - 14)]; pu = X4[((((((s - 1) * 2 + 1) * 2 + n) * 4 + wc) * 4 + fq) * 2) + (fr - 14)]; }
#pragma unroll
                for (int m = 0; m < 4; ++m) {
                    const f32x4 cg_ = acc[ai][0][m][n], cu_ = acc[ai][1][m][n];
                    f32x4 hg, hu;
#pragma unroll
                    for (int e = 0; e < 4; ++e) {
                        const float t1g = fr == 15 ? pg[e] : cg_[e], t2g = fr >= 14 ? pg[e] : cg_[e];
                        const float t1u = fr == 15 ? pu[e] : cu_[e], t2u = fr >= 14 ? pu[e] : cu_[e];
                        const float p1g = dpp_ror1(t1g), p2g = dpp_ror2(t2g), p1u = dpp_ror1(t1u), p2u = dpp_ror2(t2u);
                        hg[e] = bg[e] + wg0[e] * p2g + wg1[e] * p1g + wg2[e] * cg_[e];
                        hu[e] = bu[e] + wu0[e] * p2u + wu1[e] * p1u + wu2[e] * cu_[e];
                    }
                    f32x4 o; o[0] = hg[0] * sigm(hg[0]) * hu[0]; o[1] = hg[1] * sigm(hg[1]) * hu[1]; o[2] = hg[2] * sigm(hg[2]) * hu[2]; o[3] = hg[3] * sigm(hg[3]) * hu[3];
                    const int rt = 128 * ai + 64 * wr + 16 * m + fr; const int gr = 254 * u.pm - 2 + rt;
                    if (rt >= 2 && gr < S) *(u32x2*)(ACT + (size_t)gr * FF + ch) = pack4(o);
                    pg = cg_; pu = cu_;
                }
            }
        }
    }
};
}

constexpr size_t MiB = 1u << 20;
constexpr size_t WS_CL = 0, WS_CG = 524288, WS_GT = 1048576;
constexpr size_t WS_WIN = 2 * MiB;
constexpr size_t WS_WOUT = WS_WIN + 2ull * 2560 * 1024 * 2;
constexpr size_t WS_WGLU = WS_WOUT + 2ull * 1024 * 1024 * 2;
constexpr size_t WS_WUP = WS_WGLU + 2ull * 2048 * 1024 * 2;
constexpr size_t WS_WDN = WS_WUP + 4ull * 5632 * 1024 * 2;
constexpr size_t WS_WGT = WS_WDN + 4ull * 1024 * 2816 * 2;
constexpr size_t WS_WPR = WS_WGT + 4ull * 1024 * 1024 * 2;
constexpr size_t WS_HNA = WS_WPR + 4ull * 1024 * 256 * 2;
constexpr size_t WS_R = WS_HNA + (2ull + 16384 + 256) * 1024 * 2;
constexpr size_t WS_END = WS_R + 144 * MiB;
constexpr size_t R_Z = 0;
constexpr size_t R_AG = 0, R_TS = 40 * MiB, R_PS = 80 * MiB, R_E = 96 * MiB, R_G = 112 * MiB;
constexpr size_t R_ACT = 0;
constexpr size_t R_PB = 0, R_PP = 8 * MiB;

#ifndef PHMASK
#define PHMASK 0xFFFFFu
#endif
constexpr int LDS_BYTES = 147456, XL_OFF = 131072;

struct Params { const float* in[27]; float* out; unsigned char* ws; };

__device__ __forceinline__ float load_row(const float* xrow, int lane, f32x4 (&v)[4]) {
    const f32x4* xr = (const f32x4*)xrow + lane; float ss = 0.f;
#pragma unroll
    for (int j = 0; j < 4; ++j) { v[j] = xr[64 * j]; ss += (v[j][0] * v[j][0] + v[j][1] * v[j][1]) + (v[j][2] * v[j][2] + v[j][3] * v[j][3]); }
    return 1.0f / sqrtf(wave_sum(ss) * (1.f / D) + EPS);
}

__device__ __forceinline__ void transpose_item(const float* W, int K, int ldw, bf16_t* WT, int n0, int drow0, int kb, LAS float* scr, int lane) {
    const int k0 = 64 * kb;
#pragma unroll 8
    for (int i = 0; i < 32; ++i) { const int kk = 2 * i + (lane >> 5); scr[kk * 33 + (lane & 31)] = W[(size_t)(k0 + kk) * ldw + n0 + (lane & 31)]; }
    asm volatile("s_waitcnt lgkmcnt(0)" ::: "memory");
    const int c = lane & 7;
#pragma unroll
    for (int j = 0; j < 4; ++j) { const int n = (lane >> 3) + 8 * j; const LAS float* s = scr + (8 * c) * 33 + n;
        u32x4 o; o.x = cvt_pk_bf16(s[0 * 33], s[1 * 33]); o.y = cvt_pk_bf16(s[2 * 33], s[3 * 33]); o.z = cvt_pk_bf16(s[4 * 33], s[5 * 33]); o.w = cvt_pk_bf16(s[6 * 33], s[7 * 33]);
        *(u32x4*)(WT + (size_t)(drow0 + n) * K + k0 + 8 * c) = o; }
    asm volatile("s_waitcnt lgkmcnt(0)" ::: "memory");
}
__device__ __forceinline__ int dest_row(int mode, int n0, int half) {
    if (mode == 1) { const int seg = n0 >> 9, r = n0 & 511; const int ds = seg == 1 ? 2 : (seg == 2 ? 1 : seg); return ds * 512 + r; }
    if (mode == 2) { const int hi = n0 >= half, np = hi ? n0 - half : n0; return (np >> 7) * 256 + hi * 128 + (np & 127); }
    return n0;
}
__device__ __forceinline__ bool transpose_mat(int& r, const float* W, int K, int ldw, int ncols, bf16_t* WT, int mode, LAS float* scr, int lane) {
    const int nblk = ncols / 32, items = (K / 64) * nblk;
    if (r >= items) { r -= items; return false; }
    const int kb = r / nblk, nb = r % nblk;
    transpose_item(W, K, ldw, WT, nb * 32, dest_row(mode, nb * 32, ncols / 2), kb, scr, lane);
    return true;
}

__global__ void __launch_bounds__(512, 2) mega(Params P) {
    extern __shared__ __attribute__((aligned(16))) unsigned char lds_raw[];
    LAS unsigned char* lds = (LAS unsigned char*)lds_raw;
    cg::grid_group grid = cg::this_grid();
    const int G = gridDim.x, bid = blockIdx.x, NGW = G * 8;
#define PHASE_IDS int tid = threadIdx.x; asm volatile("" : "+v"(tid)); const int lane = tid & 63, wid = __builtin_amdgcn_readfirstlane(tid >> 6), gw = bid * 8 + wid; (void)lane; (void)gw;
    unsigned char* ws = P.ws;
    float* X = P.out;
    float* CL = (float*)(ws + WS_CL); float* CGm = (float*)(ws + WS_CG); float* GT = (float*)(ws + WS_GT);
    bf16_t* HNA = (bf16_t*)(ws + WS_HNA); bf16_t* HN = HNA + 2 * D;
    unsigned char* R = ws + WS_R;

    if (PHMASK & (1u << 0)) { PHASE_IDS
        LAS float* scr = (LAS float*)(lds + wid * 16384);
        constexpr int I_IN = 16 * 80, I_OUT = 16 * 32, I_GLU = 16 * 64, I_UP = 16 * 176, I_DN = 44 * 32, I_GT = 16 * 32, I_PR = 4 * 32;
        constexpr int NIT = 2 * I_IN + 2 * I_OUT + 2 * I_GLU + 4 * I_UP + 4 * I_DN + 4 * I_GT + 4 * I_PR;
        for (int it = gw; it < NIT; it += NGW) {
            int r = it; bool done = false;
#pragma unroll 1
            for (int e = 0; e < 2 && !done; ++e) done = transpose_mat(r, P.in[4] + (size_t)e * 1024 * 2568, 1024, 2568, 2560, (bf16_t*)(ws + WS_WIN) + (size_t)e * 2560 * 1024, 1, scr, lane);
#pragma unroll 1
            for (int e = 0; e < 2 && !done; ++e) done = transpose_mat(r, P.in[11] + (size_t)e * 1024 * 1024, 1024, 1024, 1024, (bf16_t*)(ws + WS_WOUT) + (size_t)e * 1024 * 1024, 0, scr, lane);
#pragma unroll 1
            for (int e = 0; e < 2 && !done; ++e) done = transpose_mat(r, P.in[20] + (size_t)e * 1024 * 2048, 1024, 2048, 2048, (bf16_t*)(ws + WS_WGLU) + (size_t)e * 2048 * 1024, 2, scr, lane);
#pragma unroll 1
            for (int e = 0; e < 4 && !done; ++e) done = transpose_mat(r, P.in[21] + (size_t)e * 1024 * 5632, 1024, 5632, 5632, (bf16_t*)(ws + WS_WUP) + (size_t)e * 5632 * 1024, 2, scr, lane);
#pragma unroll 1
            for (int e = 0; e < 4 && !done; ++e) done = transpose_mat(r, P.in[24] + (size_t)e * 2816 * 1024, 2816, 1024, 1024, (bf16_t*)(ws + WS_WDN) + (size_t)e * 1024 * 2816, 0, scr, lane);
#pragma unroll 1
            for (int e = 0; e < 4 && !done; ++e) done = transpose_mat(r, P.in[26] + (size_t)e * 1024 * 1024, 1024, 1024, 1024, (bf16_t*)(ws + WS_WGT) + (size_t)e * 1024 * 1024, 0, scr, lane);
#pragma unroll 1
            for (int e = 0; e < 4 && !done; ++e) done = transpose_mat(r, P.in[25] + (size_t)e * 256 * 1024, 256, 1024, 1024, (bf16_t*)(ws + WS_WPR) + (size_t)e * 1024 * 256, 0, scr, lane);
        }
        for (int m = gw; m < S; m += NGW) { const f32x4* s = (const f32x4*)(P.in[0] + (size_t)m * D) + lane; f32x4* d = (f32x4*)(X + (size_t)m * D) + lane;
#pragma unroll
            for (int j = 0; j < 4; ++j) d[64 * j] = s[64 * j]; }
        if (bid == 0) for (int i = tid; i < 2 * D / 2; i += 512) ((unsigned*)HNA)[i] = 0u;
    }
    grid.sync();

#pragma unroll 1
    for (int L = 0; L < 4; ++L) {
        const int e = L >> 1;
        if ((L & 1) == 0) {
            if (PHMASK & (1u << 1)) { PHASE_IDS
                const float* gmix = P.in[2] + L * D; const float* Win = P.in[4] + (size_t)e * 1024 * 2568; const float* bfg = P.in[5] + e * 8;
                f32x4 wfa[16], wfb[16];
#pragma unroll
                for (int j = 0; j < 4; ++j)
#pragma unroll
                    for (int i = 0; i < 4; ++i) { const float* wp = Win + (size_t)(4 * lane + 256 * j + i) * 2568 + 2560; wfa[j * 4 + i] = *(const f32x4*)wp; wfb[j * 4 + i] = *(const f32x4*)(wp + 4); }
                float bb[8];
#pragma unroll
                for (int h = 0; h < 8; ++h) bb[h] = bfg[h];
                for (int gi = gw; gi < 2048; gi += NGW) {
                    float cum[8];
#pragma unroll
                    for (int h = 0; h < 8; ++h) cum[h] = 0.f;
#pragma unroll 1
                    for (int rr = 0; rr < 8; ++rr) {
                        const int t = 8 * gi + rr; f32x4 v[4]; const float rs = load_row(X + (size_t)t * D, lane, v);
                        f32x4 fa = (f32x4){0.f, 0.f, 0.f, 0.f}, fb = fa;
#pragma unroll
                        for (int j = 0; j < 4; ++j) { const f32x4 gg = *((const f32x4*)gmix + lane + 64 * j); v[j] = v[j] * rs * gg;
                            *((u32x2*)(HN + (size_t)t * D) + lane + 64 * j) = pack4(v[j]);
#pragma unroll
                            for (int i = 0; i < 4; ++i) { fa += wfa[j * 4 + i] * v[j][i]; fb += wfb[j * 4 + i] * v[j][i]; } }
                        float f[8] = {fa[0], fa[1], fa[2], fa[3], fb[0], fb[1], fb[2], fb[3]};
#pragma unroll
                        for (int h = 0; h < 8; ++h) { const float z = wave_sum(f[h]) + bb[h]; const float ls = z >= 0.f ? -log1pf(expf(-z)) : z - log1pf(expf(z)); cum[h] += ls * LOG2E; }
                        if (lane == 0) { *(f32x4*)(CL + (size_t)t * 8) = (f32x4){cum[0], cum[1], cum[2], cum[3]}; *(f32x4*)(CL + (size_t)t * 8 + 4) = (f32x4){cum[4], cum[5], cum[6], cum[7]}; }
                    }
                    if (lane == 0) { *(f32x4*)(GT + (size_t)gi * 8) = (f32x4){cum[0], cum[1], cum[2], cum[3]}; *(f32x4*)(GT + (size_t)gi * 8 + 4) = (f32x4){cum[4], cum[5], cum[6], cum[7]}; }
                }
            }
            grid.sync();
            if (PHMASK & (1u << 2)) { PHASE_IDS
                pg8::Gemm g{HN, (const bf16_t*)(ws + WS_WIN) + (size_t)e * 2560 * 1024, 1024, 1024, 256};
                pg8::StaticOrder so; so.init(64, 10, G, bid);
                pg8::EpiStore E{(bf16_t*)(R + R_Z), ZW, 1};
                pg8::gemm_phase(lds, g, so, E);
            }
            grid.sync();
            if (PHMASK & (1u << 3)) { PHASE_IDS
                bf16_t* Z = (bf16_t*)(R + R_Z);
                const float* gq = P.in[6] + e * 64; const float* gk = P.in[7] + e * 64;
                LAS float* red = (LAS float*)lds;
                for (int ck = bid; ck < 256; ck += G) {
                    { const int h = tid & 7, part = tid >> 3; float s = 0.f;
                      for (int gi = part; gi < 8 * ck; gi += 64) s += GT[(size_t)gi * 8 + h];
                      s += __shfl_xor(s, 8); s += __shfl_xor(s, 16); s += __shfl_xor(s, 32);
                      __syncthreads();
                      if (lane < 8) red[wid * 8 + lane] = s;
                      __syncthreads();
                      const int tok = tid >> 3; float off = 0.f;
#pragma unroll
                      for (int w = 0; w < 8; ++w) off += red[w * 8 + h];
                      const int gl = tok >> 3;
                      for (int i2 = 0; i2 < gl; ++i2) off += GT[(size_t)(8 * ck + i2) * 8 + h];
                      const int t = 64 * ck + tok; CGm[(size_t)t * 8 + h] = CL[(size_t)t * 8 + h] + off; }
#pragma unroll 1
                    for (int ps = 0; ps < 16; ++ps) {
                        const int pair = ps * 64 + (tid >> 3), sub = tid & 7; const int tok = pair >> 4, hh = (pair >> 1) & 7, isk = pair & 1;
                        bf16_t* ptr = Z + (size_t)(64 * ck + tok) * ZW + (isk ? 1536 : 512) + hh * 64 + sub * 8;
                        const u32x4 w = *(const u32x4*)ptr; float v[8];
                        v[0] = bf2f(w.x & 0xffffu); v[1] = bf2f(w.x >> 16); v[2] = bf2f(w.y & 0xffffu); v[3] = bf2f(w.y >> 16); v[4] = bf2f(w.z & 0xffffu); v[5] = bf2f(w.z >> 16); v[6] = bf2f(w.w & 0xffffu); v[7] = bf2f(w.w >> 16);
                        float ss = 0.f;
#pragma unroll
                        for (int i = 0; i < 8; ++i) ss += v[i] * v[i];
                        ss += __shfl_xor(ss, 1); ss += __shfl_xor(ss, 2); ss += __shfl_xor(ss, 4);
                        const float rs = (1.0f / sqrtf(ss * (1.f / 64.f) + EPS)) * (isk ? 1.f : 0.125f * LOG2E);
                        const float* gp = (isk ? gk : gq) + sub * 8;
#pragma unroll
                        for (int i = 0; i < 8; ++i) v[i] = v[i] * rs * gp[i];
                        u32x4 o; o.x = cvt_pk_bf16(v[0], v[1]); o.y = cvt_pk_bf16(v[2], v[3]); o.z = cvt_pk_bf16(v[4], v[5]); o.w = cvt_pk_bf16(v[6], v[7]);
                        *(u32x4*)ptr = o;
                    }
                }
                LAS bf16_t* Wsm = (LAS bf16_t*)lds; LAS bf16_t* VT = (LAS bf16_t*)(lds + 34816);
                const float* wsp = P.in[9] + (size_t)e * 4 * 128 * 128; const float* bsp = P.in[10] + e * 512; const float* vg = P.in[8] + e * 512;
                for (int it = bid; it < 512; it += G) {
                    const int n = it >> 2, g = it & 3;
                    __syncthreads();
                    for (int idx = tid; idx < 128 * 32; idx += 512) { const int t = idx >> 5, s4 = (idx & 31) * 4; f32x4 w = *(const f32x4*)(wsp + ((size_t)g * 128 + t) * 128 + s4);
#pragma unroll
                        for (int i = 0; i < 4; ++i) if (s4 + i > t) w[i] = 0.f;
                        *(LAS u32x2*)(Wsm + t * 136 + s4) = pack4(w); }
                    { const int tok = tid >> 2, part = tid & 3; const bf16_t* vp = Z + (size_t)(128 * n + tok) * ZW + 1024 + g * 128 + part * 32;
                      float v[32]; float ss = 0.f;
#pragma unroll
                      for (int q = 0; q < 4; ++q) { const u32x4 w = *(const u32x4*)(vp + q * 8);
                          v[q * 8 + 0] = bf2f(w.x & 0xffffu); v[q * 8 + 1] = bf2f(w.x >> 16); v[q * 8 + 2] = bf2f(w.y & 0xffffu); v[q * 8 + 3] = bf2f(w.y >> 16);
                          v[q * 8 + 4] = bf2f(w.z & 0xffffu); v[q * 8 + 5] = bf2f(w.z >> 16); v[q * 8 + 6] = bf2f(w.w & 0xffffu); v[q * 8 + 7] = bf2f(w.w >> 16); }
#pragma unroll
                      for (int i = 0; i < 32; ++i) ss += v[i] * v[i];
                      ss += __shfl_xor(ss, 1); ss += __shfl_xor(ss, 2);
                      const float rs = 1.0f / sqrtf(ss * (1.f / 128.f) + EPS);
#pragma unroll
                      for (int i = 0; i < 32; ++i) { const int c = part * 32 + i; const float y = v[i] * rs * vg[g * 128 + c]; VT[c * 136 + tok] = (bf16_t)(cvt_pk_bf16(y, 0.f) & 0xffffu); } }
                    __syncthreads();
                    const int l15 = lane & 15, quad = lane >> 4;
                    f32x4 acc[8];
#pragma unroll
                    for (int cb = 0; cb < 8; ++cb) acc[cb] = (f32x4){0.f, 0.f, 0.f, 0.f};
                    for (int ks = 0; ks <= (wid >> 1); ++ks) {
                        const bf16x8 a = *(const LAS bf16x8*)(Wsm + (16 * wid + l15) * 136 + 32 * ks + quad * 8);
#pragma unroll
                        for (int cb = 0; cb < 8; ++cb) { const bf16x8 b = *(const LAS bf16x8*)(VT + (16 * cb + l15) * 136 + 32 * ks + quad * 8);
                            acc[cb] = __builtin_amdgcn_mfma_f32_16x16x32_bf16(b, a, acc[cb], 0, 0, 0); }
                    }
                    const int t = 16 * wid + l15; const float bs = bsp[g * 128 + t];
                    bf16_t* up = Z + (size_t)(128 * n + t) * ZW + g * 128 + quad * 4;
#pragma unroll
                    for (int cb = 0; cb < 8; ++cb) { const f32x4 uu = unpack4(*(const u32x2*)(up + 16 * cb)); f32x4 y = uu * (acc[cb] + bs); *(u32x2*)(up + 16 * cb) = pack4(y); }
                }
            }
            grid.sync();
            if (PHMASK & (1u << 4)) { PHASE_IDS
                bf16_t* Z = (bf16_t*)(R + R_Z);
                LAS bf16_t* Ks = (LAS bf16_t*)lds; LAS bf16_t* VT = (LAS bf16_t*)(lds + 9216); LAS float* Ck = (LAS float*)(lds + 18432);
                const int l15 = lane & 15, quad = lane >> 4;
                const float Gq = wave_max(fabsf(P.in[6][e * 64 + lane])), Gk = wave_max(fabsf(P.in[7][e * 64 + lane]));
                const float thr = -(40.f + 2.f * 8.f * Gq * Gk * LOG2E);
                for (int item = bid; item < 1024; item += G) {
                    const int qb = 127 - (item >> 3), h = item & 7; const int q0 = 128 * qb, qw = q0 + 16 * wid;
                    const bf16_t* Qp = Z + (size_t)(qw + l15) * ZW + 512 + 64 * h;
                    const bf16x8 qf0 = *(const bf16x8*)(Qp + quad * 8), qf1 = *(const bf16x8*)(Qp + 32 + quad * 8);
                    const float c2q = CGm[(size_t)(qw + l15) * 8 + h], c2q0 = CGm[(size_t)q0 * 8 + h];
                    float mrun = -1e30f, lrun = 0.f; f32x4 o[4];
#pragma unroll
                    for (int db = 0; db < 4; ++db) o[db] = (f32x4){0.f, 0.f, 0.f, 0.f};
                    int j = 2 * qb + 1;
                    u32x4 kreg = *(const u32x4*)(Z + (size_t)(64 * j + (tid >> 3)) * ZW + 1536 + 64 * h + (tid & 7) * 8);
                    u32x4 vreg = *(const u32x4*)(Z + (size_t)(64 * j + lane) * ZW + 2048 + 64 * h + wid * 8);
                    float ckreg = CGm[(size_t)(64 * j + lane) * 8 + h];
                    for (; j >= 0; --j) {
                        __syncthreads();
                        *(LAS u32x4*)(Ks + (tid >> 3) * 72 + (tid & 7) * 8) = kreg;
                        { LAS bf16_t* vt = VT + (wid * 8) * 72 + lane;
                          vt[0 * 72] = (bf16_t)(vreg.x & 0xffffu); vt[1 * 72] = (bf16_t)(vreg.x >> 16); vt[2 * 72] = (bf16_t)(vreg.y & 0xffffu); vt[3 * 72] = (bf16_t)(vreg.y >> 16);
                          vt[4 * 72] = (bf16_t)(vreg.z & 0xffffu); vt[5 * 72] = (bf16_t)(vreg.z >> 16); vt[6 * 72] = (bf16_t)(vreg.w & 0xffffu); vt[7 * 72] = (bf16_t)(vreg.w >> 16); }
                        if (wid == 0) Ck[lane] = ckreg;
                        __syncthreads();
                        if (j > 0) {
                            kreg = *(const u32x4*)(Z + (size_t)(64 * (j - 1) + (tid >> 3)) * ZW + 1536 + 64 * h + (tid & 7) * 8);
                            vreg = *(const u32x4*)(Z + (size_t)(64 * (j - 1) + lane) * ZW + 2048 + 64 * h + wid * 8);
                            ckreg = CGm[(size_t)(64 * (j - 1) + lane) * 8 + h];
                        }
                        if (64 * j + 63 < q0 && (c2q0 - Ck[63]) < thr) break;
                        if (64 * j > qw + 15) continue;
                        f32x4 s[4];
#pragma unroll
                        for (int kb = 0; kb < 4; ++kb) {
                            const LAS bf16_t* kp = Ks + (16 * kb + l15) * 72 + quad * 8;
                            const bf16x8 k0 = *(const LAS bf16x8*)kp, k1 = *(const LAS bf16x8*)(kp + 32);
                            f32x4 z = (f32x4){0.f, 0.f, 0.f, 0.f};
                            z = __builtin_amdgcn_mfma_f32_16x16x32_bf16(k0, qf0, z, 0, 0, 0);
                            z = __builtin_amdgcn_mfma_f32_16x16x32_bf16(k1, qf1, z, 0, 0, 0);
                            const f32x4 ck4 = *(const LAS f32x4*)(Ck + 16 * kb + quad * 4);
                            s[kb] = z + (c2q - ck4);
                        }
                        if (64 * j + 63 > qw) {
#pragma unroll
                            for (int kb = 0; kb < 4; ++kb)
#pragma unroll
                                for (int jj = 0; jj < 4; ++jj) if (64 * j + 16 * kb + 4 * quad + jj > qw + l15) s[kb][jj] = -1e30f;
                        }
                        float mx = -1e30f;
#pragma unroll
                        for (int kb = 0; kb < 4; ++kb) mx = fmaxf(fmaxf(mx, fmaxf(s[kb][0], s[kb][1])), fmaxf(s[kb][2], s[kb][3]));
                        mx = fmaxf(mx, __shfl_xor(mx, 16)); mx = fmaxf(mx, __shfl_xor(mx, 32));
                        const float mn = fmaxf(mrun, mx); const float alpha = __builtin_amdgcn_exp2f(mrun - mn); mrun = mn;
                        float ls = 0.f;
#pragma unroll
                        for (int kb = 0; kb < 4; ++kb)
#pragma unroll
                            for (int jj = 0; jj < 4; ++jj) { s[kb][jj] = __builtin_amdgcn_exp2f(s[kb][jj] - mn); ls += s[kb][jj]; }
                        lrun = lrun * alpha + ls;
#pragma unroll
                        for (int db = 0; db < 4; ++db) o[db] = o[db] * alpha;
#pragma unroll
                        for (int kk = 0; kk < 2; ++kk) {
                            u32x4 pw; pw.x = cvt_pk_bf16(s[2 * kk][0], s[2 * kk][1]); pw.y = cvt_pk_bf16(s[2 * kk][2], s[2 * kk][3]); pw.z = cvt_pk_bf16(s[2 * kk + 1][0], s[2 * kk + 1][1]); pw.w = cvt_pk_bf16(s[2 * kk + 1][2], s[2 * kk + 1][3]);
                            const bf16x8 pb = __builtin_bit_cast(bf16x8, pw);
#pragma unroll
                            for (int db = 0; db < 4; ++db) {
                                const LAS bf16_t* vp = VT + (16 * db + l15) * 72 + 32 * kk + quad * 4;
                                u32x4 vw; const u32x2 va = *(const LAS u32x2*)vp, vb = *(const LAS u32x2*)(vp + 16); vw.x = va.x; vw.y = va.y; vw.z = vb.x; vw.w = vb.y;
                                o[db] = __builtin_amdgcn_mfma_f32_16x16x32_bf16(__builtin_bit_cast(bf16x8, vw), pb, o[db], 0, 0, 0);
                            }
                        }
                    }
                    lrun += __shfl_xor(lrun, 16); lrun += __shfl_xor(lrun, 32);
                    const float inv = 1.0f / lrun;
                    bf16_t* Op = Z + (size_t)(qw + l15) * ZW + 512 + 64 * h + 4 * quad;
#pragma unroll
                    for (int db = 0; db < 4; ++db) *(u32x2*)(Op + 16 * db) = pack4(o[db] * inv);
                }
            }
            grid.sync();
            if (PHMASK & (1u << 5)) { PHASE_IDS
                pg8::Gemm g{(const bf16_t*)(R + R_Z), (const bf16_t*)(ws + WS_WOUT) + (size_t)e * 1024 * 1024, 1024, ZW, 256};
                pg8::StaticOrder so; so.init(64, 4, G, bid);
                pg8::EpiRes E{X};
                pg8::gemm_phase(lds, g, so, E);
            }
            grid.sync();
        } else {
            if (PHMASK & (1u << 6)) { PHASE_IDS
                bf16_t* AG = (bf16_t*)(R + R_AG); bf16_t* TS = (bf16_t*)(R + R_TS); bf16_t* PS = (bf16_t*)(R + R_PS);
                const float* gmix = P.in[2] + L * D;
                for (int t = gw; t < S; t += NGW) { f32x4 v[4]; const float rs = load_row(X + (size_t)t * D, lane, v);
#pragma unroll
                    for (int j = 0; j < 4; ++j) { const f32x4 gg = *((const f32x4*)gmix + lane + 64 * j); v[j] = v[j] * rs * gg; const int d = 4 * lane + 256 * j; const int g = d >> 4, c = d & 15;
                        *(u32x2*)(AG + (size_t)(g * 512 + (t >> 5)) * 640 + (t & 31) * 16 + c) = pack4(v[j]); } }
                const float* a_re = P.in[12] + e * 4096; const float* a_im = P.in[13] + e * 4096; const float* ldt = P.in[14] + e * 64;
                const float* b_re = P.in[15] + (size_t)e * 65536; const float* b_im = P.in[16] + (size_t)e * 65536; const float* c_re = P.in[17] + (size_t)e * 65536; const float* c_im = P.in[18] + (size_t)e * 65536;
                LAS float* Wr = (LAS float*)lds; LAS float* Wi = Wr + 64; LAS float* Pr = Wr + 128; LAS float* Pi = Wr + 192;
                for (int it = bid; it < 2048; it += G) {
                    const int g = it >> 5, j = it & 31;
                    __syncthreads();
                    if (tid < 64) { const int p = tid; const float dt = expf(ldt[g]), lr = a_re[g * 64 + p], li = a_im[g * 64 + p];
                        float s1, c1; sincosf(li * dt, &s1, &c1); const float e1 = expf(lr * dt); const float abr = e1 * c1, abi = e1 * s1;
                        const float den = lr * lr + li * li, nr = abr - 1.0f, ni = abi; const float cr = (nr * lr + ni * li) / den, ci = (ni * lr - nr * li) / den;
                        float sj, cj; sincosf((float)j * (li * dt), &sj, &cj); const float ej = expf((float)j * (lr * dt)); const float ajr = ej * cj, aji = ej * sj;
                        Wr[p] = ajr * cr - aji * ci; Wi[p] = ajr * ci + aji * cr;
                        float sp, cp; sincosf((float)(j + 1) * (li * dt), &sp, &cp); const float ep = expf((float)(j + 1) * (lr * dt)); Pr[p] = ep * cp; Pi[p] = ep * sp; }
                    __syncthreads();
                    if (tid < 256) { const int c = tid >> 4, cq = tid & 15; float acc = 0.f;
                        for (int p = 0; p < 64; ++p) { const float Cr = c_re[((size_t)g * 16 + c) * 64 + p], Ci = c_im[((size_t)g * 16 + c) * 64 + p]; const float wr_ = Wr[p], wi_ = Wi[p];
                            const float cwr = Cr * wr_ - Ci * wi_, cwi = Cr * wi_ + Ci * wr_; const float br = b_re[((size_t)g * 64 + p) * 16 + cq], bi = b_im[((size_t)g * 64 + p) * 16 + cq];
                            acc += cwr * br - cwi * bi; }
                        const bf16_t kv = (bf16_t)(cvt_pk_bf16(acc, 0.f) & 0xffffu);
                        for (int s = 0; s + j < 32; ++s) { TS[(size_t)(g * 512 + (j + s) * 16 + c) * 640 + s * 16 + cq] = kv; if (j >= 1) TS[(size_t)(g * 512 + s * 16 + c) * 640 + (s + j) * 16 + cq] = 0; }
                    } else {
#pragma unroll 1
                        for (int k = 0; k < 8; ++k) { const int idx = (tid - 256) + 256 * k; const int c = idx >> 7, rp = idx & 127, p = rp & 63;
                            const float Cr = c_re[((size_t)g * 16 + c) * 64 + p], Ci = c_im[((size_t)g * 16 + c) * 64 + p];
                            const float val = (rp < 64) ? (Cr * Pr[p] - Ci * Pi[p]) : -(Cr * Pi[p] + Ci * Pr[p]);
                            TS[(size_t)(g * 512 + j * 16 + c) * 640 + 512 + rp] = (bf16_t)(cvt_pk_bf16(val, 0.f) & 0xffffu); }
                    }
                    { const int s = 31 - j;
#pragma unroll 1
                      for (int k = 0; k < 4; ++k) { const int idx = tid + 512 * k; const int rp = idx >> 4, cq = idx & 15, p = rp & 63;
                          const float br = b_re[((size_t)g * 64 + p) * 16 + cq], bi = b_im[((size_t)g * 64 + p) * 16 + cq];
                          const float val = (rp < 64) ? (Wr[p] * br - Wi[p] * bi) : (Wr[p] * bi + Wi[p] * br);
                          PS[(size_t)(g * 256 + rp) * 512 + s * 16 + cq] = (bf16_t)(cvt_pk_bf16(val, 0.f) & 0xffffu);
                          PS[(size_t)(g * 256 + 128 + rp) * 512 + s * 16 + cq] = 0; } }
                }
            }
            grid.sync();
            if (PHMASK & (1u << 7)) { PHASE_IDS
                pg8::Gemm g{(const bf16_t*)(R + R_AG), (const bf16_t*)(R + R_PS), 512, 640, 256};
                pg8::OrderS5E so{G, bid};
                pg8::EpiE E{(float*)(R + R_E)};
                pg8::gemm_phase(lds, g, so, E);
            }
            grid.sync();
            if (PHMASK & (1u << 8)) { PHASE_IDS
                bf16_t* AG = (bf16_t*)(R + R_AG); const float* Eb = (const float*)(R + R_E);
                const float* a_re = P.in[12] + e * 4096; const float* a_im = P.in[13] + e * 4096; const float* ldt = P.in[14] + e * 64;
                LAS float* Tr = (LAS float*)lds; LAS float* Ti = Tr + 512;
                for (int g = bid; g < 64; g += G) {
                    const int p = lane, seg = wid;
                    const float dt = expf(ldt[g]), lr = a_re[g * 64 + p], li = a_im[g * 64 + p];
                    float sA, cA; sincosf(32.f * (li * dt), &sA, &cA); const float eA = expf(32.f * (lr * dt)); const float ar = eA * cA, ai = eA * sA;
                    float sB, cB; sincosf(2048.f * (li * dt), &sB, &cB); const float eB = expf(2048.f * (lr * dt)); const float br = eB * cB, bi = eB * sB;
                    float xr = 0.f, xi = 0.f;
#pragma unroll 8
                    for (int n = 64 * seg; n < 64 * seg + 64; ++n) { const float er = Eb[(size_t)(g * 512 + n) * 128 + p], ei = Eb[(size_t)(g * 512 + n) * 128 + 64 + p];
                        const float nr = ar * xr - ai * xi + er, ni = ar * xi + ai * xr + ei; xr = nr; xi = ni; }
                    __syncthreads();
                    Tr[seg * 64 + p] = xr; Ti[seg * 64 + p] = xi;
                    __syncthreads();
                    xr = 0.f; xi = 0.f;
                    for (int s2 = 0; s2 < seg; ++s2) { const float nr = br * xr - bi * xi + Tr[s2 * 64 + p], ni = br * xi + bi * xr + Ti[s2 * 64 + p]; xr = nr; xi = ni; }
#pragma unroll 8
                    for (int n = 64 * seg; n < 64 * seg + 64; ++n) { const float er = Eb[(size_t)(g * 512 + n) * 128 + p], ei = Eb[(size_t)(g * 512 + n) * 128 + 64 + p];
                        bf16_t* sp = AG + (size_t)(g * 512 + n) * 640 + 512 + p; sp[0] = (bf16_t)(cvt_pk_bf16(xr, 0.f) & 0xffffu); sp[64] = (bf16_t)(cvt_pk_bf16(xi, 0.f) & 0xffffu);
                        const float nr = ar * xr - ai * xi + er, ni = ar * xi + ai * xr + ei; xr = nr; xi = ni; }
                }
            }
            grid.sync();
            if (PHMASK & (1u << 9)) { PHASE_IDS
                pg8::Gemm g{(const bf16_t*)(R + R_AG), (const bf16_t*)(R + R_TS), 640, 640, 256};
                pg8::OrderS5Y so{G, bid};
                pg8::EpiY E{(const bf16_t*)(R + R_AG), P.in[19] + e * D, (bf16_t*)(R + R_G)};
                pg8::gemm_phase(lds, g, so, E);
            }
            grid.sync();
            if (PHMASK & (1u << 10)) { PHASE_IDS
                pg8::Gemm g{(const bf16_t*)(R + R_G), (const bf16_t*)(ws + WS_WGLU) + (size_t)e * 2048 * 1024, 1024, 1024, 256};
                pg8::StaticOrder so; so.init(64, 8, G, bid);
                pg8::EpiGlu E{X};
                pg8::gemm_phase(lds, g, so, E);
            }
            grid.sync();
        }
        if (PHMASK & (1u << 11)) { PHASE_IDS
            const float* gf = P.in[3] + L * D;
            for (int t = gw; t < S; t += NGW) { f32x4 v[4]; const float rs = load_row(X + (size_t)t * D, lane, v);
#pragma unroll
                for (int j = 0; j < 4; ++j) { const f32x4 gg = *((const f32x4*)gf + lane + 64 * j); *((u32x2*)(HN + (size_t)t * D) + lane + 64 * j) = pack4(v[j] * rs * gg); } }
        }
        grid.sync();
        if (PHMASK & (1u << 12)) { PHASE_IDS
            pg8::Gemm g{HNA, (const bf16_t*)(ws + WS_WUP) + (size_t)L * 5632 * 1024, 1024, 1024, 254};
            pg8::StaticOrder so; so.init(65, 22, G, bid);
            pg8::EpiConv E{(bf16_t*)(R + R_ACT), P.in[22] + (size_t)L * 3 * 5632, P.in[23] + (size_t)L * 5632, lds + XL_OFF};
            pg8::gemm_phase(lds, g, so, E);
        }
        grid.sync();
        if (PHMASK & (1u << 13)) { PHASE_IDS
            pg8::Gemm g{(const bf16_t*)(R + R_ACT), (const bf16_t*)(ws + WS_WDN) + (size_t)L * 1024 * 2816, 2816, 2816, 256};
            pg8::StaticOrder so; so.init(64, 4, G, bid);
            pg8::EpiRes E{X};
            pg8::gemm_phase(lds, g, so, E);
        }
        grid.sync();
        if (PHMASK & (1u << 14)) { PHASE_IDS
            const float* pin = P.in[1] + (size_t)L * S * 256; bf16_t* PB = (bf16_t*)(R + R_PB);
            for (int t = gw; t < S; t += NGW) { f32x4 v[4]; const float rs = load_row(X + (size_t)t * D, lane, v);
#pragma unroll
                for (int j = 0; j < 4; ++j) *((u32x2*)(HN + (size_t)t * D) + lane + 64 * j) = pack4(v[j] * rs);
                const f32x4 pv = *((const f32x4*)(pin + (size_t)t * 256) + lane); *((u32x2*)(PB + (size_t)t * 256) + lane) = pack4(pv); }
        }
        grid.sync();
        if (PHMASK & (1u << 15)) { PHASE_IDS
            pg8::StaticOrder so; so.init(64, 4, G, bid);
            { pg8::Gemm g{(const bf16_t*)(R + R_PB), (const bf16_t*)(ws + WS_WPR) + (size_t)L * 1024 * 256, 256, 256, 256};
              pg8::EpiStore E{(bf16_t*)(R + R_PP), D, 0};
              pg8::gemm_phase(lds, g, so, E); }
            asm volatile("s_waitcnt vmcnt(0)" ::: "memory"); __syncthreads();
            { pg8::Gemm g{HN, (const bf16_t*)(ws + WS_WGT) + (size_t)L * 1024 * 1024, 1024, 1024, 256};
              pg8::EpiGate E{X, (const bf16_t*)(R + R_PP)};
              pg8::gemm_phase(lds, g, so, E); }
        }
        grid.sync();
    }
}

extern "C" void kernel_launch(void* const* d_in, const int* in_sizes, int n_in, void* d_out, int out_size, void* d_ws, size_t ws_size, hipStream_t stream) {
    static int grid = 0;
    if (grid == 0) {
        if (n_in != 27 || out_size != S * D || ws_size < WS_END) { fprintf(stderr, "kernel_launch: unexpected shapes (n_in %d out %d ws %zu need %zu)\n", n_in, out_size, ws_size, (size_t)WS_END); grid = -1; return; }
        int dev = 0, cus = 0, per_cu = 0;
        hipGetDevice(&dev); hipDeviceGetAttribute(&cus, hipDeviceAttributeMultiprocessorCount, dev);
        hipFuncSetAttribute((const void*)mega, hipFuncAttributeMaxDynamicSharedMemorySize, LDS_BYTES);
        hipOccupancyMaxActiveBlocksPerMultiprocessor(&per_cu, (const void*)mega, 512, LDS_BYTES);
        if (per_cu < 1) per_cu = 1;
        grid = cus * per_cu;
    }
    if (grid < 0) return;
    Params p{};
    for (int i = 0; i < 27; ++i) p.in[i] = (const float*)d_in[i];
    p.out = (float*)d_out; p.ws = (unsigned char*)d_ws;
    void* args[] = {&p};
    hipError_t err = hipLaunchCooperativeKernel((const void*)mega, dim3(grid), dim3(512), args, LDS_BYTES, stream);
    if (err != hipSuccess) fprintf(stderr, "cooperative launch failed: %s (grid %d)\n", hipGetErrorString(err), grid);
}
```

```cpp
#include <hip/hip_runtime.h>
#include <hip/hip_cooperative_groups.h>
#include <cstdio>
#include <cstdint>
namespace cg = cooperative_groups;

#define LAS __attribute__((address_space(3)))
typedef unsigned short bf16_t;
typedef short bf16x8 __attribute__((ext_vector_type(8)));
typedef float f32x4 __attribute__((ext_vector_type(4)));
typedef unsigned u32x4 __attribute__((ext_vector_type(4)));
typedef unsigned u32x2 __attribute__((ext_vector_type(2)));

constexpr int S = 16384, D = 1024, FF = 2816, ZW = 2560;
constexpr float EPS = 1e-6f;
constexpr float LOG2E = 1.4426950408889634f;

__device__ __forceinline__ unsigned cvt_pk_bf16(float lo, float hi) { unsigned r; asm volatile("v_cvt_pk_bf16_f32 %0, %1, %2" : "=v"(r) : "v"(lo), "v"(hi)); return r; }
__device__ __forceinline__ float bf2f(unsigned b) { return __uint_as_float(b << 16); }
__device__ __forceinline__ float sigm(float z) { return __builtin_amdgcn_rcpf(1.f + __builtin_amdgcn_exp2f(-LOG2E * z)); }
__device__ __forceinline__ float gelu_t(float x) { const float z = 1.5957691216057308f * (x + 0.044715f * x * x * x); return x * sigm(z); }
__device__ __forceinline__ u32x2 pack4(f32x4 v) { u32x2 w; w.x = cvt_pk_bf16(v[0], v[1]); w.y = cvt_pk_bf16(v[2], v[3]); return w; }
__device__ __forceinline__ f32x4 unpack4(u32x2 w) { return (f32x4){bf2f(w.x & 0xffffu), bf2f(w.x >> 16), bf2f(w.y & 0xffffu), bf2f(w.y >> 16)}; }
__device__ __forceinline__ float wave_sum(float v) {
#pragma unroll
    for (int o = 1; o < 64; o <<= 1) v += __shfl_xor(v, o);
    return v;
}
__device__ __forceinline__ float wave_max(float v) {
#pragma unroll
    for (int o = 1; o < 64; o <<= 1) v = fmaxf(v, __shfl_xor(v, o));
    return v;
}

namespace pg8 {
constexpr int BM = 256, BK = 64, HALF = 128, HTB = HALF * BK * 2, STAGE_BYTES = 8 * HTB, NXCD = 8, WGM = 8;
__host__ __device__ __forceinline__ int lds_byte(int r, int c) { const int st = (r >> 4) * 2 + (c >> 5), rr = r & 15, cc = c & 31, ob = rr * 64 + cc * 2; return st * 1024 + (ob ^ (((ob >> 9) & 1) << 5)); }
__host__ __device__ __forceinline__ void stage_rc(int b, int& R, int& C) { const int st = b / 1024, sb = b % 1024, swz = sb ^ (((sb >> 9) & 1) << 5); R = (st >> 1) * 16 + swz / 64; C = (st & 1) * 32 + (swz % 64) / 2; }
struct Unit { int pm, pn; };
struct Gemm { const bf16_t* A; const bf16_t* Bt; int K, lda, arows; };

struct StaticOrder {
    int nM, nN, nwg, G, c;
    __device__ void init(int nM_, int nN_, int G_, int c_) { nM = nM_; nN = nN_; nwg = nM * nN; G = G_; c = c_; }
    __device__ bool next(int i, Unit& u) const {
        const long L = (long)i * G + c; if (L >= nwg) return false;
        int wgid = (int)L; { const int q = nwg / NXCD, r = nwg % NXCD, xcd = wgid % NXCD, off = wgid / NXCD; wgid = (xcd < r ? xcd * (q + 1) : r * (q + 1) + (xcd - r) * q) + off; }
        const int nig = WGM * nN, gid = wgid / nig, fm = gid * WGM, gsz = (nM - fm) < WGM ? (nM - fm) : WGM;
        u.pm = fm + ((wgid % nig) % gsz); u.pn = (wgid % nig) / gsz; return true;
    }
};
struct OrderS5E { int G, c; __device__ bool next(int i, Unit& u) const { const int L = i * G + c; if (L >= 128) return false; u.pm = L; u.pn = L >> 1; return true; } };
struct OrderS5Y { int G, c; __device__ bool next(int i, Unit& u) const { const int L = i * G + c; if (L >= 256) return false; const int g = L >> 2; u.pm = 2 * g + ((L >> 1) & 1); u.pn = 2 * g + (L & 1); return true; } };

template <class Epi, class Sched>
__device__ __forceinline__ void gemm_phase(LAS unsigned char* lds, const Gemm g, const Sched& S, const Epi& E) {
    int tid_ = threadIdx.x; asm volatile("" : "+v"(tid_));
    const int tid = tid_, wid = __builtin_amdgcn_readfirstlane(tid >> 6), lane = tid & 63, wr = wid >> 2, wc = wid & 3, fr = lane & 15, fq = lane >> 4;
    const int K = g.K, nt = K / BK, lda = g.lda;
    unsigned voffA[2], voffB[2];
#pragma unroll
    for (int i = 0; i < 2; ++i) { int R, C; stage_rc(tid * 16 + i * 8192, R, C); voffA[i] = (unsigned)(R * lda + C) * 2u; voffB[i] = (unsigned)(R * K + C) * 2u; }
    const size_t kstep = (size_t)(BK * 2);
    const size_t hstepA = (size_t)HALF * lda * 2, hstepB = (size_t)HALF * K * 2;
    const size_t tstepA = (size_t)g.arows * lda * 2, tstepB = 2 * hstepB;
    const unsigned ldsw = (unsigned)wid * 1024u;
    const int aoff = lds_byte(wr * 64 + fr, fq * 8), boff = lds_byte(wc * 32 + fr, fq * 8);
#define PG8_SA(b, h) (((b) * 2 + (h)) * HTB)
#define PG8_SB(b, h) ((4 + (b) * 2 + (h)) * HTB)
#define PG8_STAGE(bufoff, gbase, voff) do { _Pragma("unroll") for (int _i = 0; _i < 2; ++_i) \
        __builtin_amdgcn_global_load_lds((const unsigned*)((const char*)(gbase) + (voff)[_i]), (LAS unsigned*)(lds + (bufoff) + ldsw + _i * 8192), 16, 0, 0); } while (0)
#define PG8_LDA(dst, b, h) do { _Pragma("unroll") for (int m = 0; m < 4; ++m) _Pragma("unroll") for (int k = 0; k < 2; ++k) dst[m][k] = *(const LAS bf16x8*)(lds + PG8_SA(b, h) + aoff + m * 2048 + k * 1024); } while (0)
#define PG8_LDB(dst, b, h) do { _Pragma("unroll") for (int n = 0; n < 2; ++n) _Pragma("unroll") for (int k = 0; k < 2; ++k) dst[n][k] = *(const LAS bf16x8*)(lds + PG8_SB(b, h) + boff + n * 2048 + k * 1024); } while (0)
#define PG8_MMA(ai, bj, At, Bt) do { __builtin_amdgcn_s_setprio(1); _Pragma("unroll") for (int m = 0; m < 4; ++m) _Pragma("unroll") for (int n = 0; n < 2; ++n) _Pragma("unroll") for (int k = 0; k < 2; ++k) \
        acc[ai][bj][m][n] = __builtin_amdgcn_mfma_f32_16x16x32_bf16(Bt[n][k], At[m][k], acc[ai][bj][m][n], 0, 0, 0); __builtin_amdgcn_s_setprio(0); } while (0)
#define PG8_WAIT_V(n) asm volatile("s_waitcnt vmcnt(" #n ")" ::: "memory")
#define PG8_WAIT_L(n) asm volatile("s_waitcnt lgkmcnt(" #n ")" ::: "memory")
#define PG8_BAR __builtin_amdgcn_s_barrier()
#define PG8_SCHED __builtin_amdgcn_sched_barrier(0)
    Unit cur, nxt; int ui = 0;
    if (!S.next(0, cur)) return;
    f32x4 acc[2][2][4][2];
#pragma unroll
    for (int a = 0; a < 2; ++a)
#pragma unroll
        for (int b = 0; b < 2; ++b)
#pragma unroll
            for (int m = 0; m < 4; ++m)
#pragma unroll
                for (int n = 0; n < 2; ++n) acc[a][b][m][n] = (f32x4){0.f, 0.f, 0.f, 0.f};
    bf16x8 At[4][2], B0[2][2], B1[2][2];
    const char* cA = (const char*)g.A + (size_t)cur.pm * tstepA; const char* cB = (const char*)g.Bt + (size_t)cur.pn * tstepB;
    PG8_STAGE(PG8_SB(0, 0), cB, voffB); PG8_STAGE(PG8_SB(0, 1), cB + hstepB, voffB); PG8_STAGE(PG8_SA(0, 0), cA, voffA); PG8_STAGE(PG8_SA(0, 1), cA + hstepA, voffA);
    if (wr == 1) PG8_BAR;
    PG8_WAIT_V(2); PG8_BAR;
    PG8_STAGE(PG8_SB(1, 0), cB + kstep, voffB); PG8_STAGE(PG8_SA(1, 0), cA + kstep, voffA); PG8_STAGE(PG8_SB(1, 1), cB + hstepB + kstep, voffB);
    PG8_WAIT_V(6); PG8_BAR;
    for (;;) {
        const bool has_next = S.next(ui + 1, nxt);
        const char* nA = has_next ? (const char*)g.A + (size_t)nxt.pm * tstepA : cA; const char* nB = has_next ? (const char*)g.Bt + (size_t)nxt.pn * tstepB : cB;
        for (int t = 0; t < nt; t += 2) {
            const bool last = (t == nt - 2);
            const char* a1 = cA + (size_t)(t + 1) * kstep;
            const char* a2 = last ? nA : cA + (size_t)(t + 2) * kstep; const char* b2 = last ? nB : cB + (size_t)(t + 2) * kstep;
            const char* a3 = a2 + kstep; const char* b3 = b2 + kstep;
            PG8_LDB(B0, 0, 0); PG8_LDB(B1, 0, 1); PG8_SCHED; PG8_LDA(At, 0, 0); PG8_STAGE(PG8_SA(1, 1), a1 + hstepA, voffA);
            PG8_WAIT_V(8); PG8_WAIT_L(0); PG8_BAR; PG8_MMA(0, 0, At, B0); PG8_MMA(0, 1, At, B1); PG8_BAR; PG8_SCHED;
            PG8_LDA(At, 0, 1); PG8_STAGE(PG8_SB(0, 0), b2, voffB); PG8_STAGE(PG8_SB(0, 1), b2 + hstepB, voffB); PG8_STAGE(PG8_SA(0, 0), a2, voffA);
            PG8_WAIT_V(8); PG8_WAIT_L(0); PG8_BAR; PG8_MMA(1, 0, At, B0); PG8_MMA(1, 1, At, B1); PG8_BAR; PG8_SCHED;
            PG8_LDB(B0, 1, 0); PG8_LDB(B1, 1, 1); PG8_SCHED; PG8_LDA(At, 1, 0); PG8_STAGE(PG8_SA(0, 1), a2 + hstepA, voffA);
            PG8_WAIT_V(8); PG8_WAIT_L(0); PG8_BAR; PG8_MMA(0, 0, At, B0); PG8_MMA(0, 1, At, B1); PG8_BAR; PG8_SCHED;
            PG8_LDA(At, 1, 1); PG8_STAGE(PG8_SB(1, 0), b3, voffB); PG8_STAGE(PG8_SB(1, 1), b3 + hstepB, voffB); PG8_STAGE(PG8_SA(1, 0), a3, voffA);
            PG8_WAIT_V(8); PG8_WAIT_L(0); PG8_BAR; PG8_MMA(1, 0, At, B0); PG8_MMA(1, 1, At, B1); PG8_BAR; PG8_SCHED;
        }
        if (wr == 0) PG8_BAR;
        E(acc, cur, wr, wc, fr, fq);
        if (!has_next) break;
#pragma unroll
        for (int a = 0; a < 2; ++a)
#pragma unroll
            for (int b = 0; b < 2; ++b)
#pragma unroll
                for (int m = 0; m < 4; ++m)
#pragma unroll
                    for (int n = 0; n < 2; ++n) acc[a][b][m][n] = (f32x4){0.f, 0.f, 0.f, 0.f};
        cur = nxt; cA = nA; cB = nB; ++ui;
        if (wr == 1) PG8_BAR;
    }
    PG8_WAIT_V(0);
    PG8_BAR;
#undef PG8_SA
#undef PG8_SB
#undef PG8_STAGE
#undef PG8_LDA
#undef PG8_LDB
#undef PG8_MMA
#undef PG8_WAIT_V
#undef PG8_WAIT_L
#undef PG8_BAR
#undef PG8_SCHED
}

typedef f32x4 Acc[2][2][4][2];
struct EpiRes {
    float* X;
    __device__ __forceinline__ void operator()(const Acc& acc, const Unit& u, int wr, int wc, int fr, int fq) const {
#pragma unroll
        for (int ai = 0; ai < 2; ++ai)
#pragma unroll
            for (int m = 0; m < 4; ++m) { float* rp = X + (size_t)(u.pm * 256 + ai * 128 + wr * 64 + m * 16 + fr) * D + u.pn * 256 + wc * 32 + 4 * fq;
#pragma unroll
                for (int bj = 0; bj < 2; ++bj)
#pragma unroll
                    for (int n = 0; n < 2; ++n) { f32x4* q = (f32x4*)(rp + bj * 128 + n * 16); *q = *q + acc[ai][bj][m][n]; } }
    }
};
struct EpiStore {
    bf16_t* O; int ld; int mode;
    __device__ __forceinline__ void operator()(const Acc& acc, const Unit& u, int wr, int wc, int fr, int fq) const {
        const bool act = mode == 1 && (u.pn < 2 || u.pn == 4 || u.pn == 5);
#pragma unroll
        for (int ai = 0; ai < 2; ++ai)
#pragma unroll
            for (int m = 0; m < 4; ++m) { bf16_t* rp = O + (size_t)(u.pm * 256 + ai * 128 + wr * 64 + m * 16 + fr) * ld + u.pn * 256 + wc * 32 + 4 * fq;
#pragma unroll
                for (int bj = 0; bj < 2; ++bj)
#pragma unroll
                    for (int n = 0; n < 2; ++n) { f32x4 v = acc[ai][bj][m][n];
                        if (act) { v[0] = gelu_t(v[0]); v[1] = gelu_t(v[1]); v[2] = gelu_t(v[2]); v[3] = gelu_t(v[3]); }
                        *(u32x2*)(rp + bj * 128 + n * 16) = pack4(v); } }
    }
};
struct EpiGate {
    float* X; const bf16_t* PP;
    __device__ __forceinline__ void operator()(const Acc& acc, const Unit& u, int wr, int wc, int fr, int fq) const {
#pragma unroll
        for (int ai = 0; ai < 2; ++ai)
#pragma unroll
            for (int m = 0; m < 4; ++m) { const size_t off = (size_t)(u.pm * 256 + ai * 128 + wr * 64 + m * 16 + fr) * D + u.pn * 256 + wc * 32 + 4 * fq;
#pragma unroll
                for (int bj = 0; bj < 2; ++bj)
#pragma unroll
                    for (int n = 0; n < 2; ++n) { const f32x4 a = acc[ai][bj][m][n]; const f32x4 pp = unpack4(*(const u32x2*)(PP + off + bj * 128 + n * 16));
                        f32x4* q = (f32x4*)(X + off + bj * 128 + n * 16); f32x4 x = *q;
                        x[0] += sigm(a[0]) * pp[0]; x[1] += sigm(a[1]) * pp[1]; x[2] += sigm(a[2]) * pp[2]; x[3] += sigm(a[3]) * pp[3]; *q = x; } }
    }
};
struct EpiGlu {
    float* X;
    __device__ __forceinline__ void operator()(const Acc& acc, const Unit& u, int wr, int wc, int fr, int fq) const {
#pragma unroll
        for (int ai = 0; ai < 2; ++ai)
#pragma unroll
            for (int m = 0; m < 4; ++m) { float* rp = X + (size_t)(u.pm * 256 + ai * 128 + wr * 64 + m * 16 + fr) * D + u.pn * 128 + wc * 32 + 4 * fq;
#pragma unroll
                for (int n = 0; n < 2; ++n) { const f32x4 a = acc[ai][0][m][n], b = acc[ai][1][m][n]; f32x4* q = (f32x4*)(rp + n * 16); f32x4 x = *q;
                    x[0] += a[0] * sigm(b[0]); x[1] += a[1] * sigm(b[1]); x[2] += a[2] * sigm(b[2]); x[3] += a[3] * sigm(b[3]); *q = x; } }
    }
};
struct EpiE {
    float* Eo;
    __device__ __forceinline__ void operator()(const Acc& acc, const Unit& u, int wr, int wc, int fr, int fq) const {
#pragma unroll
        for (int ai = 0; ai < 2; ++ai)
#pragma unroll
            for (int m = 0; m < 4; ++m) { float* rp = Eo + (size_t)(u.pm * 256 + ai * 128 + wr * 64 + m * 16 + fr) * 128 + wc * 32 + 4 * fq;
#pragma unroll
                for (int n = 0; n < 2; ++n) *(f32x4*)(rp + n * 16) = acc[ai][0][m][n]; }
    }
};
struct EpiY {
    const bf16_t* AG; const float* Dv; bf16_t* Gm;
    __device__ __forceinline__ void operator()(const Acc& acc, const Unit& u, int wr, int wc, int fr, int fq) const {
        const int g = u.pm >> 1, jj = u.pn & 1; const f32x4 d4 = *(const f32x4*)(Dv + g * 16 + 4 * fq);
#pragma unroll
        for (int ai = 0; ai < 2; ++ai)
#pragma unroll
            for (int m = 0; m < 4; ++m) { const int rowA = u.pm * 256 + ai * 128 + wr * 64 + m * 16 + fr; const int nchunk = rowA - g * 512;
#pragma unroll
                for (int bj = 0; bj < 2; ++bj)
#pragma unroll
                    for (int n = 0; n < 2; ++n) { const int sp = 16 * jj + 8 * bj + 2 * wc + n; const int t = nchunk * 32 + sp;
                        const f32x4 uu = unpack4(*(const u32x2*)(AG + (size_t)rowA * 640 + sp * 16 + 4 * fq));
                        f32x4 y = acc[ai][bj][m][n] + d4 * uu; y[0] = gelu_t(y[0]); y[1] = gelu_t(y[1]); y[2] = gelu_t(y[2]); y[3] = gelu_t(y[3]);
                        *(u32x2*)(Gm + (size_t)t * D + g * 16 + 4 * fq) = pack4(y); } }
    }
};
__device__ __forceinline__ float dpp_ror1(float v) { return __int_as_float(__builtin_amdgcn_update_dpp(0, __float_as_int(v), 0x121, 0xf, 0xf, false)); }
__device__ __forceinline__ float dpp_ror2(float v) { return __int_as_float(__builtin_amdgcn_update_dpp(0, __float_as_int(v), 0x122, 0xf, 0xf, false)); }
struct EpiConv {
    bf16_t* ACT; const float* cw; const float* cb; LAS unsigned char* xl;
    __device__ __forceinline__ void operator()(const Acc& acc, const Unit& u, int wr, int wc, int fr, int fq) const {
        LAS f32x4* X4 = (LAS f32x4*)xl;
        if (fr >= 14) {
#pragma unroll
            for (int ai = 0; ai < 2; ++ai) { const int s = 2 * ai + wr;
                if (s <= 2) {
#pragma unroll
                    for (int bj = 0; bj < 2; ++bj)
#pragma unroll
                        for (int n = 0; n < 2; ++n) X4[(((((s * 2 + bj) * 2 + n) * 4 + wc) * 4 + fq) * 2) + (fr - 14)] = acc[ai][bj][3][n]; } }
        }
        asm volatile("s_waitcnt lgkmcnt(0)" ::: "memory"); __builtin_amdgcn_s_barrier(); asm volatile("" ::: "memory");
#pragma unroll
        for (int ai = 0; ai < 2; ++ai) { const int s = 2 * ai + wr;
#pragma unroll
            for (int n = 0; n < 2; ++n) {
                const int ch = 128 * u.pn + 32 * wc + 16 * n + 4 * fq;
                const f32x4 wg0 = *(const f32x4*)(cw + ch), wg1 = *(const f32x4*)(cw + 2 * FF + ch), wg2 = *(const f32x4*)(cw + 4 * FF + ch), bg = *(const f32x4*)(cb + ch);
                const f32x4 wu0 = *(const f32x4*)(cw + FF + ch), wu1 = *(const f32x4*)(cw + 3 * FF + ch), wu2 = *(const f32x4*)(cw + 5 * FF + ch), bu = *(const f32x4*)(cb + FF + ch);
                f32x4 pg = (f32x4){0.f, 0.f, 0.f, 0.f}, pu = pg;
                if (s >= 1 && fr >= 14) { pg = X4[((((((s - 1) * 2 + 0) * 2 + n) * 4 + wc) * 4 + fq) * 2) + (fr - 14)]; pu = X4[((((((s - 1) * 2 + 1) * 2 + n) * 4 + wc) * 4 + fq) * 2) + (fr - 14)]; }
#pragma unroll
                for (int m = 0; m < 4; ++m) {
                    const f32x4 cg_ = acc[ai][0][m][n], cu_ = acc[ai][1][m][n];
                    f32x4 hg, hu;
#pragma unroll
                    for (int e = 0; e < 4; ++e) {
                        const float t1g = fr == 15 ? pg[e] : cg_[e], t2g = fr >= 14 ? pg[e] : cg_[e];
                        const float t1u = fr == 15 ? pu[e] : cu_[e], t2u = fr >= 14 ? pu[e] : cu_[e];
                        const float p1g = dpp_ror1(t1g), p2g = dpp_ror2(t2g), p1u = dpp_ror1(t1u), p2u = dpp_ror2(t2u);
                        hg[e] = bg[e] + wg0[e] * p2g + wg1[e] * p1g + wg2[e] * cg_[e];
                        hu[e] = bu[e] + wu0[e] * p2u + wu1[e] * p1u + wu2[e] * cu_[e];
                    }
                    f32x4 o; o[0] = hg[0] * sigm(hg[0]) * hu[0]; o[1] = hg[1] * sigm(hg[1]) * hu[1]; o[2] = hg[2] * sigm(hg[2]) * hu[2]; o[3] = hg[3] * sigm(hg[3]) * hu[3];
                    const int rt = 128 * ai + 64 * wr + 16 * m + fr; const int gr = 254 * u.pm - 2 + rt;
                    if (rt >= 2 && gr < S) *(u32x2*)(ACT + (size_t)gr * FF + ch) = pack4(o);
                    pg = cg_; pu = cu_;
                }
            }
        }
    }
};
}

constexpr size_t MiB = 1u << 20;
constexpr size_t WS_CL = 0, WS_CG = 524288, WS_GT = 1048576, WS_BAR = 1572864, BAR_BYTES = 16384;
constexpr size_t WS_WIN = 2 * MiB;
constexpr size_t WS_WOUT = WS_WIN + 2ull * 2560 * 1024 * 2;
constexpr size_t WS_WGLU = WS_WOUT + 2ull * 1024 * 1024 * 2;
constexpr size_t WS_WUP = WS_WGLU + 2ull * 2048 * 1024 * 2;
constexpr size_t WS_WDN = WS_WUP + 4ull * 5632 * 1024 * 2;
constexpr size_t WS_WGT = WS_WDN + 4ull * 1024 * 2816 * 2;
constexpr size_t WS_WPR = WS_WGT + 4ull * 1024 * 1024 * 2;
constexpr size_t WS_HNA = WS_WPR + 4ull * 1024 * 256 * 2;
constexpr size_t WS_R = WS_HNA + (2ull + 16384 + 256) * 1024 * 2;
constexpr size_t WS_END = WS_R + 144 * MiB;
constexpr size_t R_Z = 0;
constexpr size_t R_AG = 0, R_TS = 40 * MiB, R_PS = 80 * MiB, R_E = 96 * MiB, R_G = 112 * MiB;
constexpr size_t R_ACT = 0;
constexpr size_t R_PB = 0, R_PP = 8 * MiB;

#ifndef REPMASK
#define REPMASK 0u
#endif
#ifndef XSYNC
#define XSYNC 0
#endif
constexpr int LDS_BYTES = 147456, XL_OFF = 131072;

#define XB_TMO      128
#define XB_XCNT(j)  (256  + 64 * (j))
#define XB_XSUB(j)  (1280 + 64 * (j))
#define XB_XGEN(j)  (2304 + 64 * (j))
#define XB_TOP      3328
#define XB_TOPGEN   3392
#define XCD_BAR_WORDS 3456
#define XB_SPIN_CAP (1u << 18)
__device__ __forceinline__ unsigned xb_ld(unsigned* p)              { return __hip_atomic_load(p, __ATOMIC_RELAXED, __HIP_MEMORY_SCOPE_AGENT); }
__device__ __forceinline__ unsigned xb_add(unsigned* p, unsigned v) { return __hip_atomic_fetch_add(p, v, __ATOMIC_RELAXED, __HIP_MEMORY_SCOPE_AGENT); }
__device__ __forceinline__ unsigned xb_xcc_id() { return (unsigned)__builtin_amdgcn_s_getreg((3 << 11) | 20) & 0xFu; }
#define XB_SPIN(cond, bar) do { unsigned _sp = 0; while (cond) { __builtin_amdgcn_s_sleep(1); \
    if ((++_sp & 255u) == 0u) { if (xb_ld(&(bar)[XB_TMO])) break; if (_sp > XB_SPIN_CAP) { atomicAdd(&(bar)[XB_TMO], 1u); break; } } } } while (0)
struct XcdBarrier { unsigned* bar; unsigned x; volatile LAS unsigned* st; };
__device__ __forceinline__ XcdBarrier xcd_barrier_post(unsigned* bar, volatile LAS unsigned* st) {
    XcdBarrier b; b.bar = bar; b.x = xb_xcc_id(); b.st = st;
    if (threadIdx.x == 0) (void)xb_add(&bar[XB_XCNT(b.x)], 1u);
    return b;
}
__device__ __forceinline__ void xcd_barrier_complete(unsigned* bar, unsigned x, unsigned& nloc, unsigned& nx) {
    const unsigned G = gridDim.x * gridDim.y * gridDim.z;
    unsigned sum, cnt, mine, sp = 0u;
    for (;;) {
        sum = 0u; cnt = 0u; mine = 0u;
#pragma unroll
        for (unsigned j = 0; j < 16; ++j) { const unsigned c = xb_ld(&bar[XB_XCNT(j)]); sum += c; cnt += (c > 0u) ? 1u : 0u; mine = (j == x) ? c : mine; }
        if (sum == G) break;
        __builtin_amdgcn_s_sleep(1);
        if ((++sp & 255u) == 0u) { if (xb_ld(&bar[XB_TMO])) break; if (sp > XB_SPIN_CAP) { atomicAdd(&bar[XB_TMO], 1u); break; } }
    }
    nloc = mine > 0u ? mine : 1u; nx = cnt > 0u ? cnt : 1u;
}
__device__ __forceinline__ void xcd_barrier(const XcdBarrier& b) {
    asm volatile("s_waitcnt vmcnt(0)" ::: "memory");
    __syncthreads();
    if (threadIdx.x == 0) {
        unsigned* bar = b.bar;
        __builtin_amdgcn_s_waitcnt(0);
        unsigned nloc = b.st[0], nx = b.st[1];
        if (nloc == 0u) { xcd_barrier_complete(bar, b.x, nloc, nx); b.st[0] = nloc; b.st[1] = nx; }
        const unsigned old = xb_add(&bar[XB_XSUB(b.x)], 1u);
        const unsigned gen = old / nloc;
        if (old + 1u == (gen + 1u) * nloc) {
            __builtin_amdgcn_fence(__ATOMIC_RELEASE, "agent");
            asm volatile("s_waitcnt vmcnt(0)" ::: "memory");
            const unsigned og = xb_add(&bar[XB_TOP], 1u);
            const unsigned tg = og / nx;
            if (og + 1u == (tg + 1u) * nx) xb_add(&bar[XB_TOPGEN], 1u);
            else XB_SPIN(xb_ld(&bar[XB_TOPGEN]) == tg, bar);
            __builtin_amdgcn_fence(__ATOMIC_ACQUIRE, "agent");
            xb_add(&bar[XB_XGEN(b.x)], 1u);
            asm volatile("s_waitcnt vmcnt(0)" ::: "memory");
        } else {
            XB_SPIN(xb_ld(&bar[XB_XGEN(b.x)]) == gen, bar);
            __builtin_amdgcn_fence(__ATOMIC_ACQUIRE, "agent");
            asm volatile("s_waitcnt vmcnt(0)" ::: "memory");
        }
    }
    __syncthreads();
}

struct Params { const float* in[27]; float* out; unsigned char* ws; };

__device__ __forceinline__ float load_row(const float* xrow, int lane, f32x4 (&v)[4]) {
    const f32x4* xr = (const f32x4*)xrow + lane; float ss = 0.f;
#pragma unroll
    for (int j = 0; j < 4; ++j) { v[j] = xr[64 * j]; ss += (v[j][0] * v[j][0] + v[j][1] * v[j][1]) + (v[j][2] * v[j][2] + v[j][3] * v[j][3]); }
    return 1.0f / sqrtf(wave_sum(ss) * (1.f / D) + EPS);
}

__device__ __forceinline__ void transpose_item(const float* W, int K, int ldw, bf16_t* WT, int n0, int drow0, int kb, LAS float* scr, int lane) {
    const int k0 = 64 * kb;
#pragma unroll 8
    for (int i = 0; i < 32; ++i) { const int kk = 2 * i + (lane >> 5); scr[kk * 33 + (lane & 31)] = W[(size_t)(k0 + kk) * ldw + n0 + (lane & 31)]; }
    asm volatile("s_waitcnt lgkmcnt(0)" ::: "memory");
    const int c = lane & 7;
#pragma unroll
    for (int j = 0; j < 4; ++j) { const int n = (lane >> 3) + 8 * j; const LAS float* s = scr + (8 * c) * 33 + n;
        u32x4 o; o.x = cvt_pk_bf16(s[0 * 33], s[1 * 33]); o.y = cvt_pk_bf16(s[2 * 33], s[3 * 33]); o.z = cvt_pk_bf16(s[4 * 33], s[5 * 33]); o.w = cvt_pk_bf16(s[6 * 33], s[7 * 33]);
        *(u32x4*)(WT + (size_t)(drow0 + n) * K + k0 + 8 * c) = o; }
    asm volatile("s_waitcnt lgkmcnt(0)" ::: "memory");
}
__device__ __forceinline__ int dest_row(int mode, int n0, int half) {
    if (mode == 1) { const int seg = n0 >> 9, r = n0 & 511; const int ds = seg == 1 ? 2 : (seg == 2 ? 1 : seg); return ds * 512 + r; }
    if (mode == 2) { const int hi = n0 >= half, np = hi ? n0 - half : n0; return (np >> 7) * 256 + hi * 128 + (np & 127); }
    return n0;
}
__device__ __forceinline__ bool transpose_mat(int& r, const float* W, int K, int ldw, int ncols, bf16_t* WT, int mode, LAS float* scr, int lane) {
    const int nblk = ncols / 32, items = (K / 64) * nblk;
    if (r >= items) { r -= items; return false; }
    const int kb = r / nblk, nb = r % nblk;
    transpose_item(W, K, ldw, WT, nb * 32, dest_row(mode, nb * 32, ncols / 2), kb, scr, lane);
    return true;
}

__global__ void __launch_bounds__(512, 2) mega(Params P) {
    extern __shared__ __attribute__((aligned(16))) unsigned char lds_raw[];
    LAS unsigned char* lds = (LAS unsigned char*)lds_raw;
    cg::grid_group grid = cg::this_grid();
    const int G = gridDim.x, bid = blockIdx.x, NGW = G * 8;
#define PHASE_IDS int tid = threadIdx.x; asm volatile("" : "+v"(tid)); const int lane = tid & 63, wid = __builtin_amdgcn_readfirstlane(tid >> 6), gw = bid * 8 + wid; (void)lane; (void)gw;
    unsigned char* ws = P.ws;
    float* X = P.out;
    float* CL = (float*)(ws + WS_CL); float* CGm = (float*)(ws + WS_CG); float* GT = (float*)(ws + WS_GT);
    bf16_t* HNA = (bf16_t*)(ws + WS_HNA); bf16_t* HN = HNA + 2 * D;
    unsigned char* R = ws + WS_R;
    { volatile LAS unsigned* st0 = (volatile LAS unsigned*)(lds + XL_OFF + 8192); if (threadIdx.x < 2) st0[threadIdx.x] = 0u; __syncthreads(); }
    const XcdBarrier xbar = xcd_barrier_post((unsigned*)(ws + WS_BAR), (volatile LAS unsigned*)(lds + XL_OFF + 8192));
#define GSYNC() xcd_barrier(xbar)

    for (int rep_ = 0; rep_ < 1 + (int)((REPMASK >> 0) & 1u); ++rep_) { PHASE_IDS
        LAS float* scr = (LAS float*)(lds + wid * 16384);
        constexpr int I_IN = 16 * 80, I_OUT = 16 * 32, I_GLU = 16 * 64, I_UP = 16 * 176, I_DN = 44 * 32, I_GT = 16 * 32, I_PR = 4 * 32;
        constexpr int NIT = 2 * I_IN + 2 * I_OUT + 2 * I_GLU + 4 * I_UP + 4 * I_DN + 4 * I_GT + 4 * I_PR;
        for (int it = gw; it < NIT; it += NGW) {
            int r = it; bool done = false;
#pragma unroll 1
            for (int e = 0; e < 2 && !done; ++e) done = transpose_mat(r, P.in[4] + (size_t)e * 1024 * 2568, 1024, 2568, 2560, (bf16_t*)(ws + WS_WIN) + (size_t)e * 2560 * 1024, 1, scr, lane);
#pragma unroll 1
            for (int e = 0; e < 2 && !done; ++e) done = transpose_mat(r, P.in[11] + (size_t)e * 1024 * 1024, 1024, 1024, 1024, (bf16_t*)(ws + WS_WOUT) + (size_t)e * 1024 * 1024, 0, scr, lane);
#pragma unroll 1
            for (int e = 0; e < 2 && !done; ++e) done = transpose_mat(r, P.in[20] + (size_t)e * 1024 * 2048, 1024, 2048, 2048, (bf16_t*)(ws + WS_WGLU) + (size_t)e * 2048 * 1024, 2, scr, lane);
#pragma unroll 1
            for (int e = 0; e < 4 && !done; ++e) done = transpose_mat(r, P.in[21] + (size_t)e * 1024 * 5632, 1024, 5632, 5632, (bf16_t*)(ws + WS_WUP) + (size_t)e * 5632 * 1024, 2, scr, lane);
#pragma unroll 1
            for (int e = 0; e < 4 && !done; ++e) done = transpose_mat(r, P.in[24] + (size_t)e * 2816 * 1024, 2816, 1024, 1024, (bf16_t*)(ws + WS_WDN) + (size_t)e * 1024 * 2816, 0, scr, lane);
#pragma unroll 1
            for (int e = 0; e < 4 && !done; ++e) done = transpose_mat(r, P.in[26] + (size_t)e * 1024 * 1024, 1024, 1024, 1024, (bf16_t*)(ws + WS_WGT) + (size_t)e * 1024 * 1024, 0, scr, lane);
#pragma unroll 1
            for (int e = 0; e < 4 && !done; ++e) done = transpose_mat(r, P.in[25] + (size_t)e * 256 * 1024, 256, 1024, 1024, (bf16_t*)(ws + WS_WPR) + (size_t)e * 1024 * 256, 0, scr, lane);
        }
        for (int m = gw; m < S; m += NGW) { const f32x4* s = (const f32x4*)(P.in[0] + (size_t)m * D) + lane; f32x4* d = (f32x4*)(X + (size_t)m * D) + lane;
#pragma unroll
            for (int j = 0; j < 4; ++j) d[64 * j] = s[64 * j]; }
        if (bid == 0) for (int i = tid; i < 2 * D / 2; i += 512) ((unsigned*)HNA)[i] = 0u;
    }
    grid.sync();

#pragma unroll 1
    for (int L = 0; L < 4; ++L) {
        const int e = L >> 1;
        if ((L & 1) == 0) {
            for (int rep_ = 0; rep_ < 1 + (int)((REPMASK >> 1) & 1u); ++rep_) { PHASE_IDS
                const float* gmix = P.in[2] + L * D; const float* Win = P.in[4] + (size_t)e * 1024 * 2568; const float* bfg = P.in[5] + e * 8;
                f32x4 wfa[16], wfb[16];
#pragma unroll
                for (int j = 0; j < 4; ++j)
#pragma unroll
                    for (int i = 0; i < 4; ++i) { const float* wp = Win + (size_t)(4 * lane + 256 * j + i) * 2568 + 2560; wfa[j * 4 + i] = *(const f32x4*)wp; wfb[j * 4 + i] = *(const f32x4*)(wp + 4); }
                float bb[8];
#pragma unroll
                for (int h = 0; h < 8; ++h) bb[h] = bfg[h];
                for (int gi = gw; gi < 2048; gi += NGW) {
                    float cum[8];
#pragma unroll
                    for (int h = 0; h < 8; ++h) cum[h] = 0.f;
#pragma unroll 1
                    for (int rr = 0; rr < 8; ++rr) {
                        const int t = 8 * gi + rr; f32x4 v[4]; const float rs = load_row(X + (size_t)t * D, lane, v);
                        f32x4 fa = (f32x4){0.f, 0.f, 0.f, 0.f}, fb = fa;
#pragma unroll
                        for (int j = 0; j < 4; ++j) { const f32x4 gg = *((const f32x4*)gmix + lane + 64 * j); v[j] = v[j] * rs * gg;
                            *((u32x2*)(HN + (size_t)t * D) + lane + 64 * j) = pack4(v[j]);
#pragma unroll
                            for (int i = 0; i < 4; ++i) { fa += wfa[j * 4 + i] * v[j][i]; fb += wfb[j * 4 + i] * v[j][i]; } }
                        float f[8] = {fa[0], fa[1], fa[2], fa[3], fb[0], fb[1], fb[2], fb[3]};
#pragma unroll
                        for (int h = 0; h < 8; ++h) { const float z = wave_sum(f[h]) + bb[h]; const float ls = z >= 0.f ? -log1pf(expf(-z)) : z - log1pf(expf(z)); cum[h] += ls * LOG2E; }
                        if (lane == 0) { *(f32x4*)(CL + (size_t)t * 8) = (f32x4){cum[0], cum[1], cum[2], cum[3]}; *(f32x4*)(CL + (size_t)t * 8 + 4) = (f32x4){cum[4], cum[5], cum[6], cum[7]}; }
                    }
                    if (lane == 0) { *(f32x4*)(GT + (size_t)gi * 8) = (f32x4){cum[0], cum[1], cum[2], cum[3]}; *(f32x4*)(GT + (size_t)gi * 8 + 4) = (f32x4){cum[4], cum[5], cum[6], cum[7]}; }
                }
            }
            GSYNC();
            for (int rep_ = 0; rep_ < 1 + (int)((REPMASK >> 2) & 1u); ++rep_) { PHASE_IDS
                pg8::Gemm g{HN, (const bf16_t*)(ws + WS_WIN) + (size_t)e * 2560 * 1024, 1024, 1024, 256};
                pg8::StaticOrder so; so.init(64, 10, G, bid);
                pg8::EpiStore E{(bf16_t*)(R + R_Z), ZW, 1};
                pg8::gemm_phase(lds, g, so, E);
            }
            GSYNC();
            for (int rep_ = 0; rep_ < 1 + (int)((REPMASK >> 3) & 1u); ++rep_) { PHASE_IDS
                bf16_t* Z = (bf16_t*)(R + R_Z);
                const float* gq = P.in[6] + e * 64; const float* gk = P.in[7] + e * 64;
                LAS float* red = (LAS float*)lds;
                for (int ck = bid; ck < 256; ck += G) {
                    { const int h = tid & 7, part = tid >> 3; float s = 0.f;
                      for (int gi = part; gi < 8 * ck; gi += 64) s += GT[(size_t)gi * 8 + h];
                      s += __shfl_xor(s, 8); s += __shfl_xor(s, 16); s += __shfl_xor(s, 32);
                      __syncthreads();
                      if (lane < 8) red[wid * 8 + lane] = s;
                      __syncthreads();
                      const int tok = tid >> 3; float off = 0.f;
#pragma unroll
                      for (int w = 0; w < 8; ++w) off += red[w * 8 + h];
                      const int gl = tok >> 3;
                      for (int i2 = 0; i2 < gl; ++i2) off += GT[(size_t)(8 * ck + i2) * 8 + h];
                      const int t = 64 * ck + tok; CGm[(size_t)t * 8 + h] = CL[(size_t)t * 8 + h] + off; }
#pragma unroll 1
                    for (int ps = 0; ps < 16; ++ps) {
                        const int pair = ps * 64 + (tid >> 3), sub = tid & 7; const int tok = pair >> 4, hh = (pair >> 1) & 7, isk = pair & 1;
                        bf16_t* ptr = Z + (size_t)(64 * ck + tok) * ZW + (isk ? 1536 : 512) + hh * 64 + sub * 8;
                        const u32x4 w = *(const u32x4*)ptr; float v[8];
                        v[0] = bf2f(w.x & 0xffffu); v[1] = bf2f(w.x >> 16); v[2] = bf2f(w.y & 0xffffu); v[3] = bf2f(w.y >> 16); v[4] = bf2f(w.z & 0xffffu); v[5] = bf2f(w.z >> 16); v[6] = bf2f(w.w & 0xffffu); v[7] = bf2f(w.w >> 16);
                        float ss = 0.f;
#pragma unroll
                        for (int i = 0; i < 8; ++i) ss += v[i] * v[i];
                        ss += __shfl_xor(ss, 1); ss += __shfl_xor(ss, 2); ss += __shfl_xor(ss, 4);
                        const float rs = (1.0f / sqrtf(ss * (1.f / 64.f) + EPS)) * (isk ? 1.f : 0.125f * LOG2E);
                        const float* gp = (isk ? gk : gq) + sub * 8;
#pragma unroll
                        for (int i = 0; i < 8; ++i) v[i] = v[i] * rs * gp[i];
                        u32x4 o; o.x = cvt_pk_bf16(v[0], v[1]); o.y = cvt_pk_bf16(v[2], v[3]); o.z = cvt_pk_bf16(v[4], v[5]); o.w = cvt_pk_bf16(v[6], v[7]);
                        *(u32x4*)ptr = o;
                    }
                }
                LAS bf16_t* Wsm = (LAS bf16_t*)lds; LAS bf16_t* VT = (LAS bf16_t*)(lds + 34816);
                const float* wsp = P.in[9] + (size_t)e * 4 * 128 * 128; const float* bsp = P.in[10] + e * 512; const float* vg = P.in[8] + e * 512;
                for (int it = bid; it < 512; it += G) {
                    const int n = it >> 2, g = it & 3;
                    __syncthreads();
                    for (int idx = tid; idx < 128 * 32; idx += 512) { const int t = idx >> 5, s4 = (idx & 31) * 4; f32x4 w = *(const f32x4*)(wsp + ((size_t)g * 128 + t) * 128 + s4);
#pragma unroll
                        for (int i = 0; i < 4; ++i) if (s4 + i > t) w[i] = 0.f;
                        *(LAS u32x2*)(Wsm + t * 136 + s4) = pack4(w); }
                    { const int tok = tid >> 2, part = tid & 3; const bf16_t* vp = Z + (size_t)(128 * n + tok) * ZW + 1024 + g * 128 + part * 32;
                      float v[32]; float ss = 0.f;
#pragma unroll
                      for (int q = 0; q < 4; ++q) { const u32x4 w = *(const u32x4*)(vp + q * 8);
                          v[q * 8 + 0] = bf2f(w.x & 0xffffu); v[q * 8 + 1] = bf2f(w.x >> 16); v[q * 8 + 2] = bf2f(w.y & 0xffffu); v[q * 8 + 3] = bf2f(w.y >> 16);
                          v[q * 8 + 4] = bf2f(w.z & 0xffffu); v[q * 8 + 5] = bf2f(w.z >> 16); v[q * 8 + 6] = bf2f(w.w & 0xffffu); v[q * 8 + 7] = bf2f(w.w >> 16); }
#pragma unroll
                      for (int i = 0; i < 32; ++i) ss += v[i] * v[i];
                      ss += __shfl_xor(ss, 1); ss += __shfl_xor(ss, 2);
                      const float rs = 1.0f / sqrtf(ss * (1.f / 128.f) + EPS);
#pragma unroll
                      for (int i = 0; i < 32; ++i) { const int c = part * 32 + i; const float y = v[i] * rs * vg[g * 128 + c]; VT[c * 136 + tok] = (bf16_t)(cvt_pk_bf16(y, 0.f) & 0xffffu); } }
                    __syncthreads();
                    const int l15 = lane & 15, quad = lane >> 4;
                    f32x4 acc[8];
#pragma unroll
                    for (int cb = 0; cb < 8; ++cb) acc[cb] = (f32x4){0.f, 0.f, 0.f, 0.f};
                    for (int ks = 0; ks <= (wid >> 1); ++ks) {
                        const bf16x8 a = *(const LAS bf16x8*)(Wsm + (16 * wid + l15) * 136 + 32 * ks + quad * 8);
#pragma unroll
                        for (int cb = 0; cb < 8; ++cb) { const bf16x8 b = *(const LAS bf16x8*)(VT + (16 * cb + l15) * 136 + 32 * ks + quad * 8);
                            acc[cb] = __builtin_amdgcn_mfma_f32_16x16x32_bf16(b, a, acc[cb], 0, 0, 0); }
                    }
                    const int t = 16 * wid + l15; const float bs = bsp[g * 128 + t];
                    bf16_t* up = Z + (size_t)(128 * n + t) * ZW + g * 128 + quad * 4;
#pragma unroll
                    for (int cb = 0; cb < 8; ++cb) { const f32x4 uu = unpack4(*(const u32x2*)(up + 16 * cb)); f32x4 y = uu * (acc[cb] + bs); *(u32x2*)(up + 16 * cb) = pack4(y); }
                }
            }
            GSYNC();
            for (int rep_ = 0; rep_ < 1 + (int)((REPMASK >> 4) & 1u); ++rep_) { PHASE_IDS
                bf16_t* Z = (bf16_t*)(R + R_Z);
                LAS bf16_t* Ks = (LAS bf16_t*)lds; LAS bf16_t* VT = (LAS bf16_t*)(lds + 9216); LAS float* Ck = (LAS float*)(lds + 18432);
                const int l15 = lane & 15, quad = lane >> 4;
                const float Gq = wave_max(fabsf(P.in[6][e * 64 + lane])), Gk = wave_max(fabsf(P.in[7][e * 64 + lane]));
                const float thr = -(40.f + 2.f * 8.f * Gq * Gk * LOG2E);
                for (int item = bid; item < 1024; item += G) {
                    const int qb = 127 - (item >> 3), h = item & 7; const int q0 = 128 * qb, qw = q0 + 16 * wid;
                    const bf16_t* Qp = Z + (size_t)(qw + l15) * ZW + 512 + 64 * h;
                    const bf16x8 qf0 = *(const bf16x8*)(Qp + quad * 8), qf1 = *(const bf16x8*)(Qp + 32 + quad * 8);
                    const float c2q = CGm[(size_t)(qw + l15) * 8 + h], c2q0 = CGm[(size_t)q0 * 8 + h];
                    float mrun = -1e30f, lrun = 0.f; f32x4 o[4];
#pragma unroll
                    for (int db = 0; db < 4; ++db) o[db] = (f32x4){0.f, 0.f, 0.f, 0.f};
                    int j = 2 * qb + 1;
                    u32x4 kreg = *(const u32x4*)(Z + (size_t)(64 * j + (tid >> 3)) * ZW + 1536 + 64 * h + (tid & 7) * 8);
                    u32x4 vreg = *(const u32x4*)(Z + (size_t)(64 * j + lane) * ZW + 2048 + 64 * h + wid * 8);
                    float ckreg = CGm[(size_t)(64 * j + lane) * 8 + h];
                    for (; j >= 0; --j) {
                        __syncthreads();
                        *(LAS u32x4*)(Ks + (tid >> 3) * 72 + (tid & 7) * 8) = kreg;
                        { LAS bf16_t* vt = VT + (wid * 8) * 72 + lane;
                          vt[0 * 72] = (bf16_t)(vreg.x & 0xffffu); vt[1 * 72] = (bf16_t)(vreg.x >> 16); vt[2 * 72] = (bf16_t)(vreg.y & 0xffffu); vt[3 * 72] = (bf16_t)(vreg.y >> 16);
                          vt[4 * 72] = (bf16_t)(vreg.z & 0xffffu); vt[5 * 72] = (bf16_t)(vreg.z >> 16); vt[6 * 72] = (bf16_t)(vreg.w & 0xffffu); vt[7 * 72] = (bf16_t)(vreg.w >> 16); }
                        if (wid == 0) Ck[lane] = ckreg;
                        __syncthreads();
                        if (j > 0) {
                            kreg = *(const u32x4*)(Z + (size_t)(64 * (j - 1) + (tid >> 3)) * ZW + 1536 + 64 * h + (tid & 7) * 8);
                            vreg = *(const u32x4*)(Z + (size_t)(64 * (j - 1) + lane) * ZW + 2048 + 64 * h + wid * 8);
                            ckreg = CGm[(size_t)(64 * (j - 1) + lane) * 8 + h];
                        }
                        if (64 * j + 63 < q0 && (c2q0 - Ck[63]) < thr) break;
                        if (64 * j > qw + 15) continue;
                        f32x4 s[4];
#pragma unroll
                        for (int kb = 0; kb < 4; ++kb) {
                            const LAS bf16_t* kp = Ks + (16 * kb + l15) * 72 + quad * 8;
                            const bf16x8 k0 = *(const LAS bf16x8*)kp, k1 = *(const LAS bf16x8*)(kp + 32);
                            f32x4 z = (f32x4){0.f, 0.f, 0.f, 0.f};
                            z = __builtin_amdgcn_mfma_f32_16x16x32_bf16(k0, qf0, z, 0, 0, 0);
                            z = __builtin_amdgcn_mfma_f32_16x16x32_bf16(k1, qf1, z, 0, 0, 0);
                            const f32x4 ck4 = *(const LAS f32x4*)(Ck + 16 * kb + quad * 4);
                            s[kb] = z + (c2q - ck4);
                        }
                        if (64 * j + 63 > qw) {
#pragma unroll
                            for (int kb = 0; kb < 4; ++kb)
#pragma unroll
                                for (int jj = 0; jj < 4; ++jj) if (64 * j + 16 * kb + 4 * quad + jj > qw + l15) s[kb][jj] = -1e30f;
                        }
                        float mx = -1e30f;
#pragma unroll
                        for (int kb = 0; kb < 4; ++kb) mx = fmaxf(fmaxf(mx, fmaxf(s[kb][0], s[kb][1])), fmaxf(s[kb][2], s[kb][3]));
                        mx = fmaxf(mx, __shfl_xor(mx, 16)); mx = fmaxf(mx, __shfl_xor(mx, 32));
                        const float mn = fmaxf(mrun, mx); const float alpha = __builtin_amdgcn_exp2f(mrun - mn); mrun = mn;
                        float ls = 0.f;
#pragma unroll
                        for (int kb = 0; kb < 4; ++kb)
#pragma unroll
                            for (int jj = 0; jj < 4; ++jj) { s[kb][jj] = __builtin_amdgcn_exp2f(s[kb][jj] - mn); ls += s[kb][jj]; }
                        lrun = lrun * alpha + ls;
#pragma unroll
                        for (int db = 0; db < 4; ++db) o[db] = o[db] * alpha;
#pragma unroll
                        for (int kk = 0; kk < 2; ++kk) {
                            u32x4 pw; pw.x = cvt_pk_bf16(s[2 * kk][0], s[2 * kk][1]); pw.y = cvt_pk_bf16(s[2 * kk][2], s[2 * kk][3]); pw.z = cvt_pk_bf16(s[2 * kk + 1][0], s[2 * kk + 1][1]); pw.w = cvt_pk_bf16(s[2 * kk + 1][2], s[2 * kk + 1][3]);
                            const bf16x8 pb = __builtin_bit_cast(bf16x8, pw);
#pragma unroll
                            for (int db = 0; db < 4; ++db) {
                                const LAS bf16_t* vp = VT + (16 * db + l15) * 72 + 32 * kk + quad * 4;
                                u32x4 vw; const u32x2 va = *(const LAS u32x2*)vp, vb = *(const LAS u32x2*)(vp + 16); vw.x = va.x; vw.y = va.y; vw.z = vb.x; vw.w = vb.y;
                                o[db] = __builtin_amdgcn_mfma_f32_16x16x32_bf16(__builtin_bit_cast(bf16x8, vw), pb, o[db], 0, 0, 0);
                            }
                        }
                    }
                    lrun += __shfl_xor(lrun, 16); lrun += __shfl_xor(lrun, 32);
                    const float inv = 1.0f / lrun;
                    bf16_t* Op = (rep_ ? (bf16_t*)(R + 80 * MiB) : Z) + (size_t)(qw + l15) * ZW + 512 + 64 * h + 4 * quad;
#pragma unroll
                    for (int db = 0; db < 4; ++db) *(u32x2*)(Op + 16 * db) = pack4(o[db] * inv);
                }
            }
            GSYNC();
            for (int rep_ = 0; rep_ < 1 + (int)((REPMASK >> 5) & 1u); ++rep_) { PHASE_IDS
                pg8::Gemm g{(const bf16_t*)(R + R_Z), (const bf16_t*)(ws + WS_WOUT) + (size_t)e * 1024 * 1024, 1024, ZW, 256};
                pg8::StaticOrder so; so.init(64, 4, G, bid);
                pg8::EpiRes E{X};
                pg8::gemm_phase(lds, g, so, E);
            }
            GSYNC();
        } else {
            for (int rep_ = 0; rep_ < 1 + (int)((REPMASK >> 6) & 1u); ++rep_) { PHASE_IDS
                bf16_t* AG = (bf16_t*)(R + R_AG); bf16_t* TS = (bf16_t*)(R + R_TS); bf16_t* PS = (bf16_t*)(R + R_PS);
                const float* gmix = P.in[2] + L * D;
                for (int t = gw; t < S; t += NGW) { f32x4 v[4]; const float rs = load_row(X + (size_t)t * D, lane, v);
#pragma unroll
                    for (int j = 0; j < 4; ++j) { const f32x4 gg = *((const f32x4*)gmix + lane + 64 * j); v[j] = v[j] * rs * gg; const int d = 4 * lane + 256 * j; const int g = d >> 4, c = d & 15;
                        *(u32x2*)(AG + (size_t)(g * 512 + (t >> 5)) * 640 + (t & 31) * 16 + c) = pack4(v[j]); } }
                const float* a_re = P.in[12] + e * 4096; const float* a_im = P.in[13] + e * 4096; const float* ldt = P.in[14] + e * 64;
                const float* b_re = P.in[15] + (size_t)e * 65536; const float* b_im = P.in[16] + (size_t)e * 65536; const float* c_re = P.in[17] + (size_t)e * 65536; const float* c_im = P.in[18] + (size_t)e * 65536;
                LAS float* Wr = (LAS float*)lds; LAS float* Wi = Wr + 64; LAS float* Pr = Wr + 128; LAS float* Pi = Wr + 192;
                for (int it = bid; it < 2048; it += G) {
                    const int g = it >> 5, j = it & 31;
                    __syncthreads();
                    if (tid < 64) { const int p = tid; const float dt = expf(ldt[g]), lr = a_re[g * 64 + p], li = a_im[g * 64 + p];
                        float s1, c1; sincosf(li * dt, &s1, &c1); const float e1 = expf(lr * dt); const float abr = e1 * c1, abi = e1 * s1;
                        const float den = lr * lr + li * li, nr = abr - 1.0f, ni = abi; const float cr = (nr * lr + ni * li) / den, ci = (ni * lr - nr * li) / den;
                        float sj, cj; sincosf((float)j * (li * dt), &sj, &cj); const float ej = expf((float)j * (lr * dt)); const float ajr = ej * cj, aji = ej * sj;
                        Wr[p] = ajr * cr - aji * ci; Wi[p] = ajr * ci + aji * cr;
                        float sp, cp; sincosf((float)(j + 1) * (li * dt), &sp, &cp); const float ep = expf((float)(j + 1) * (lr * dt)); Pr[p] = ep * cp; Pi[p] = ep * sp; }
                    __syncthreads();
                    if (tid < 256) { const int c = tid >> 4, cq = tid & 15; float acc = 0.f;
                        for (int p = 0; p < 64; ++p) { const float Cr = c_re[((size_t)g * 16 + c) * 64 + p], Ci = c_im[((size_t)g * 16 + c) * 64 + p]; const float wr_ = Wr[p], wi_ = Wi[p];
                            const float cwr = Cr * wr_ - Ci * wi_, cwi = Cr * wi_ + Ci * wr_; const float br = b_re[((size_t)g * 64 + p) * 16 + cq], bi = b_im[((size_t)g * 64 + p) * 16 + cq];
                            acc += cwr * br - cwi * bi; }
                        const bf16_t kv = (bf16_t)(cvt_pk_bf16(acc, 0.f) & 0xffffu);
                        for (int s = 0; s + j < 32; ++s) { TS[(size_t)(g * 512 + (j + s) * 16 + c) * 640 + s * 16 + cq] = kv; if (j >= 1) TS[(size_t)(g * 512 + s * 16 + c) * 640 + (s + j) * 16 + cq] = 0; }
                    } else {
#pragma unroll 1
                        for (int k = 0; k < 8; ++k) { const int idx = (tid - 256) + 256 * k; const int c = idx >> 7, rp = idx & 127, p = rp & 63;
                            const float Cr = c_re[((size_t)g * 16 + c) * 64 + p], Ci = c_im[((size_t)g * 16 + c) * 64 + p];
                            const float val = (rp < 64) ? (Cr * Pr[p] - Ci * Pi[p]) : -(Cr * Pi[p] + Ci * Pr[p]);
                            TS[(size_t)(g * 512 + j * 16 + c) * 640 + 512 + rp] = (bf16_t)(cvt_pk_bf16(val, 0.f) & 0xffffu); }
                    }
                    { const int s = 31 - j;
#pragma unroll 1
                      for (int k = 0; k < 4; ++k) { const int idx = tid + 512 * k; const int rp = idx >> 4, cq = idx & 15, p = rp & 63;
                          const float br = b_re[((size_t)g * 64 + p) * 16 + cq], bi = b_im[((size_t)g * 64 + p) * 16 + cq];
                          const float val = (rp < 64) ? (Wr[p] * br - Wi[p] * bi) : (Wr[p] * bi + Wi[p] * br);
                          PS[(size_t)(g * 256 + rp) * 512 + s * 16 + cq] = (bf16_t)(cvt_pk_bf16(val, 0.f) & 0xffffu);
                          PS[(size_t)(g * 256 + 128 + rp) * 512 + s * 16 + cq] = 0; } }
                }
            }
            GSYNC();
            for (int rep_ = 0; rep_ < 1 + (int)((REPMASK >> 7) & 1u); ++rep_) { PHASE_IDS
                pg8::Gemm g{(const bf16_t*)(R + R_AG), (const bf16_t*)(R + R_PS), 512, 640, 256};
                pg8::OrderS5E so{G, bid};
                pg8::EpiE E{(float*)(R + R_E)};
                pg8::gemm_phase(lds, g, so, E);
            }
            GSYNC();
            for (int rep_ = 0; rep_ < 1 + (int)((REPMASK >> 8) & 1u); ++rep_) { PHASE_IDS
                bf16_t* AG = (bf16_t*)(R + R_AG); const float* Eb = (const float*)(R + R_E);
                const float* a_re = P.in[12] + e * 4096; const float* a_im = P.in[13] + e * 4096; const float* ldt = P.in[14] + e * 64;
                LAS float* Tr = (LAS float*)lds; LAS float* Ti = Tr + 512;
                for (int g = bid; g < 64; g += G) {
                    const int p = lane, seg = wid;
                    const float dt = expf(ldt[g]), lr = a_re[g * 64 + p], li = a_im[g * 64 + p];
                    float sA, cA; sincosf(32.f * (li * dt), &sA, &cA); const float eA = expf(32.f * (lr * dt)); const float ar = eA * cA, ai = eA * sA;
                    float sB, cB; sincosf(2048.f * (li * dt), &sB, &cB); const float eB = expf(2048.f * (lr * dt)); const float br = eB * cB, bi = eB * sB;
                    float xr = 0.f, xi = 0.f;
#pragma unroll 8
                    for (int n = 64 * seg; n < 64 * seg + 64; ++n) { const float er = Eb[(size_t)(g * 512 + n) * 128 + p], ei = Eb[(size_t)(g * 512 + n) * 128 + 64 + p];
                        const float nr = ar * xr - ai * xi + er, ni = ar * xi + ai * xr + ei; xr = nr; xi = ni; }
                    __syncthreads();
                    Tr[seg * 64 + p] = xr; Ti[seg * 64 + p] = xi;
                    __syncthreads();
                    xr = 0.f; xi = 0.f;
                    for (int s2 = 0; s2 < seg; ++s2) { const float nr = br * xr - bi * xi + Tr[s2 * 64 + p], ni = br * xi + bi * xr + Ti[s2 * 64 + p]; xr = nr; xi = ni; }
#pragma unroll 8
                    for (int n = 64 * seg; n < 64 * seg + 64; ++n) { const float er = Eb[(size_t)(g * 512 + n) * 128 + p], ei = Eb[(size_t)(g * 512 + n) * 128 + 64 + p];
                        bf16_t* sp = AG + (size_t)(g * 512 + n) * 640 + 512 + p; sp[0] = (bf16_t)(cvt_pk_bf16(xr, 0.f) & 0xffffu); sp[64] = (bf16_t)(cvt_pk_bf16(xi, 0.f) & 0xffffu);
                        const float nr = ar * xr - ai * xi + er, ni = ar * xi + ai * xr + ei; xr = nr; xi = ni; }
                }
            }
            GSYNC();
            for (int rep_ = 0; rep_ < 1 + (int)((REPMASK >> 9) & 1u); ++rep_) { PHASE_IDS
                pg8::Gemm g{(const bf16_t*)(R + R_AG), (const bf16_t*)(R + R_TS), 640, 640, 256};
                pg8::OrderS5Y so{G, bid};
                pg8::EpiY E{(const bf16_t*)(R + R_AG), P.in[19] + e * D, (bf16_t*)(R + R_G)};
                pg8::gemm_phase(lds, g, so, E);
            }
            GSYNC();
            for (int rep_ = 0; rep_ < 1 + (int)((REPMASK >> 10) & 1u); ++rep_) { PHASE_IDS
                pg8::Gemm g{(const bf16_t*)(R + R_G), (const bf16_t*)(ws + WS_WGLU) + (size_t)e * 2048 * 1024, 1024, 1024, 256};
                pg8::StaticOrder so; so.init(64, 8, G, bid);
                pg8::EpiGlu E{X};
                pg8::gemm_phase(lds, g, so, E);
            }
            GSYNC();
        }
        for (int rep_ = 0; rep_ < 1 + (int)((REPMASK >> 11) & 1u); ++rep_) { PHASE_IDS
            const float* gf = P.in[3] + L * D;
            for (int t = gw; t < S; t += NGW) { f32x4 v[4]; const float rs = load_row(X + (size_t)t * D, lane, v);
#pragma unroll
                for (int j = 0; j < 4; ++j) { const f32x4 gg = *((const f32x4*)gf + lane + 64 * j); *((u32x2*)(HN + (size_t)t * D) + lane + 64 * j) = pack4(v[j] * rs * gg); } }
        }
        GSYNC();
        for (int rep_ = 0; rep_ < 1 + (int)((REPMASK >> 12) & 1u); ++rep_) { PHASE_IDS
            pg8::Gemm g{HNA, (const bf16_t*)(ws + WS_WUP) + (size_t)L * 5632 * 1024, 1024, 1024, 254};
            pg8::StaticOrder so; so.init(65, 22, G, bid);
            pg8::EpiConv E{(bf16_t*)(R + R_ACT), P.in[22] + (size_t)L * 3 * 5632, P.in[23] + (size_t)L * 5632, lds + XL_OFF};
            pg8::gemm_phase(lds, g, so, E);
        }
        GSYNC();
        for (int rep_ = 0; rep_ < 1 + (int)((REPMASK >> 13) & 1u); ++rep_) { PHASE_IDS
            pg8::Gemm g{(const bf16_t*)(R + R_ACT), (const bf16_t*)(ws + WS_WDN) + (size_t)L * 1024 * 2816, 2816, 2816, 256};
            pg8::StaticOrder so; so.init(64, 4, G, bid);
            pg8::EpiRes E{X};
            pg8::gemm_phase(lds, g, so, E);
        }
        GSYNC();
        for (int rep_ = 0; rep_ < 1 + (int)((REPMASK >> 14) & 1u); ++rep_) { PHASE_IDS
            const float* pin = P.in[1] + (size_t)L * S * 256; bf16_t* PB = (bf16_t*)(R + R_PB);
            for (int t = gw; t < S; t += NGW) { f32x4 v[4]; const float rs = load_row(X + (size_t)t * D, lane, v);
#pragma unroll
                for (int j = 0; j < 4; ++j) *((u32x2*)(HN + (size_t)t * D) + lane + 64 * j) = pack4(v[j] * rs);
                const f32x4 pv = *((const f32x4*)(pin + (size_t)t * 256) + lane); *((u32x2*)(PB + (size_t)t * 256) + lane) = pack4(pv); }
        }
        GSYNC();
        for (int rep_ = 0; rep_ < 1 + (int)((REPMASK >> 15) & 1u); ++rep_) { PHASE_IDS
            pg8::StaticOrder so; so.init(64, 4, G, bid);
            { pg8::Gemm g{(const bf16_t*)(R + R_PB), (const bf16_t*)(ws + WS_WPR) + (size_t)L * 1024 * 256, 256, 256, 256};
              pg8::EpiStore E{(bf16_t*)(R + R_PP), D, 0};
              pg8::gemm_phase(lds, g, so, E); }
            asm volatile("s_waitcnt vmcnt(0)" ::: "memory"); __syncthreads();
            { pg8::Gemm g{HN, (const bf16_t*)(ws + WS_WGT) + (size_t)L * 1024 * 1024, 1024, 1024, 256};
              pg8::EpiGate E{X, (const bf16_t*)(R + R_PP)};
              pg8::gemm_phase(lds, g, so, E); }
        }
        GSYNC();
        for (int xs = 0; xs < XSYNC; ++xs) GSYNC();
    }
}

extern "C" void kernel_launch(void* const* d_in, const int* in_sizes, int n_in, void* d_out, int out_size, void* d_ws, size_t ws_size, hipStream_t stream) {
    static int grid = 0;
    if (grid == 0) {
        if (n_in != 27 || out_size != S * D || ws_size < WS_END) { fprintf(stderr, "kernel_launch: unexpected shapes (n_in %d out %d ws %zu need %zu)\n", n_in, out_size, ws_size, (size_t)WS_END); grid = -1; return; }
        int dev = 0, cus = 0, per_cu = 0;
        hipGetDevice(&dev); hipDeviceGetAttribute(&cus, hipDeviceAttributeMultiprocessorCount, dev);
        hipFuncSetAttribute((const void*)mega, hipFuncAttributeMaxDynamicSharedMemorySize, LDS_BYTES);
        hipOccupancyMaxActiveBlocksPerMultiprocessor(&per_cu, (const void*)mega, 512, LDS_BYTES);
        if (per_cu < 1) per_cu = 1;
        grid = cus * per_cu;
    }
    if (grid < 0) return;
    Params p{};
    for (int i = 0; i < 27; ++i) p.in[i] = (const float*)d_in[i];
    p.out = (float*)d_out; p.ws = (unsigned char*)d_ws;
    hipMemsetAsync((char*)d_ws + WS_BAR, 0, BAR_BYTES, stream);
    void* args[] = {&p};
    hipError_t err = hipLaunchCooperativeKernel((const void*)mega, dim3(grid), dim3(512), args, LDS_BYTES, stream);
    if (err != hipSuccess) fprintf(stderr, "cooperative launch failed: %s (grid %d)\n", hipGetErrorString(err), grid);
}
```

```cpp
#include <hip/hip_runtime.h>
#include <hip/hip_cooperative_groups.h>
#include <cstdio>
#include <cstdint>
namespace cg = cooperative_groups;

#define LAS __attribute__((address_space(3)))
typedef unsigned short bf16_t;
typedef short bf16x8 __attribute__((ext_vector_type(8)));
typedef float f32x4 __attribute__((ext_vector_type(4)));
typedef unsigned u32x4 __attribute__((ext_vector_type(4)));
typedef unsigned u32x2 __attribute__((ext_vector_type(2)));

constexpr int S = 16384, D = 1024, FF = 2816, ZW = 2560;
constexpr float EPS = 1e-6f;
constexpr float LOG2E = 1.4426950408889634f;

__device__ __forceinline__ unsigned cvt_pk_bf16(float lo, float hi) { unsigned r; asm volatile("v_cvt_pk_bf16_f32 %0, %1, %2" : "=v"(r) : "v"(lo), "v"(hi)); return r; }
__device__ __forceinline__ float bf2f(unsigned b) { return __uint_as_float(b << 16); }
__device__ __forceinline__ float sigm(float z) { return __builtin_amdgcn_rcpf(1.f + __builtin_amdgcn_exp2f(-LOG2E * z)); }
__device__ __forceinline__ float gelu_t(float x) { const float z = 1.5957691216057308f * (x + 0.044715f * x * x * x); return x * sigm(z); }
__device__ __forceinline__ u32x2 pack4(f32x4 v) { u32x2 w; w.x = cvt_pk_bf16(v[0], v[1]); w.y = cvt_pk_bf16(v[2], v[3]); return w; }
__device__ __forceinline__ f32x4 unpack4(u32x2 w) { return (f32x4){bf2f(w.x & 0xffffu), bf2f(w.x >> 16), bf2f(w.y & 0xffffu), bf2f(w.y >> 16)}; }
__device__ __forceinline__ float wave_sum(float v) {
#pragma unroll
    for (int o = 1; o < 64; o <<= 1) v += __shfl_xor(v, o);
    return v;
}
__device__ __forceinline__ float wave_max(float v) {
#pragma unroll
    for (int o = 1; o < 64; o <<= 1) v = fmaxf(v, __shfl_xor(v, o));
    return v;
}

__device__ __forceinline__ float quad_max(float v) {
    auto a = __builtin_amdgcn_permlane16_swap(__float_as_uint(v), __float_as_uint(v), false, false); v = fmaxf(__uint_as_float(a[0]), __uint_as_float(a[1]));
    auto b = __builtin_amdgcn_permlane32_swap(__float_as_uint(v), __float_as_uint(v), false, false); return fmaxf(__uint_as_float(b[0]), __uint_as_float(b[1]));
}
__device__ __forceinline__ float quad_sum(float v) {
    auto a = __builtin_amdgcn_permlane16_swap(__float_as_uint(v), __float_as_uint(v), false, false); v = __uint_as_float(a[0]) + __uint_as_float(a[1]);
    auto b = __builtin_amdgcn_permlane32_swap(__float_as_uint(v), __float_as_uint(v), false, false); return __uint_as_float(b[0]) + __uint_as_float(b[1]);
}

namespace pg8 {
constexpr int BM = 256, BK = 64, HALF = 128, HTB = HALF * BK * 2, STAGE_BYTES = 8 * HTB, NXCD = 8, WGM = 8;
__host__ __device__ __forceinline__ int lds_byte(int r, int c) { const int st = (r >> 4) * 2 + (c >> 5), rr = r & 15, cc = c & 31, ob = rr * 64 + cc * 2; return st * 1024 + (ob ^ (((ob >> 9) & 1) << 5)); }
__host__ __device__ __forceinline__ void stage_rc(int b, int& R, int& C) { const int st = b / 1024, sb = b % 1024, swz = sb ^ (((sb >> 9) & 1) << 5); R = (st >> 1) * 16 + swz / 64; C = (st & 1) * 32 + (swz % 64) / 2; }
struct Unit { int pm, pn; };
struct Gemm { const bf16_t* A; const bf16_t* Bt; int K, lda, arows; };

struct StaticOrder {
    int nM, nN, nwg, G, c;
    __device__ void init(int nM_, int nN_, int G_, int c_) { nM = nM_; nN = nN_; nwg = nM * nN; G = G_; c = c_; }
    __device__ bool next(int i, Unit& u) const {
        const long L = (long)i * G + c; if (L >= nwg) return false;
        int wgid = (int)L; { const int q = nwg / NXCD, r = nwg % NXCD, xcd = wgid % NXCD, off = wgid / NXCD; wgid = (xcd < r ? xcd * (q + 1) : r * (q + 1) + (xcd - r) * q) + off; }
        const int nig = WGM * nN, gid = wgid / nig, fm = gid * WGM, gsz = (nM - fm) < WGM ? (nM - fm) : WGM;
        u.pm = fm + ((wgid % nig) % gsz); u.pn = (wgid % nig) / gsz; return true;
    }
};
struct OrderS5E { int G, c; __device__ bool next(int i, Unit& u) const { const int L = i * G + c; if (L >= 128) return false; u.pm = L; u.pn = L >> 1; return true; } };
struct OrderS5Y { int G, c; __device__ bool next(int i, Unit& u) const { const int L = i * G + c; if (L >= 256) return false; const int g = L >> 2; u.pm = 2 * g + ((L >> 1) & 1); u.pn = 2 * g + (L & 1); return true; } };

template <class Epi, class Sched>
__device__ __forceinline__ void gemm_phase(LAS unsigned char* lds, const Gemm g, const Sched& S, const Epi& E) {
    int tid_ = threadIdx.x; asm volatile("" : "+v"(tid_));
    const int tid = tid_, wid = __builtin_amdgcn_readfirstlane(tid >> 6), lane = tid & 63, wr = wid >> 2, wc = wid & 3, fr = lane & 15, fq = lane >> 4;
    const int K = g.K, nt = K / BK, lda = g.lda;
    unsigned voffA[2], voffB[2];
#pragma unroll
    for (int i = 0; i < 2; ++i) { int R, C; stage_rc(tid * 16 + i * 8192, R, C); voffA[i] = (unsigned)(R * lda + C) * 2u; voffB[i] = (unsigned)(R * K + C) * 2u; }
    const size_t kstep = (size_t)(BK * 2);
    const size_t hstepA = (size_t)HALF * lda * 2, hstepB = (size_t)HALF * K * 2;
    const size_t tstepA = (size_t)g.arows * lda * 2, tstepB = 2 * hstepB;
    const unsigned ldsw = (unsigned)wid * 1024u;
    const int aoff = lds_byte(wr * 64 + fr, fq * 8), boff = lds_byte(wc * 32 + fr, fq * 8);
#define PG8_SA(b, h) (((b) * 2 + (h)) * HTB)
#define PG8_SB(b, h) ((4 + (b) * 2 + (h)) * HTB)
#define PG8_STAGE(bufoff, gbase, voff) do { _Pragma("unroll") for (int _i = 0; _i < 2; ++_i) \
        __builtin_amdgcn_global_load_lds((const unsigned*)((const char*)(gbase) + (voff)[_i]), (LAS unsigned*)(lds + (bufoff) + ldsw + _i * 8192), 16, 0, 0); } while (0)
#define PG8_LDA(dst, b, h) do { _Pragma("unroll") for (int m = 0; m < 4; ++m) _Pragma("unroll") for (int k = 0; k < 2; ++k) dst[m][k] = *(const LAS bf16x8*)(lds + PG8_SA(b, h) + aoff + m * 2048 + k * 1024); } while (0)
#define PG8_LDB(dst, b, h) do { _Pragma("unroll") for (int n = 0; n < 2; ++n) _Pragma("unroll") for (int k = 0; k < 2; ++k) dst[n][k] = *(const LAS bf16x8*)(lds + PG8_SB(b, h) + boff + n * 2048 + k * 1024); } while (0)
#define PG8_MMA(ai, bj, At, Bt) do { __builtin_amdgcn_s_setprio(1); _Pragma("unroll") for (int m = 0; m < 4; ++m) _Pragma("unroll") for (int n = 0; n < 2; ++n) _Pragma("unroll") for (int k = 0; k < 2; ++k) \
        acc[ai][bj][m][n] = __builtin_amdgcn_mfma_f32_16x16x32_bf16(Bt[n][k], At[m][k], acc[ai][bj][m][n], 0, 0, 0); __builtin_amdgcn_s_setprio(0); } while (0)
#define PG8_WAIT_V(n) asm volatile("s_waitcnt vmcnt(" #n ")" ::: "memory")
#define PG8_WAIT_L(n) asm volatile("s_waitcnt lgkmcnt(" #n ")" ::: "memory")
#define PG8_BAR __builtin_amdgcn_s_barrier()
#define PG8_SCHED __builtin_amdgcn_sched_barrier(0)
    Unit cur, nxt; int ui = 0;
    if (!S.next(0, cur)) return;
    f32x4 acc[2][2][4][2];
#pragma unroll
    for (int a = 0; a < 2; ++a)
#pragma unroll
        for (int b = 0; b < 2; ++b)
#pragma unroll
            for (int m = 0; m < 4; ++m)
#pragma unroll
                for (int n = 0; n < 2; ++n) acc[a][b][m][n] = (f32x4){0.f, 0.f, 0.f, 0.f};
    bf16x8 At[4][2], B0[2][2], B1[2][2];
    const char* cA = (const char*)g.A + (size_t)cur.pm * tstepA; const char* cB = (const char*)g.Bt + (size_t)cur.pn * tstepB;
    PG8_STAGE(PG8_SB(0, 0), cB, voffB); PG8_STAGE(PG8_SB(0, 1), cB + hstepB, voffB); PG8_STAGE(PG8_SA(0, 0), cA, voffA); PG8_STAGE(PG8_SA(0, 1), cA + hstepA, voffA);
    if (wr == 1) PG8_BAR;
    PG8_WAIT_V(2); PG8_BAR;
    PG8_STAGE(PG8_SB(1, 0), cB + kstep, voffB); PG8_STAGE(PG8_SA(1, 0), cA + kstep, voffA); PG8_STAGE(PG8_SB(1, 1), cB + hstepB + kstep, voffB);
    PG8_WAIT_V(6); PG8_BAR;
    for (;;) {
        const bool has_next = S.next(ui + 1, nxt);
        const char* nA = has_next ? (const char*)g.A + (size_t)nxt.pm * tstepA : cA; const char* nB = has_next ? (const char*)g.Bt + (size_t)nxt.pn * tstepB : cB;
        for (int t = 0; t < nt; t += 2) {
            const bool last = (t == nt - 2);
            const char* a1 = cA + (size_t)(t + 1) * kstep;
            const char* a2 = last ? nA : cA + (size_t)(t + 2) * kstep; const char* b2 = last ? nB : cB + (size_t)(t + 2) * kstep;
            const char* a3 = a2 + kstep; const char* b3 = b2 + kstep;
            PG8_LDB(B0, 0, 0); PG8_LDB(B1, 0, 1); PG8_SCHED; PG8_LDA(At, 0, 0); PG8_STAGE(PG8_SA(1, 1), a1 + hstepA, voffA);
            PG8_WAIT_V(8); PG8_WAIT_L(0); PG8_BAR; PG8_MMA(0, 0, At, B0); PG8_MMA(0, 1, At, B1); PG8_BAR; PG8_SCHED;
            PG8_LDA(At, 0, 1); PG8_STAGE(PG8_SB(0, 0), b2, voffB); PG8_STAGE(PG8_SB(0, 1), b2 + hstepB, voffB); PG8_STAGE(PG8_SA(0, 0), a2, voffA);
            PG8_WAIT_V(8); PG8_WAIT_L(0); PG8_BAR; PG8_MMA(1, 0, At, B0); PG8_MMA(1, 1, At, B1); PG8_BAR; PG8_SCHED;
            PG8_LDB(B0, 1, 0); PG8_LDB(B1, 1, 1); PG8_SCHED; PG8_LDA(At, 1, 0); PG8_STAGE(PG8_SA(0, 1), a2 + hstepA, voffA);
            PG8_WAIT_V(8); PG8_WAIT_L(0); PG8_BAR; PG8_MMA(0, 0, At, B0); PG8_MMA(0, 1, At, B1); PG8_BAR; PG8_SCHED;
            PG8_LDA(At, 1, 1); PG8_STAGE(PG8_SB(1, 0), b3, voffB); PG8_STAGE(PG8_SB(1, 1), b3 + hstepB, voffB); PG8_STAGE(PG8_SA(1, 0), a3, voffA);
            PG8_WAIT_V(8); PG8_WAIT_L(0); PG8_BAR; PG8_MMA(1, 0, At, B0); PG8_MMA(1, 1, At, B1); PG8_BAR; PG8_SCHED;
        }
        if (wr == 0) PG8_BAR;
        E(acc, cur, wr, wc, fr, fq);
        if (!has_next) break;
#pragma unroll
        for (int a = 0; a < 2; ++a)
#pragma unroll
            for (int b = 0; b < 2; ++b)
#pragma unroll
                for (int m = 0; m < 4; ++m)
#pragma unroll
                    for (int n = 0; n < 2; ++n) acc[a][b][m][n] = (f32x4){0.f, 0.f, 0.f, 0.f};
        cur = nxt; cA = nA; cB = nB; ++ui;
        if (wr == 1) PG8_BAR;
    }
    PG8_WAIT_V(0);
    PG8_BAR;
#undef PG8_SA
#undef PG8_SB
#undef PG8_STAGE
#undef PG8_LDA
#undef PG8_LDB
#undef PG8_MMA
#undef PG8_WAIT_V
#undef PG8_WAIT_L
#undef PG8_BAR
#undef PG8_SCHED
}

typedef f32x4 Acc[2][2][4][2];
struct EpiRes {
    float* X; float sc;
    __device__ __forceinline__ void operator()(const Acc& acc, const Unit& u, int wr, int wc, int fr, int fq) const {
#pragma unroll
        for (int ai = 0; ai < 2; ++ai)
#pragma unroll
            for (int m = 0; m < 4; ++m) { float* rp = X + (size_t)(u.pm * 256 + ai * 128 + wr * 64 + m * 16 + fr) * D + u.pn * 256 + wc * 32 + 4 * fq;
#pragma unroll
                for (int bj = 0; bj < 2; ++bj)
#pragma unroll
                    for (int n = 0; n < 2; ++n) { f32x4* q = (f32x4*)(rp + bj * 128 + n * 16); *q = *q + acc[ai][bj][m][n] * sc; } }
    }
};
struct EpiStore {
    bf16_t* O; int ld; int mode;
    __device__ __forceinline__ void operator()(const Acc& acc, const Unit& u, int wr, int wc, int fr, int fq) const {
        const bool act = mode == 1 && (u.pn < 2 || u.pn == 4 || u.pn == 5);
#pragma unroll
        for (int ai = 0; ai < 2; ++ai)
#pragma unroll
            for (int m = 0; m < 4; ++m) { bf16_t* rp = O + (size_t)(u.pm * 256 + ai * 128 + wr * 64 + m * 16 + fr) * ld + u.pn * 256 + wc * 32 + 4 * fq;
#pragma unroll
                for (int bj = 0; bj < 2; ++bj)
#pragma unroll
                    for (int n = 0; n < 2; ++n) { f32x4 v = acc[ai][bj][m][n];
                        if (act) { v[0] = gelu_t(v[0]); v[1] = gelu_t(v[1]); v[2] = gelu_t(v[2]); v[3] = gelu_t(v[3]); }
                        *(u32x2*)(rp + bj * 128 + n * 16) = pack4(v); } }
    }
};
struct EpiGate {
    float* X; const bf16_t* PP; float sc;
    __device__ __forceinline__ void operator()(const Acc& acc, const Unit& u, int wr, int wc, int fr, int fq) const {
#pragma unroll
        for (int ai = 0; ai < 2; ++ai)
#pragma unroll
            for (int m = 0; m < 4; ++m) { const size_t off = (size_t)(u.pm * 256 + ai * 128 + wr * 64 + m * 16 + fr) * D + u.pn * 256 + wc * 32 + 4 * fq;
#pragma unroll
                for (int bj = 0; bj < 2; ++bj)
#pragma unroll
                    for (int n = 0; n < 2; ++n) { const f32x4 a = acc[ai][bj][m][n]; const f32x4 pp = unpack4(*(const u32x2*)(PP + off + bj * 128 + n * 16)) * sc;
                        f32x4* q = (f32x4*)(X + off + bj * 128 + n * 16); f32x4 x = *q;
                        x[0] += sigm(a[0]) * pp[0]; x[1] += sigm(a[1]) * pp[1]; x[2] += sigm(a[2]) * pp[2]; x[3] += sigm(a[3]) * pp[3]; *q = x; } }
    }
};
struct EpiGlu {
    float* X; float sc;
    __device__ __forceinline__ void operator()(const Acc& acc, const Unit& u, int wr, int wc, int fr, int fq) const {
#pragma unroll
        for (int ai = 0; ai < 2; ++ai)
#pragma unroll
            for (int m = 0; m < 4; ++m) { float* rp = X + (size_t)(u.pm * 256 + ai * 128 + wr * 64 + m * 16 + fr) * D + u.pn * 128 + wc * 32 + 4 * fq;
#pragma unroll
                for (int n = 0; n < 2; ++n) { const f32x4 a = acc[ai][0][m][n] * sc, b = acc[ai][1][m][n]; f32x4* q = (f32x4*)(rp + n * 16); f32x4 x = *q;
                    x[0] += a[0] * sigm(b[0]); x[1] += a[1] * sigm(b[1]); x[2] += a[2] * sigm(b[2]); x[3] += a[3] * sigm(b[3]); *q = x; } }
    }
};
struct EpiE {
    float* Eo;
    __device__ __forceinline__ void operator()(const Acc& acc, const Unit& u, int wr, int wc, int fr, int fq) const {
#pragma unroll
        for (int ai = 0; ai < 2; ++ai)
#pragma unroll
            for (int m = 0; m < 4; ++m) { float* rp = Eo + (size_t)(u.pm * 256 + ai * 128 + wr * 64 + m * 16 + fr) * 128 + wc * 32 + 4 * fq;
#pragma unroll
                for (int n = 0; n < 2; ++n) *(f32x4*)(rp + n * 16) = acc[ai][0][m][n]; }
    }
};
struct EpiY {
    const bf16_t* AG; const float* Dv; bf16_t* Gm;
    __device__ __forceinline__ void operator()(const Acc& acc, const Unit& u, int wr, int wc, int fr, int fq) const {
        const int g = u.pm >> 1, jj = u.pn & 1; const f32x4 d4 = *(const f32x4*)(Dv + g * 16 + 4 * fq);
#pragma unroll
        for (int ai = 0; ai < 2; ++ai)
#pragma unroll
            for (int m = 0; m < 4; ++m) { const int rowA = u.pm * 256 + ai * 128 + wr * 64 + m * 16 + fr; const int nchunk = rowA - g * 512;
#pragma unroll
                for (int bj = 0; bj < 2; ++bj)
#pragma unroll
                    for (int n = 0; n < 2; ++n) { const int sp = 16 * jj + 8 * bj + 2 * wc + n; const int t = nchunk * 32 + sp;
                        const f32x4 uu = unpack4(*(const u32x2*)(AG + (size_t)rowA * 640 + sp * 16 + 4 * fq));
                        f32x4 y = acc[ai][bj][m][n] + d4 * uu; y[0] = gelu_t(y[0]); y[1] = gelu_t(y[1]); y[2] = gelu_t(y[2]); y[3] = gelu_t(y[3]);
                        *(u32x2*)(Gm + (size_t)t * D + g * 16 + 4 * fq) = pack4(y); } }
    }
};
__device__ __forceinline__ float dpp_ror1(float v) { return __int_as_float(__builtin_amdgcn_update_dpp(0, __float_as_int(v), 0x121, 0xf, 0xf, false)); }
__device__ __forceinline__ float dpp_ror2(float v) { return __int_as_float(__builtin_amdgcn_update_dpp(0, __float_as_int(v), 0x122, 0xf, 0xf, false)); }
struct EpiConv {
    bf16_t* ACT; const float* cw; const float* cb; LAS unsigned char* xl;
    __device__ __forceinline__ void operator()(const Acc& acc, const Unit& u, int wr, int wc, int fr, int fq) const {
        LAS f32x4* X4 = (LAS f32x4*)xl;
        if (fr >= 14) {
#pragma unroll
            for (int ai = 0; ai < 2; ++ai) { const int s = 2 * ai + wr;
                if (s <= 2) {
#pragma unroll
                    for (int bj = 0; bj < 2; ++bj)
#pragma unroll
                        for (int n = 0; n < 2; ++n) X4[(((((s * 2 + bj) * 2 + n) * 4 + wc) * 4 + fq) * 2) + (fr - 14)] = acc[ai][bj][3][n]; } }
        }
        asm volatile("s_waitcnt lgkmcnt(0)" ::: "memory"); __builtin_amdgcn_s_barrier(); asm volatile("" ::: "memory");
#pragma unroll
        for (int ai = 0; ai < 2; ++ai) { const int s = 2 * ai + wr;
#pragma unroll
            for (int n = 0; n < 2; ++n) {
                const int ch = 128 * u.pn + 32 * wc + 16 * n + 4 * fq;
                const f32x4 wg0 = *(const f32x4*)(cw + ch), wg1 = *(const f32x4*)(cw + 2 * FF + ch), wg2 = *(const f32x4*)(cw + 4 * FF + ch), bg = *(const f32x4*)(cb + ch);
                const f32x4 wu0 = *(const f32x4*)(cw + FF + ch), wu1 = *(const f32x4*)(cw + 3 * FF + ch), wu2 = *(const f32x4*)(cw + 5 * FF + ch), bu = *(const f32x4*)(cb + FF + ch);
                f32x4 pg = (f32x4){0.f, 0.f, 0.f, 0.f}, pu = pg;
                if (s >= 1 && fr >= 14) { pg = X4[((((((s - 1) * 2 + 0) * 2 + n) * 4 + wc) * 4 + fq) * 2) + (fr - 14)]; pu = X4[((((((s - 1) * 2 + 1) * 2 + n) * 4 + wc) * 4 + fq) * 2) + (fr - 14)]; }
#pragma unroll
                for (int m = 0; m < 4; ++m) {
                    const f32x4 cg_ = acc[ai][0][m][n], cu_ = acc[ai][1][m][n];
                    f32x4 hg, hu;
#pragma unroll
                    for (int e = 0; e < 4; ++e) {
                        const float t1g = fr == 15 ? pg[e] : cg_[e], t2g = fr >= 14 ? pg[e] : cg_[e];
                        const float t1u = fr == 15 ? pu[e] : cu_[e], t2u = fr >= 14 ? pu[e] : cu_[e];
                        const float p1g = dpp_ror1(t1g), p2g = dpp_ror2(t2g), p1u = dpp_ror1(t1u), p2u = dpp_ror2(t2u);
                        hg[e] = bg[e] + wg0[e] * p2g + wg1[e] * p1g + wg2[e] * cg_[e];
                        hu[e] = bu[e] + wu0[e] * p2u + wu1[e] * p1u + wu2[e] * cu_[e];
                    }
                    f32x4 o; o[0] = hg[0] * sigm(hg[0]) * hu[0]; o[1] = hg[1] * sigm(hg[1]) * hu[1]; o[2] = hg[2] * sigm(hg[2]) * hu[2]; o[3] = hg[3] * sigm(hg[3]) * hu[3];
                    const int rt = 128 * ai + 64 * wr + 16 * m + fr; const int gr = 254 * u.pm - 2 + rt;
                    if (rt >= 2 && gr < S) *(u32x2*)(ACT + (size_t)gr * FF + ch) = pack4(o);
                    pg = cg_; pu = cu_;
                }
            }
        }
    }
};
}

constexpr size_t MiB = 1u << 20;
constexpr size_t WS_CL = 0, WS_CG = 524288, WS_GT = 1048576, WS_BAR = 1572864, BAR_BYTES = 16384;
constexpr size_t WS_WIN = 2 * MiB;
constexpr size_t WS_WOUT = WS_WIN + 2ull * 2560 * 1024 * 2;
constexpr size_t WS_WGLU = WS_WOUT + 2ull * 1024 * 1024 * 2;
constexpr size_t WS_WUP = WS_WGLU + 2ull * 2048 * 1024 * 2;
constexpr size_t WS_WDN = WS_WUP + 4ull * 5632 * 1024 * 2;
constexpr size_t WS_WGT = WS_WDN + 4ull * 1024 * 2816 * 2;
constexpr size_t WS_WPR = WS_WGT + 4ull * 1024 * 1024 * 2;
constexpr size_t WS_HNA = WS_WPR + 4ull * 1024 * 256 * 2;
constexpr size_t WS_R = WS_HNA + (2ull + 16384 + 256) * 1024 * 2;
constexpr size_t WS_END = WS_R + 144 * MiB;
constexpr size_t R_Z = 0;
constexpr size_t R_AG = 0, R_TS = 40 * MiB, R_PS = 80 * MiB, R_E = 96 * MiB, R_G = 112 * MiB;
constexpr size_t R_ACT = 0;
constexpr size_t R_PB = 0, R_PP = 8 * MiB;

#ifndef REPMASK
#define REPMASK 0u
#endif
#ifndef XSYNC
#define XSYNC 0
#endif
constexpr int LDS_BYTES = 147456, XL_OFF = 131072;

#define XB_TMO      128
#define XB_XCNT(j)  (256  + 64 * (j))
#define XB_XSUB(j)  (1280 + 64 * (j))
#define XB_XGEN(j)  (2304 + 64 * (j))
#define XB_TOP      3328
#define XB_TOPGEN   3392
#define XCD_BAR_WORDS 3456
#define XB_SPIN_CAP (1u << 18)
__device__ __forceinline__ unsigned xb_ld(unsigned* p)              { return __hip_atomic_load(p, __ATOMIC_RELAXED, __HIP_MEMORY_SCOPE_AGENT); }
__device__ __forceinline__ unsigned xb_add(unsigned* p, unsigned v) { return __hip_atomic_fetch_add(p, v, __ATOMIC_RELAXED, __HIP_MEMORY_SCOPE_AGENT); }
__device__ __forceinline__ unsigned xb_xcc_id() { return (unsigned)__builtin_amdgcn_s_getreg((3 << 11) | 20) & 0xFu; }
#define XB_SPIN(cond, bar) do { unsigned _sp = 0; while (cond) { __builtin_amdgcn_s_sleep(1); \
    if ((++_sp & 255u) == 0u) { if (xb_ld(&(bar)[XB_TMO])) break; if (_sp > XB_SPIN_CAP) { atomicAdd(&(bar)[XB_TMO], 1u); break; } } } } while (0)
struct XcdBarrier { unsigned* bar; unsigned x; volatile LAS unsigned* st; };
__device__ __forceinline__ XcdBarrier xcd_barrier_post(unsigned* bar, volatile LAS unsigned* st) {
    XcdBarrier b; b.bar = bar; b.x = xb_xcc_id(); b.st = st;
    if (threadIdx.x == 0) (void)xb_add(&bar[XB_XCNT(b.x)], 1u);
    return b;
}
__device__ __forceinline__ void xcd_barrier_complete(unsigned* bar, unsigned x, unsigned& nloc, unsigned& nx) {
    const unsigned G = gridDim.x * gridDim.y * gridDim.z;
    unsigned sum, cnt, mine, sp = 0u;
    for (;;) {
        sum = 0u; cnt = 0u; mine = 0u;
#pragma unroll
        for (unsigned j = 0; j < 16; ++j) { const unsigned c = xb_ld(&bar[XB_XCNT(j)]); sum += c; cnt += (c > 0u) ? 1u : 0u; mine = (j == x) ? c : mine; }
        if (sum == G) break;
        __builtin_amdgcn_s_sleep(1);
        if ((++sp & 255u) == 0u) { if (xb_ld(&bar[XB_TMO])) break; if (sp > XB_SPIN_CAP) { atomicAdd(&bar[XB_TMO], 1u); break; } }
    }
    nloc = mine > 0u ? mine : 1u; nx = cnt > 0u ? cnt : 1u;
}
__device__ __forceinline__ void xcd_barrier(const XcdBarrier& b) {
    asm volatile("s_waitcnt vmcnt(0)" ::: "memory");
    __syncthreads();
    if (threadIdx.x == 0) {
        unsigned* bar = b.bar;
        __builtin_amdgcn_s_waitcnt(0);
        unsigned nloc = b.st[0], nx = b.st[1];
        if (nloc == 0u) { xcd_barrier_complete(bar, b.x, nloc, nx); b.st[0] = nloc; b.st[1] = nx; }
        const unsigned old = xb_add(&bar[XB_XSUB(b.x)], 1u);
        const unsigned gen = old / nloc;
        if (old + 1u == (gen + 1u) * nloc) {
            __builtin_amdgcn_fence(__ATOMIC_RELEASE, "agent");
            asm volatile("s_waitcnt vmcnt(0)" ::: "memory");
            const unsigned og = xb_add(&bar[XB_TOP], 1u);
            const unsigned tg = og / nx;
            if (og + 1u == (tg + 1u) * nx) xb_add(&bar[XB_TOPGEN], 1u);
            else XB_SPIN(xb_ld(&bar[XB_TOPGEN]) == tg, bar);
            __builtin_amdgcn_fence(__ATOMIC_ACQUIRE, "agent");
            xb_add(&bar[XB_XGEN(b.x)], 1u);
            asm volatile("s_waitcnt vmcnt(0)" ::: "memory");
        } else {
            XB_SPIN(xb_ld(&bar[XB_XGEN(b.x)]) == gen, bar);
            __builtin_amdgcn_fence(__ATOMIC_ACQUIRE, "agent");
            asm volatile("s_waitcnt vmcnt(0)" ::: "memory");
        }
    }
    __syncthreads();
}

struct Params { const float* in[27]; float* out; unsigned char* ws; };

__device__ __forceinline__ float load_row(const float* xrow, int lane, f32x4 (&v)[4]) {
    const f32x4* xr = (const f32x4*)xrow + lane; float ss = 0.f;
#pragma unroll
    for (int j = 0; j < 4; ++j) { v[j] = xr[64 * j]; ss += (v[j][0] * v[j][0] + v[j][1] * v[j][1]) + (v[j][2] * v[j][2] + v[j][3] * v[j][3]); }
    return 1.0f / sqrtf(wave_sum(ss) * (1.f / D) + EPS);
}

__device__ __forceinline__ void transpose_item(const float* W, int K, int ldw, bf16_t* WT, int n0, int drow0, int kb, LAS float* scr, int lane) {
    const int k0 = 64 * kb;
#pragma unroll 8
    for (int i = 0; i < 32; ++i) { const int kk = 2 * i + (lane >> 5); scr[kk * 33 + (lane & 31)] = W[(size_t)(k0 + kk) * ldw + n0 + (lane & 31)]; }
    asm volatile("s_waitcnt lgkmcnt(0)" ::: "memory");
    const int c = lane & 7;
#pragma unroll
    for (int j = 0; j < 4; ++j) { const int n = (lane >> 3) + 8 * j; const LAS float* s = scr + (8 * c) * 33 + n;
        u32x4 o; o.x = cvt_pk_bf16(s[0 * 33], s[1 * 33]); o.y = cvt_pk_bf16(s[2 * 33], s[3 * 33]); o.z = cvt_pk_bf16(s[4 * 33], s[5 * 33]); o.w = cvt_pk_bf16(s[6 * 33], s[7 * 33]);
        *(u32x4*)(WT + (size_t)(drow0 + n) * K + k0 + 8 * c) = o; }
    asm volatile("s_waitcnt lgkmcnt(0)" ::: "memory");
}
__device__ __forceinline__ int dest_row(int mode, int n0, int half) {
    if (mode == 1) { const int seg = n0 >> 9, r = n0 & 511; const int ds = seg == 1 ? 2 : (seg == 2 ? 1 : seg); return ds * 512 + r; }
    if (mode == 2) { const int hi = n0 >= half, np = hi ? n0 - half : n0; return (np >> 7) * 256 + hi * 128 + (np & 127); }
    return n0;
}
__device__ __forceinline__ bool transpose_mat(int& r, const float* W, int K, int ldw, int ncols, bf16_t* WT, int mode, LAS float* scr, int lane) {
    const int nblk = ncols / 32, items = (K / 64) * nblk;
    if (r >= items) { r -= items; return false; }
    const int kb = r / nblk, nb = r % nblk;
    transpose_item(W, K, ldw, WT, nb * 32, dest_row(mode, nb * 32, ncols / 2), kb, scr, lane);
    return true;
}

__global__ void __launch_bounds__(512, 2) mega(Params P) {
    extern __shared__ __attribute__((aligned(16))) unsigned char lds_raw[];
    LAS unsigned char* lds = (LAS unsigned char*)lds_raw;
    cg::grid_group grid = cg::this_grid();
    const int G = gridDim.x, bid = blockIdx.x, NGW = G * 8;
#define PHASE_IDS int tid = threadIdx.x; asm volatile("" : "+v"(tid)); const int lane = tid & 63, wid = __builtin_amdgcn_readfirstlane(tid >> 6), gw = bid * 8 + wid; (void)lane; (void)gw;
    unsigned char* ws = P.ws;
    float* X = P.out;
    float* CL = (float*)(ws + WS_CL); float* CGm = (float*)(ws + WS_CG); float* GT = (float*)(ws + WS_GT);
    bf16_t* HNA = (bf16_t*)(ws + WS_HNA); bf16_t* HN = HNA + 2 * D;
    unsigned char* R = ws + WS_R;
    { volatile LAS unsigned* st0 = (volatile LAS unsigned*)(lds + XL_OFF + 8192); if (threadIdx.x < 2) st0[threadIdx.x] = 0u; __syncthreads(); }
    const XcdBarrier xbar = xcd_barrier_post((unsigned*)(ws + WS_BAR), (volatile LAS unsigned*)(lds + XL_OFF + 8192));
#define GSYNC() xcd_barrier(xbar)

    for (int rep_ = 0; rep_ < 1 + (int)((REPMASK >> 0) & 1u); ++rep_) { PHASE_IDS
        LAS float* scr = (LAS float*)(lds + wid * 16384);
        constexpr int I_IN = 16 * 80, I_OUT = 16 * 32, I_GLU = 16 * 64, I_UP = 16 * 176, I_DN = 44 * 32, I_GT = 16 * 32, I_PR = 4 * 32;
        constexpr int NIT = 2 * I_IN + 2 * I_OUT + 2 * I_GLU + 4 * I_UP + 4 * I_DN + 4 * I_GT + 4 * I_PR;
        for (int it = gw; it < NIT; it += NGW) {
            int r = it; bool done = false;
#pragma unroll 1
            for (int e = 0; e < 2 && !done; ++e) done = transpose_mat(r, P.in[4] + (size_t)e * 1024 * 2568, 1024, 2568, 2560, (bf16_t*)(ws + WS_WIN) + (size_t)e * 2560 * 1024, 1, scr, lane);
#pragma unroll 1
            for (int e = 0; e < 2 && !done; ++e) done = transpose_mat(r, P.in[11] + (size_t)e * 1024 * 1024, 1024, 1024, 1024, (bf16_t*)(ws + WS_WOUT) + (size_t)e * 1024 * 1024, 0, scr, lane);
#pragma unroll 1
            for (int e = 0; e < 2 && !done; ++e) done = transpose_mat(r, P.in[20] + (size_t)e * 1024 * 2048, 1024, 2048, 2048, (bf16_t*)(ws + WS_WGLU) + (size_t)e * 2048 * 1024, 2, scr, lane);
#pragma unroll 1
            for (int e = 0; e < 4 && !done; ++e) done = transpose_mat(r, P.in[21] + (size_t)e * 1024 * 5632, 1024, 5632, 5632, (bf16_t*)(ws + WS_WUP) + (size_t)e * 5632 * 1024, 2, scr, lane);
#pragma unroll 1
            for (int e = 0; e < 4 && !done; ++e) done = transpose_mat(r, P.in[24] + (size_t)e * 2816 * 1024, 2816, 1024, 1024, (bf16_t*)(ws + WS_WDN) + (size_t)e * 1024 * 2816, 0, scr, lane);
#pragma unroll 1
            for (int e = 0; e < 4 && !done; ++e) done = transpose_mat(r, P.in[26] + (size_t)e * 1024 * 1024, 1024, 1024, 1024, (bf16_t*)(ws + WS_WGT) + (size_t)e * 1024 * 1024, 0, scr, lane);
#pragma unroll 1
            for (int e = 0; e < 4 && !done; ++e) done = transpose_mat(r, P.in[25] + (size_t)e * 256 * 1024, 256, 1024, 1024, (bf16_t*)(ws + WS_WPR) + (size_t)e * 1024 * 256, 0, scr, lane);
        }
        for (int m = gw; m < S; m += NGW) { const f32x4* s = (const f32x4*)(P.in[0] + (size_t)m * D) + lane; f32x4* d = (f32x4*)(X + (size_t)m * D) + lane;
#pragma unroll
            for (int j = 0; j < 4; ++j) d[64 * j] = s[64 * j]; }
        if (bid == 0) for (int i = tid; i < 2 * D / 2; i += 512) ((unsigned*)HNA)[i] = 0u;
    }
    grid.sync();

#pragma unroll 1
    for (int L = 0; L < 4; ++L) {
        const int e = L >> 1;
        if ((L & 1) == 0) {
            for (int rep_ = 0; rep_ < 1 + (int)((REPMASK >> 1) & 1u); ++rep_) { PHASE_IDS
                const float* gmix = P.in[2] + L * D; const float* Win = P.in[4] + (size_t)e * 1024 * 2568; const float* bfg = P.in[5] + e * 8;
                f32x4 wfa[16], wfb[16];
#pragma unroll
                for (int j = 0; j < 4; ++j)
#pragma unroll
                    for (int i = 0; i < 4; ++i) { const float* wp = Win + (size_t)(4 * lane + 256 * j + i) * 2568 + 2560; wfa[j * 4 + i] = *(const f32x4*)wp; wfb[j * 4 + i] = *(const f32x4*)(wp + 4); }
                float bb[8];
#pragma unroll
                for (int h = 0; h < 8; ++h) bb[h] = bfg[h];
                for (int gi = gw; gi < 2048; gi += NGW) {
                    float cum[8];
#pragma unroll
                    for (int h = 0; h < 8; ++h) cum[h] = 0.f;
#pragma unroll 1
                    for (int rr = 0; rr < 8; ++rr) {
                        const int t = 8 * gi + rr; f32x4 v[4]; const float rs = load_row(X + (size_t)t * D, lane, v);
                        f32x4 fa = (f32x4){0.f, 0.f, 0.f, 0.f}, fb = fa;
#pragma unroll
                        for (int j = 0; j < 4; ++j) { const f32x4 gg = *((const f32x4*)gmix + lane + 64 * j); v[j] = v[j] * rs * gg;
                            *((u32x2*)(HN + (size_t)t * D) + lane + 64 * j) = pack4(v[j]);
#pragma unroll
                            for (int i = 0; i < 4; ++i) { fa += wfa[j * 4 + i] * v[j][i]; fb += wfb[j * 4 + i] * v[j][i]; } }
                        float f[8] = {fa[0], fa[1], fa[2], fa[3], fb[0], fb[1], fb[2], fb[3]};
#pragma unroll
                        for (int h = 0; h < 8; ++h) { const float z = wave_sum(f[h]) + bb[h]; const float ls = z >= 0.f ? -log1pf(expf(-z)) : z - log1pf(expf(z)); cum[h] += ls * LOG2E; }
                        if (lane == 0) { *(f32x4*)(CL + (size_t)t * 8) = (f32x4){cum[0], cum[1], cum[2], cum[3]}; *(f32x4*)(CL + (size_t)t * 8 + 4) = (f32x4){cum[4], cum[5], cum[6], cum[7]}; }
                    }
                    if (lane == 0) { *(f32x4*)(GT + (size_t)gi * 8) = (f32x4){cum[0], cum[1], cum[2], cum[3]}; *(f32x4*)(GT + (size_t)gi * 8 + 4) = (f32x4){cum[4], cum[5], cum[6], cum[7]}; }
                }
            }
            GSYNC();
            for (int rep_ = 0; rep_ < 1 + (int)((REPMASK >> 2) & 1u); ++rep_) { PHASE_IDS
                pg8::Gemm g{HN, (const bf16_t*)(ws + WS_WIN) + (size_t)e * 2560 * 1024, 1024, 1024, 256};
                pg8::StaticOrder so; so.init(64, 10, G, bid);
                pg8::EpiStore E{(bf16_t*)(R + R_Z), ZW, 1};
                pg8::gemm_phase(lds, g, so, E);
            }
            GSYNC();
            for (int rep_ = 0; rep_ < 1 + (int)((REPMASK >> 3) & 1u); ++rep_) { PHASE_IDS
                bf16_t* Z = (bf16_t*)(R + R_Z);
                const float* gq = P.in[6] + e * 64; const float* gk = P.in[7] + e * 64;
                LAS float* CT = (LAS float*)(lds + 98304); LAS float* BT = CT + 2048; LAS float* OFF = BT + 512;
                __syncthreads();
                { const int ckk = tid >> 1, hq = (tid & 1) * 4; f32x4 s = (f32x4){0.f, 0.f, 0.f, 0.f};
#pragma unroll
                  for (int i = 0; i < 8; ++i) s += *(const f32x4*)(GT + (size_t)(8 * ckk + i) * 8 + hq);
                  *(LAS f32x4*)(CT + ckk * 8 + hq) = s; }
                __syncthreads();
                { const int h = tid & 7, b4 = tid >> 3; BT[b4 * 8 + h] = (CT[(4 * b4) * 8 + h] + CT[(4 * b4 + 1) * 8 + h]) + (CT[(4 * b4 + 2) * 8 + h] + CT[(4 * b4 + 3) * 8 + h]); }
                __syncthreads();
                { const int h = tid & 7, b4 = tid >> 3; float o_ = 0.f;
                  for (int i = 0; i < b4; ++i) o_ += BT[i * 8 + h];
#pragma unroll
                  for (int i = 0; i < 4; ++i) { OFF[(4 * b4 + i) * 8 + h] = o_; o_ += CT[(4 * b4 + i) * 8 + h]; } }
                __syncthreads();
                for (int ck = bid; ck < 256; ck += G) {
                    { const int h = tid & 7, tok = tid >> 3; float off = OFF[ck * 8 + h];
                      const int gl = tok >> 3;
                      for (int i2 = 0; i2 < gl; ++i2) off += GT[(size_t)(8 * ck + i2) * 8 + h];
                      const int t = 64 * ck + tok; CGm[(size_t)t * 8 + h] = CL[(size_t)t * 8 + h] + off; }
#pragma unroll 1
                    for (int ps = 0; ps < 16; ++ps) {
                        const int pair = ps * 64 + (tid >> 3), sub = tid & 7; const int tok = pair >> 4, hh = (pair >> 1) & 7, isk = pair & 1;
                        bf16_t* ptr = Z + (size_t)(64 * ck + tok) * ZW + (isk ? 1536 : 512) + hh * 64 + sub * 8;
                        const u32x4 w = *(const u32x4*)ptr; float v[8];
                        v[0] = bf2f(w.x & 0xffffu); v[1] = bf2f(w.x >> 16); v[2] = bf2f(w.y & 0xffffu); v[3] = bf2f(w.y >> 16); v[4] = bf2f(w.z & 0xffffu); v[5] = bf2f(w.z >> 16); v[6] = bf2f(w.w & 0xffffu); v[7] = bf2f(w.w >> 16);
                        float ss = 0.f;
#pragma unroll
                        for (int i = 0; i < 8; ++i) ss += v[i] * v[i];
                        ss += __shfl_xor(ss, 1); ss += __shfl_xor(ss, 2); ss += __shfl_xor(ss, 4);
                        const float rs = (1.0f / sqrtf(ss * (1.f / 64.f) + EPS)) * (isk ? 1.f : 0.125f * LOG2E);
                        const float* gp = (isk ? gk : gq) + sub * 8;
#pragma unroll
                        for (int i = 0; i < 8; ++i) v[i] = v[i] * rs * gp[i];
                        u32x4 o; o.x = cvt_pk_bf16(v[0], v[1]); o.y = cvt_pk_bf16(v[2], v[3]); o.z = cvt_pk_bf16(v[4], v[5]); o.w = cvt_pk_bf16(v[6], v[7]);
                        { int rp_ = rep_; asm volatile("" : "+v"(rp_)); if (rp_) o = w; }
                        *(u32x4*)ptr = o;
                    }
                    { LAS bf16_t* LT = (LAS bf16_t*)(lds + 1024); bf16_t* VTg = (bf16_t*)(R + 80 * MiB);
                      __syncthreads();
#pragma unroll 1
                      for (int k = 0; k < 8; ++k) { const int idx = tid + 512 * k; const int tok = idx & 63, cc = idx >> 6;
                          const u32x4 w = *(const u32x4*)(Z + (size_t)(64 * ck + tok) * ZW + 2048 + cc * 8); LAS bf16_t* lt = LT + (cc * 8) * 72 + tok;
                          lt[0 * 72] = (bf16_t)(w.x & 0xffffu); lt[1 * 72] = (bf16_t)(w.x >> 16); lt[2 * 72] = (bf16_t)(w.y & 0xffffu); lt[3 * 72] = (bf16_t)(w.y >> 16);
                          lt[4 * 72] = (bf16_t)(w.z & 0xffffu); lt[5 * 72] = (bf16_t)(w.z >> 16); lt[6 * 72] = (bf16_t)(w.w & 0xffffu); lt[7 * 72] = (bf16_t)(w.w >> 16); }
                      __syncthreads();
#pragma unroll 1
                      for (int k = 0; k < 8; ++k) { const int idx = tid + 512 * k; const int c = idx >> 3, part = idx & 7;
                          *(u32x4*)(VTg + (size_t)c * S + 64 * ck + part * 8) = *(const LAS u32x4*)(LT + c * 72 + part * 8); }
                    }
                }
                LAS bf16_t* Wsm = (LAS bf16_t*)lds; LAS bf16_t* VT = (LAS bf16_t*)(lds + 34816);
                const float* wsp = P.in[9] + (size_t)e * 4 * 128 * 128; const float* bsp = P.in[10] + e * 512; const float* vg = P.in[8] + e * 512;
                for (int it = bid; it < 512; it += G) {
                    const int n = it >> 2, g = it & 3;
                    __syncthreads();
                    for (int idx = tid; idx < 128 * 32; idx += 512) { const int t = idx >> 5, s4 = (idx & 31) * 4; f32x4 w = *(const f32x4*)(wsp + ((size_t)g * 128 + t) * 128 + s4);
#pragma unroll
                        for (int i = 0; i < 4; ++i) if (s4 + i > t) w[i] = 0.f;
                        *(LAS u32x2*)(Wsm + t * 136 + s4) = pack4(w); }
                    { const int tok = tid >> 2, part = tid & 3; const bf16_t* vp = Z + (size_t)(128 * n + tok) * ZW + 1024 + g * 128 + part * 32;
                      float v[32]; float ss = 0.f;
#pragma unroll
                      for (int q = 0; q < 4; ++q) { const u32x4 w = *(const u32x4*)(vp + q * 8);
                          v[q * 8 + 0] = bf2f(w.x & 0xffffu); v[q * 8 + 1] = bf2f(w.x >> 16); v[q * 8 + 2] = bf2f(w.y & 0xffffu); v[q * 8 + 3] = bf2f(w.y >> 16);
                          v[q * 8 + 4] = bf2f(w.z & 0xffffu); v[q * 8 + 5] = bf2f(w.z >> 16); v[q * 8 + 6] = bf2f(w.w & 0xffffu); v[q * 8 + 7] = bf2f(w.w >> 16); }
#pragma unroll
                      for (int i = 0; i < 32; ++i) ss += v[i] * v[i];
                      ss += __shfl_xor(ss, 1); ss += __shfl_xor(ss, 2);
                      const float rs = 1.0f / sqrtf(ss * (1.f / 128.f) + EPS);
#pragma unroll
                      for (int i = 0; i < 32; ++i) { const int c = part * 32 + i; const float y = v[i] * rs * vg[g * 128 + c]; VT[c * 136 + tok] = (bf16_t)(cvt_pk_bf16(y, 0.f) & 0xffffu); } }
                    __syncthreads();
                    const int l15 = lane & 15, quad = lane >> 4;
                    f32x4 acc[8];
#pragma unroll
                    for (int cb = 0; cb < 8; ++cb) acc[cb] = (f32x4){0.f, 0.f, 0.f, 0.f};
                    for (int ks = 0; ks <= (wid >> 1); ++ks) {
                        const bf16x8 a = *(const LAS bf16x8*)(Wsm + (16 * wid + l15) * 136 + 32 * ks + quad * 8);
#pragma unroll
                        for (int cb = 0; cb < 8; ++cb) { const bf16x8 b = *(const LAS bf16x8*)(VT + (16 * cb + l15) * 136 + 32 * ks + quad * 8);
                            acc[cb] = __builtin_amdgcn_mfma_f32_16x16x32_bf16(b, a, acc[cb], 0, 0, 0); }
                    }
                    const int t = 16 * wid + l15; const float bs = bsp[g * 128 + t];
                    bf16_t* up = Z + (size_t)(128 * n + t) * ZW + g * 128 + quad * 4;
#pragma unroll
                    for (int cb = 0; cb < 8; ++cb) { const f32x4 uu = unpack4(*(const u32x2*)(up + 16 * cb)); f32x4 y = uu * (acc[cb] + bs); { int rp_ = rep_; asm volatile("" : "+v"(rp_)); if (rp_) y = uu; } *(u32x2*)(up + 16 * cb) = pack4(y); }
                }
            }
            GSYNC();
            for (int rep_ = 0; rep_ < 1 + (int)((REPMASK >> 4) & 1u); ++rep_) { PHASE_IDS
                bf16_t* Z = (bf16_t*)(R + R_Z); const bf16_t* VTg = (const bf16_t*)(R + 80 * MiB);
                const int l15 = lane & 15, quad = lane >> 4;
                const float Gq = wave_max(fabsf(P.in[6][e * 64 + lane])), Gk = wave_max(fabsf(P.in[7][e * 64 + lane]));
                const float thr = -(40.f + 2.f * 8.f * Gq * Gk * LOG2E);
                int hord = 0;
                { float tot[8];
#pragma unroll
                  for (int hh = 0; hh < 8; ++hh) tot[hh] = CGm[(size_t)(S - 1) * 8 + hh];
#pragma unroll
                  for (int hh = 0; hh < 8; ++hh) { int rank = 0;
#pragma unroll
                      for (int h2 = 0; h2 < 8; ++h2) rank += (tot[h2] > tot[hh] || (tot[h2] == tot[hh] && h2 < hh)) ? 1 : 0;
                      hord |= hh << (4 * rank); } }
                for (int item = bid; item < 512; item += G) {
                    const int half = (item >> 8) & 1, rk = half ? 7 - (item & 7) : (item & 7);
                    const int qb2 = 63 - (item >> 3), h = (hord >> (4 * rk)) & 7; const int q0 = 256 * qb2, qw = q0 + 32 * wid;
                    bf16x8 qf[2][2]; float c2q[2];
#pragma unroll
                    for (int rb = 0; rb < 2; ++rb) { const bf16_t* Qp = Z + (size_t)(qw + 16 * rb + l15) * ZW + 512 + 64 * h;
                        qf[rb][0] = *(const bf16x8*)(Qp + quad * 8); qf[rb][1] = *(const bf16x8*)(Qp + 32 + quad * 8); c2q[rb] = CGm[(size_t)(qw + 16 * rb + l15) * 8 + h]; }
                    const float c2q0 = CGm[(size_t)q0 * 8 + h];
                    float mrun[2] = {-1e30f, -1e30f}, lrun[2] = {0.f, 0.f}; f32x4 o[2][4];
#pragma unroll
                    for (int rb = 0; rb < 2; ++rb)
#pragma unroll
                        for (int db = 0; db < 4; ++db) o[rb][db] = (f32x4){0.f, 0.f, 0.f, 0.f};
                    const bf16_t* kbase = Z + (size_t)(tid >> 3) * ZW + 1536 + 64 * h + (tid & 7) * 8;
                    const bf16_t* vbase = VTg + (size_t)(h * 64 + (tid >> 3)) * S + (tid & 7) * 8;
                    const float* cbase = CGm + (size_t)lane * 8 + h;
                    u32x4 kreg, vreg; float ckreg;
#define ATT_LOAD(jj) do { kreg = *(const u32x4*)(kbase + (size_t)(64 * (jj)) * ZW); vreg = *(const u32x4*)(vbase + 64 * (jj)); ckreg = cbase[(size_t)(64 * (jj)) * 8]; } while (0)
#define ATT_STORE(bb) do { LAS unsigned char* lb = lds + (bb) * 18688; *(LAS u32x4*)(lb + ((tid >> 3) * 72 + (tid & 7) * 8) * 2) = kreg; *(LAS u32x4*)(lb + 9216 + ((tid >> 3) * 72 + (tid & 7) * 8) * 2) = vreg; if (wid == 0) ((LAS float*)(lb + 18432))[lane] = ckreg; } while (0)
                    int j = 4 * qb2 + 3;
                    ATT_LOAD(j); ATT_STORE(j & 1); ATT_LOAD(j - 1);
                    __syncthreads();
                    for (; j >= 0; --j) {
                        const int b = j & 1;
                        if (j > 0) { ATT_STORE(b ^ 1); if (j > 1) ATT_LOAD(j - 2); }
                        const LAS bf16_t* Ks = (const LAS bf16_t*)(lds + b * 18688); const LAS bf16_t* VT = (const LAS bf16_t*)(lds + b * 18688 + 9216); const LAS float* Ck = (const LAS float*)(lds + b * 18688 + 18432);
                        const bool stop = (64 * j + 63 < q0) && ((c2q0 - Ck[63]) < thr);
                        if (!stop && !(64 * j > qw + 31)) {
                            f32x4 s[2][4];
#pragma unroll
                            for (int kb = 0; kb < 4; ++kb) {
                                const LAS bf16_t* kp = Ks + (16 * kb + l15) * 72 + quad * 8;
                                const bf16x8 k0 = *(const LAS bf16x8*)kp, k1 = *(const LAS bf16x8*)(kp + 32);
                                const f32x4 ck4 = *(const LAS f32x4*)(Ck + 16 * kb + quad * 4);
#pragma unroll
                                for (int rb = 0; rb < 2; ++rb) {
                                    f32x4 z = (f32x4){0.f, 0.f, 0.f, 0.f};
                                    z = __builtin_amdgcn_mfma_f32_16x16x32_bf16(k0, qf[rb][0], z, 0, 0, 0);
                                    z = __builtin_amdgcn_mfma_f32_16x16x32_bf16(k1, qf[rb][1], z, 0, 0, 0);
                                    s[rb][kb] = z + (c2q[rb] - ck4);
                                }
                            }
                            if (64 * j + 63 > qw) {
#pragma unroll
                                for (int rb = 0; rb < 2; ++rb)
#pragma unroll
                                    for (int kb = 0; kb < 4; ++kb)
#pragma unroll
                                        for (int jj = 0; jj < 4; ++jj) if (64 * j + 16 * kb + 4 * quad + jj > qw + 16 * rb + l15) s[rb][kb][jj] = -1e30f;
                            }
                            bf16x8 pb[2][2];
#pragma unroll
                            for (int rb = 0; rb < 2; ++rb) {
                                float mx = -1e30f;
#pragma unroll
                                for (int kb = 0; kb < 4; ++kb) mx = fmaxf(fmaxf(mx, fmaxf(s[rb][kb][0], s[rb][kb][1])), fmaxf(s[rb][kb][2], s[rb][kb][3]));
                                mx = quad_max(mx);
                                if (__builtin_amdgcn_ballot_w64(mx > mrun[rb]) != 0ull) {
                                    const float mn_ = fmaxf(mrun[rb], mx); const float alpha = __builtin_amdgcn_exp2f(mrun[rb] - mn_); mrun[rb] = mn_; lrun[rb] *= alpha;
#pragma unroll
                                    for (int db = 0; db < 4; ++db) o[rb][db] = o[rb][db] * alpha;
                                }
                                const float mn = mrun[rb];
                                float ls = 0.f;
#pragma unroll
                                for (int kb = 0; kb < 4; ++kb)
#pragma unroll
                                    for (int jj = 0; jj < 4; ++jj) { s[rb][kb][jj] = __builtin_amdgcn_exp2f(s[rb][kb][jj] - mn); ls += s[rb][kb][jj]; }
                                lrun[rb] += ls;
#pragma unroll
                                for (int kk = 0; kk < 2; ++kk) { u32x4 pw; pw.x = cvt_pk_bf16(s[rb][2 * kk][0], s[rb][2 * kk][1]); pw.y = cvt_pk_bf16(s[rb][2 * kk][2], s[rb][2 * kk][3]);
                                    pw.z = cvt_pk_bf16(s[rb][2 * kk + 1][0], s[rb][2 * kk + 1][1]); pw.w = cvt_pk_bf16(s[rb][2 * kk + 1][2], s[rb][2 * kk + 1][3]); pb[rb][kk] = __builtin_bit_cast(bf16x8, pw); }
                            }
#pragma unroll
                            for (int kk = 0; kk < 2; ++kk)
#pragma unroll
                                for (int db = 0; db < 4; ++db) {
                                    const LAS bf16_t* vp = VT + (16 * db + l15) * 72 + 32 * kk + quad * 4;
                                    u32x4 vw; const u32x2 va = *(const LAS u32x2*)vp, vb = *(const LAS u32x2*)(vp + 16); vw.x = va.x; vw.y = va.y; vw.z = vb.x; vw.w = vb.y;
                                    const bf16x8 vf = __builtin_bit_cast(bf16x8, vw);
                                    o[0][db] = __builtin_amdgcn_mfma_f32_16x16x32_bf16(vf, pb[0][kk], o[0][db], 0, 0, 0);
                                    o[1][db] = __builtin_amdgcn_mfma_f32_16x16x32_bf16(vf, pb[1][kk], o[1][db], 0, 0, 0);
                                }
                        }
                        __syncthreads();
                        if (stop) break;
                    }
#undef ATT_LOAD
#undef ATT_STORE
#pragma unroll
                    for (int rb = 0; rb < 2; ++rb) {
                        const float lr = quad_sum(lrun[rb]);
                        const float inv = 1.0f / lr;
                        bf16_t* Op = Z + (size_t)(qw + 16 * rb + l15) * ZW + 512 + 64 * h + 4 * quad;
#pragma unroll
                        for (int db = 0; db < 4; ++db) *(u32x2*)(Op + 16 * db) = pack4(o[rb][db] * inv);
                    }
                }
            }
            GSYNC();
            for (int rep_ = 0; rep_ < 1 + (int)((REPMASK >> 5) & 1u); ++rep_) { PHASE_IDS
                pg8::Gemm g{(const bf16_t*)(R + R_Z), (const bf16_t*)(ws + WS_WOUT) + (size_t)e * 1024 * 1024, 1024, ZW, 256};
                pg8::StaticOrder so; so.init(64, 4, G, bid);
                pg8::EpiRes E{X, rep_ ? 0.f : 1.f};
                pg8::gemm_phase(lds, g, so, E);
            }
            GSYNC();
        } else {
            for (int rep_ = 0; rep_ < 1 + (int)((REPMASK >> 6) & 1u); ++rep_) { PHASE_IDS
                bf16_t* AG = (bf16_t*)(R + R_AG); bf16_t* TS = (bf16_t*)(R + R_TS); bf16_t* PS = (bf16_t*)(R + R_PS);
                const float* gmix = P.in[2] + L * D;
                for (int t = gw; t < S; t += NGW) { f32x4 v[4]; const float rs = load_row(X + (size_t)t * D, lane, v);
#pragma unroll
                    for (int j = 0; j < 4; ++j) { const f32x4 gg = *((const f32x4*)gmix + lane + 64 * j); v[j] = v[j] * rs * gg; const int d = 4 * lane + 256 * j; const int g = d >> 4, c = d & 15;
                        *(u32x2*)(AG + (size_t)(g * 512 + (t >> 5)) * 640 + (t & 31) * 16 + c) = pack4(v[j]); } }
                const float* a_re = P.in[12] + e * 4096; const float* a_im = P.in[13] + e * 4096; const float* ldt = P.in[14] + e * 64;
                const float* b_re = P.in[15] + (size_t)e * 65536; const float* b_im = P.in[16] + (size_t)e * 65536; const float* c_re = P.in[17] + (size_t)e * 65536; const float* c_im = P.in[18] + (size_t)e * 65536;
                LAS float* Wr = (LAS float*)lds; LAS float* Wi = Wr + 64; LAS float* Pr = Wr + 128; LAS float* Pi = Wr + 192;
                for (int it = bid; it < 2048; it += G) {
                    const int g = it >> 5, j = it & 31;
                    __syncthreads();
                    if (tid < 64) { const int p = tid; const float dt = expf(ldt[g]), lr = a_re[g * 64 + p], li = a_im[g * 64 + p];
                        float s1, c1; sincosf(li * dt, &s1, &c1); const float e1 = expf(lr * dt); const float abr = e1 * c1, abi = e1 * s1;
                        const float den = lr * lr + li * li, nr = abr - 1.0f, ni = abi; const float cr = (nr * lr + ni * li) / den, ci = (ni * lr - nr * li) / den;
                        float sj, cj; sincosf((float)j * (li * dt), &sj, &cj); const float ej = expf((float)j * (lr * dt)); const float ajr = ej * cj, aji = ej * sj;
                        Wr[p] = ajr * cr - aji * ci; Wi[p] = ajr * ci + aji * cr;
                        float sp, cp; sincosf((float)(j + 1) * (li * dt), &sp, &cp); const float ep = expf((float)(j + 1) * (lr * dt)); Pr[p] = ep * cp; Pi[p] = ep * sp; }
                    __syncthreads();
                    if (tid < 256) { const int c = tid >> 4, cq = tid & 15; float acc = 0.f;
                        for (int p = 0; p < 64; ++p) { const float Cr = c_re[((size_t)g * 16 + c) * 64 + p], Ci = c_im[((size_t)g * 16 + c) * 64 + p]; const float wr_ = Wr[p], wi_ = Wi[p];
                            const float cwr = Cr * wr_ - Ci * wi_, cwi = Cr * wi_ + Ci * wr_; const float br = b_re[((size_t)g * 64 + p) * 16 + cq], bi = b_im[((size_t)g * 64 + p) * 16 + cq];
                            acc += cwr * br - cwi * bi; }
                        const bf16_t kv = (bf16_t)(cvt_pk_bf16(acc, 0.f) & 0xffffu);
                        for (int s = 0; s + j < 32; ++s) { TS[(size_t)(g * 512 + (j + s) * 16 + c) * 640 + s * 16 + cq] = kv; if (j >= 1) TS[(size_t)(g * 512 + s * 16 + c) * 640 + (s + j) * 16 + cq] = 0; }
                    } else {
#pragma unroll 1
                        for (int k = 0; k < 8; ++k) { const int idx = (tid - 256) + 256 * k; const int c = idx >> 7, rp = idx & 127, p = rp & 63;
                            const float Cr = c_re[((size_t)g * 16 + c) * 64 + p], Ci = c_im[((size_t)g * 16 + c) * 64 + p];
                            const float val = (rp < 64) ? (Cr * Pr[p] - Ci * Pi[p]) : -(Cr * Pi[p] + Ci * Pr[p]);
                            TS[(size_t)(g * 512 + j * 16 + c) * 640 + 512 + rp] = (bf16_t)(cvt_pk_bf16(val, 0.f) & 0xffffu); }
                    }
                    { const int s = 31 - j;
#pragma unroll 1
                      for (int k = 0; k < 4; ++k) { const int idx = tid + 512 * k; const int rp = idx >> 4, cq = idx & 15, p = rp & 63;
                          const float br = b_re[((size_t)g * 64 + p) * 16 + cq], bi = b_im[((size_t)g * 64 + p) * 16 + cq];
                          const float val = (rp < 64) ? (Wr[p] * br - Wi[p] * bi) : (Wr[p] * bi + Wi[p] * br);
                          PS[(size_t)(g * 256 + rp) * 512 + s * 16 + cq] = (bf16_t)(cvt_pk_bf16(val, 0.f) & 0xffffu);
                          PS[(size_t)(g * 256 + 128 + rp) * 512 + s * 16 + cq] = 0; } }
                }
            }
            GSYNC();
            for (int rep_ = 0; rep_ < 1 + (int)((REPMASK >> 7) & 1u); ++rep_) { PHASE_IDS
                pg8::Gemm g{(const bf16_t*)(R + R_AG), (const bf16_t*)(R + R_PS), 512, 640, 256};
                pg8::OrderS5E so{G, bid};
                pg8::EpiE E{(float*)(R + R_E)};
                pg8::gemm_phase(lds, g, so, E);
            }
            GSYNC();
            for (int rep_ = 0; rep_ < 1 + (int)((REPMASK >> 8) & 1u); ++rep_) { PHASE_IDS
                bf16_t* AG = (bf16_t*)(R + R_AG); const float* Eb = (const float*)(R + R_E);
                const float* a_re = P.in[12] + e * 4096; const float* a_im = P.in[13] + e * 4096; const float* ldt = P.in[14] + e * 64;
                LAS float* Tr = (LAS float*)lds; LAS float* Ti = Tr + 512;
                for (int g = bid; g < 64; g += G) {
                    const int p = lane, seg = wid;
                    const float dt = expf(ldt[g]), lr = a_re[g * 64 + p], li = a_im[g * 64 + p];
                    float sA, cA; sincosf(32.f * (li * dt), &sA, &cA); const float eA = expf(32.f * (lr * dt)); const float ar = eA * cA, ai = eA * sA;
                    float sB, cB; sincosf(2048.f * (li * dt), &sB, &cB); const float eB = expf(2048.f * (lr * dt)); const float br = eB * cB, bi = eB * sB;
                    float xr = 0.f, xi = 0.f;
#pragma unroll 8
                    for (int n = 64 * seg; n < 64 * seg + 64; ++n) { const float er = Eb[(size_t)(g * 512 + n) * 128 + p], ei = Eb[(size_t)(g * 512 + n) * 128 + 64 + p];
                        const float nr = ar * xr - ai * xi + er, ni = ar * xi + ai * xr + ei; xr = nr; xi = ni; }
                    __syncthreads();
                    Tr[seg * 64 + p] = xr; Ti[seg * 64 + p] = xi;
                    __syncthreads();
                    xr = 0.f; xi = 0.f;
                    for (int s2 = 0; s2 < seg; ++s2) { const float nr = br * xr - bi * xi + Tr[s2 * 64 + p], ni = br * xi + bi * xr + Ti[s2 * 64 + p]; xr = nr; xi = ni; }
#pragma unroll 8
                    for (int n = 64 * seg; n < 64 * seg + 64; ++n) { const float er = Eb[(size_t)(g * 512 + n) * 128 + p], ei = Eb[(size_t)(g * 512 + n) * 128 + 64 + p];
                        bf16_t* sp = AG + (size_t)(g * 512 + n) * 640 + 512 + p; sp[0] = (bf16_t)(cvt_pk_bf16(xr, 0.f) & 0xffffu); sp[64] = (bf16_t)(cvt_pk_bf16(xi, 0.f) & 0xffffu);
                        const float nr = ar * xr - ai * xi + er, ni = ar * xi + ai * xr + ei; xr = nr; xi = ni; }
                }
            }
            GSYNC();
            for (int rep_ = 0; rep_ < 1 + (int)((REPMASK >> 9) & 1u); ++rep_) { PHASE_IDS
                pg8::Gemm g{(const bf16_t*)(R + R_AG), (const bf16_t*)(R + R_TS), 640, 640, 256};
                pg8::OrderS5Y so{G, bid};
                pg8::EpiY E{(const bf16_t*)(R + R_AG), P.in[19] + e * D, (bf16_t*)(R + R_G)};
                pg8::gemm_phase(lds, g, so, E);
            }
            GSYNC();
            for (int rep_ = 0; rep_ < 1 + (int)((REPMASK >> 10) & 1u); ++rep_) { PHASE_IDS
                pg8::Gemm g{(const bf16_t*)(R + R_G), (const bf16_t*)(ws + WS_WGLU) + (size_t)e * 2048 * 1024, 1024, 1024, 256};
                pg8::StaticOrder so; so.init(64, 8, G, bid);
                pg8::EpiGlu E{X, rep_ ? 0.f : 1.f};
                pg8::gemm_phase(lds, g, so, E);
            }
            GSYNC();
        }
        for (int rep_ = 0; rep_ < 1 + (int)((REPMASK >> 11) & 1u); ++rep_) { PHASE_IDS
            const float* gf = P.in[3] + L * D;
            for (int t = gw; t < S; t += NGW) { f32x4 v[4]; const float rs = load_row(X + (size_t)t * D, lane, v);
#pragma unroll
                for (int j = 0; j < 4; ++j) { const f32x4 gg = *((const f32x4*)gf + lane + 64 * j); *((u32x2*)(HN + (size_t)t * D) + lane + 64 * j) = pack4(v[j] * rs * gg); } }
        }
        GSYNC();
        for (int rep_ = 0; rep_ < 1 + (int)((REPMASK >> 12) & 1u); ++rep_) { PHASE_IDS
            pg8::Gemm g{HNA, (const bf16_t*)(ws + WS_WUP) + (size_t)L * 5632 * 1024, 1024, 1024, 254};
            pg8::StaticOrder so; so.init(65, 22, G, bid);
            pg8::EpiConv E{(bf16_t*)(R + R_ACT), P.in[22] + (size_t)L * 3 * 5632, P.in[23] + (size_t)L * 5632, lds + XL_OFF};
            pg8::gemm_phase(lds, g, so, E);
        }
        GSYNC();
        for (int rep_ = 0; rep_ < 1 + (int)((REPMASK >> 13) & 1u); ++rep_) { PHASE_IDS
            pg8::Gemm g{(const bf16_t*)(R + R_ACT), (const bf16_t*)(ws + WS_WDN) + (size_t)L * 1024 * 2816, 2816, 2816, 256};
            pg8::StaticOrder so; so.init(64, 4, G, bid);
            pg8::EpiRes E{X, rep_ ? 0.f : 1.f};
            pg8::gemm_phase(lds, g, so, E);
        }
        GSYNC();
        for (int rep_ = 0; rep_ < 1 + (int)((REPMASK >> 14) & 1u); ++rep_) { PHASE_IDS
            const float* pin = P.in[1] + (size_t)L * S * 256; bf16_t* PB = (bf16_t*)(R + R_PB);
            for (int t = gw; t < S; t += NGW) { f32x4 v[4]; const float rs = load_row(X + (size_t)t * D, lane, v);
#pragma unroll
                for (int j = 0; j < 4; ++j) *((u32x2*)(HN + (size_t)t * D) + lane + 64 * j) = pack4(v[j] * rs);
                const f32x4 pv = *((const f32x4*)(pin + (size_t)t * 256) + lane); *((u32x2*)(PB + (size_t)t * 256) + lane) = pack4(pv); }
        }
        GSYNC();
        for (int rep_ = 0; rep_ < 1 + (int)((REPMASK >> 15) & 1u); ++rep_) { PHASE_IDS
            pg8::StaticOrder so; so.init(64, 4, G, bid);
            { pg8::Gemm g{(const bf16_t*)(R + R_PB), (const bf16_t*)(ws + WS_WPR) + (size_t)L * 1024 * 256, 256, 256, 256};
              pg8::EpiStore E{(bf16_t*)(R + R_PP), D, 0};
              pg8::gemm_phase(lds, g, so, E); }
            asm volatile("s_waitcnt vmcnt(0)" ::: "memory"); __syncthreads();
            { pg8::Gemm g{HN, (const bf16_t*)(ws + WS_WGT) + (size_t)L * 1024 * 1024, 1024, 1024, 256};
              pg8::EpiGate E{X, (const bf16_t*)(R + R_PP), rep_ ? 0.f : 1.f};
              pg8::gemm_phase(lds, g, so, E); }
        }
        GSYNC();
        for (int xs = 0; xs < XSYNC; ++xs) GSYNC();
    }
}

extern "C" void kernel_launch(void* const* d_in, const int* in_sizes, int n_in, void* d_out, int out_size, void* d_ws, size_t ws_size, hipStream_t stream) {
    static int grid = 0;
    if (grid == 0) {
        if (n_in != 27 || out_size != S * D || ws_size < WS_END) { fprintf(stderr, "kernel_launch: unexpected shapes (n_in %d out %d ws %zu need %zu)\n", n_in, out_size, ws_size, (size_t)WS_END); grid = -1; return; }
        int dev = 0, cus = 0, per_cu = 0;
        hipGetDevice(&dev); hipDeviceGetAttribute(&cus, hipDeviceAttributeMultiprocessorCount, dev);
        hipFuncSetAttribute((const void*)mega, hipFuncAttributeMaxDynamicSharedMemorySize, LDS_BYTES);
        hipOccupancyMaxActiveBlocksPerMultiprocessor(&per_cu, (const void*)mega, 512, LDS_BYTES);
        if (per_cu < 1) per_cu = 1;
        grid = cus * per_cu;
    }
    if (grid < 0) return;
    Params p{};
    for (int i = 0; i < 27; ++i) p.in[i] = (const float*)d_in[i];
    p.out = (float*)d_out; p.ws = (unsigned char*)d_ws;
    hipMemsetAsync((char*)d_ws + WS_BAR, 0, BAR_BYTES, stream);
    void* args[] = {&p};
    hipError_t err = hipLaunchCooperativeKernel((const void*)mega, dim3(grid), dim3(512), args, LDS_BYTES, stream);
    if (err != hipSuccess) fprintf(stderr, "cooperative launch failed: %s (grid %d)\n", hipGetErrorString(err), grid);
}
```

```cpp
#include <hip/hip_runtime.h>
#include <hip/hip_cooperative_groups.h>
#include <cstdio>
#include <cstdint>
namespace cg = cooperative_groups;

#define LAS __attribute__((address_space(3)))
typedef unsigned short bf16_t;
typedef short bf16x8 __attribute__((ext_vector_type(8)));
typedef float f32x4 __attribute__((ext_vector_type(4)));
typedef unsigned u32x4 __attribute__((ext_vector_type(4)));
typedef unsigned u32x2 __attribute__((ext_vector_type(2)));

constexpr int S = 16384, D = 1024, FF = 2816, ZW = 2560;
constexpr float EPS = 1e-6f;
constexpr float LOG2E = 1.4426950408889634f;

__device__ __forceinline__ unsigned cvt_pk_bf16(float lo, float hi) { unsigned r; asm volatile("v_cvt_pk_bf16_f32 %0, %1, %2" : "=v"(r) : "v"(lo), "v"(hi)); return r; }
__device__ __forceinline__ float bf2f(unsigned b) { return __uint_as_float(b << 16); }
__device__ __forceinline__ float sigm(float z) { return __builtin_amdgcn_rcpf(1.f + __builtin_amdgcn_exp2f(-LOG2E * z)); }
__device__ __forceinline__ float gelu_t(float x) { const float z = 1.5957691216057308f * (x + 0.044715f * x * x * x); return x * sigm(z); }
__device__ __forceinline__ u32x2 pack4(f32x4 v) { u32x2 w; w.x = cvt_pk_bf16(v[0], v[1]); w.y = cvt_pk_bf16(v[2], v[3]); return w; }
__device__ __forceinline__ f32x4 unpack4(u32x2 w) { return (f32x4){bf2f(w.x & 0xffffu), bf2f(w.x >> 16), bf2f(w.y & 0xffffu), bf2f(w.y >> 16)}; }
#define DPPF(v, ctrl) __int_as_float(__builtin_amdgcn_update_dpp(0, __float_as_int(v), (ctrl), 0xf, 0xf, false))
__device__ __forceinline__ float x1_sum(float v) { return v + DPPF(v, 0xB1); }
__device__ __forceinline__ float x2_sum(float v) { v += DPPF(v, 0xB1); return v + DPPF(v, 0x4E); }
__device__ __forceinline__ float x3_sum(float v) { v = x2_sum(v); return v + DPPF(v, 0x141); }
__device__ __forceinline__ float row_sum(float v) { v = x3_sum(v); return v + DPPF(v, 0x140); }
__device__ __forceinline__ float row_max(float v) { v = fmaxf(v, DPPF(v, 0xB1)); v = fmaxf(v, DPPF(v, 0x4E)); v = fmaxf(v, DPPF(v, 0x141)); return fmaxf(v, DPPF(v, 0x140)); }
__device__ __forceinline__ float quad_max(float v) {
    auto a = __builtin_amdgcn_permlane16_swap(__float_as_uint(v), __float_as_uint(v), false, false); v = fmaxf(__uint_as_float(a[0]), __uint_as_float(a[1]));
    auto b = __builtin_amdgcn_permlane32_swap(__float_as_uint(v), __float_as_uint(v), false, false); return fmaxf(__uint_as_float(b[0]), __uint_as_float(b[1]));
}
__device__ __forceinline__ float quad_sum(float v) {
    auto a = __builtin_amdgcn_permlane16_swap(__float_as_uint(v), __float_as_uint(v), false, false); v = __uint_as_float(a[0]) + __uint_as_float(a[1]);
    auto b = __builtin_amdgcn_permlane32_swap(__float_as_uint(v), __float_as_uint(v), false, false); return __uint_as_float(b[0]) + __uint_as_float(b[1]);
}
__device__ __forceinline__ float wave_sum(float v) { return quad_sum(row_sum(v)); }
__device__ __forceinline__ float wave_max(float v) { return quad_max(row_max(v)); }

namespace pg8 {
constexpr int BM = 256, BK = 64, HALF = 128, HTB = HALF * BK * 2, STAGE_BYTES = 8 * HTB, NXCD = 8, WGM = 8;
__host__ __device__ __forceinline__ int lds_byte(int r, int c) { const int st = (r >> 4) * 2 + (c >> 5), rr = r & 15, cc = c & 31, ob = rr * 64 + cc * 2; return st * 1024 + (ob ^ (((ob >> 9) & 1) << 5)); }
__host__ __device__ __forceinline__ void stage_rc(int b, int& R, int& C) { const int st = b / 1024, sb = b % 1024, swz = sb ^ (((sb >> 9) & 1) << 5); R = (st >> 1) * 16 + swz / 64; C = (st & 1) * 32 + (swz % 64) / 2; }
struct Unit { int pm, pn; };
struct Gemm { const bf16_t* A; const bf16_t* Bt; int K, lda, arows; };

struct StaticOrder {
    int nM, nN, nwg, G, c;
    __device__ void init(int nM_, int nN_, int G_, int c_) { nM = nM_; nN = nN_; nwg = nM * nN; G = G_; c = c_; }
    __device__ bool next(int i, Unit& u) const {
        const long L = (long)i * G + c; if (L >= nwg) return false;
        int wgid = (int)L; { const int q = nwg / NXCD, r = nwg % NXCD, xcd = wgid % NXCD, off = wgid / NXCD; wgid = (xcd < r ? xcd * (q + 1) : r * (q + 1) + (xcd - r) * q) + off; }
        const int nig = WGM * nN, gid = wgid / nig, fm = gid * WGM, gsz = (nM - fm) < WGM ? (nM - fm) : WGM;
        u.pm = fm + ((wgid % nig) % gsz); u.pn = (wgid % nig) / gsz; return true;
    }
};
struct OrderS5E { int G, c; __device__ bool next(int i, Unit& u) const { const int L = i * G + c; if (L >= 128) return false; u.pm = L; u.pn = L >> 1; return true; } };
struct OrderS5Y { int G, c; __device__ bool next(int i, Unit& u) const { const int L = i * G + c; if (L >= 256) return false; const int g = L >> 2; u.pm = 2 * g + ((L >> 1) & 1); u.pn = 2 * g + (L & 1); return true; } };

template <class Epi, class Sched>
__device__ __forceinline__ void gemm_phase(LAS unsigned char* lds, const Gemm g, const Sched& S, const Epi& E) {
    int tid_ = threadIdx.x; asm volatile("" : "+v"(tid_));
    const int tid = tid_, wid = __builtin_amdgcn_readfirstlane(tid >> 6), lane = tid & 63, wr = wid >> 2, wc = wid & 3, fr = lane & 15, fq = lane >> 4;
    const int K = g.K, nt = K / BK, lda = g.lda;
    unsigned voffA[2], voffB[2];
#pragma unroll
    for (int i = 0; i < 2; ++i) { int R, C; stage_rc(tid * 16 + i * 8192, R, C); voffA[i] = (unsigned)(R * lda + C) * 2u; voffB[i] = (unsigned)(R * K + C) * 2u; }
    const size_t kstep = (size_t)(BK * 2);
    const size_t hstepA = (size_t)HALF * lda * 2, hstepB = (size_t)HALF * K * 2;
    const size_t tstepA = (size_t)g.arows * lda * 2, tstepB = 2 * hstepB;
    const unsigned ldsw = (unsigned)wid * 1024u;
    const int aoff = lds_byte(wr * 64 + fr, fq * 8), boff = lds_byte(wc * 32 + fr, fq * 8);
#define PG8_SA(b, h) (((b) * 2 + (h)) * HTB)
#define PG8_SB(b, h) ((4 + (b) * 2 + (h)) * HTB)
#define PG8_STAGE(bufoff, gbase, voff) do { _Pragma("unroll") for (int _i = 0; _i < 2; ++_i) \
        __builtin_amdgcn_global_load_lds((const unsigned*)((const char*)(gbase) + (voff)[_i]), (LAS unsigned*)(lds + (bufoff) + ldsw + _i * 8192), 16, 0, 0); } while (0)
#define PG8_LDA(dst, b, h) do { _Pragma("unroll") for (int m = 0; m < 4; ++m) _Pragma("unroll") for (int k = 0; k < 2; ++k) dst[m][k] = *(const LAS bf16x8*)(lds + PG8_SA(b, h) + aoff + m * 2048 + k * 1024); } while (0)
#define PG8_LDB(dst, b, h) do { _Pragma("unroll") for (int n = 0; n < 2; ++n) _Pragma("unroll") for (int k = 0; k < 2; ++k) dst[n][k] = *(const LAS bf16x8*)(lds + PG8_SB(b, h) + boff + n * 2048 + k * 1024); } while (0)
#define PG8_MMA(ai, bj, At, Bt) do { __builtin_amdgcn_s_setprio(1); _Pragma("unroll") for (int m = 0; m < 4; ++m) _Pragma("unroll") for (int n = 0; n < 2; ++n) _Pragma("unroll") for (int k = 0; k < 2; ++k) \
        acc[ai][bj][m][n] = __builtin_amdgcn_mfma_f32_16x16x32_bf16(Bt[n][k], At[m][k], acc[ai][bj][m][n], 0, 0, 0); __builtin_amdgcn_s_setprio(0); } while (0)
#define PG8_WAIT_V(n) asm volatile("s_waitcnt vmcnt(" #n ")" ::: "memory")
#define PG8_WAIT_L(n) asm volatile("s_waitcnt lgkmcnt(" #n ")" ::: "memory")
#define PG8_BAR __builtin_amdgcn_s_barrier()
#define PG8_SCHED __builtin_amdgcn_sched_barrier(0)
    Unit cur, nxt; int ui = 0;
    if (!S.next(0, cur)) return;
    f32x4 acc[2][2][4][2];
#pragma unroll
    for (int a = 0; a < 2; ++a)
#pragma unroll
        for (int b = 0; b < 2; ++b)
#pragma unroll
            for (int m = 0; m < 4; ++m)
#pragma unroll
                for (int n = 0; n < 2; ++n) acc[a][b][m][n] = (f32x4){0.f, 0.f, 0.f, 0.f};
    bf16x8 At[4][2], B0[2][2], B1[2][2];
    const char* cA = (const char*)g.A + (size_t)cur.pm * tstepA; const char* cB = (const char*)g.Bt + (size_t)cur.pn * tstepB;
    PG8_STAGE(PG8_SB(0, 0), cB, voffB); PG8_STAGE(PG8_SB(0, 1), cB + hstepB, voffB); PG8_STAGE(PG8_SA(0, 0), cA, voffA); PG8_STAGE(PG8_SA(0, 1), cA + hstepA, voffA);
    if (wr == 1) PG8_BAR;
    PG8_WAIT_V(2); PG8_BAR;
    PG8_STAGE(PG8_SB(1, 0), cB + kstep, voffB); PG8_STAGE(PG8_SA(1, 0), cA + kstep, voffA); PG8_STAGE(PG8_SB(1, 1), cB + hstepB + kstep, voffB);
    PG8_WAIT_V(6); PG8_BAR;
    for (;;) {
        const bool has_next = S.next(ui + 1, nxt);
        const char* nA = has_next ? (const char*)g.A + (size_t)nxt.pm * tstepA : cA; const char* nB = has_next ? (const char*)g.Bt + (size_t)nxt.pn * tstepB : cB;
        for (int t = 0; t < nt; t += 2) {
            const bool last = (t == nt - 2);
            const char* a1 = cA + (size_t)(t + 1) * kstep;
            const char* a2 = last ? nA : cA + (size_t)(t + 2) * kstep; const char* b2 = last ? nB : cB + (size_t)(t + 2) * kstep;
            const char* a3 = a2 + kstep; const char* b3 = b2 + kstep;
            PG8_LDB(B0, 0, 0); PG8_LDB(B1, 0, 1); PG8_SCHED; PG8_LDA(At, 0, 0); PG8_STAGE(PG8_SA(1, 1), a1 + hstepA, voffA);
            PG8_WAIT_V(8); PG8_WAIT_L(0); PG8_BAR; PG8_MMA(0, 0, At, B0); PG8_MMA(0, 1, At, B1); PG8_BAR; PG8_SCHED;
            PG8_LDA(At, 0, 1); PG8_STAGE(PG8_SB(0, 0), b2, voffB); PG8_STAGE(PG8_SB(0, 1), b2 + hstepB, voffB); PG8_STAGE(PG8_SA(0, 0), a2, voffA);
            PG8_WAIT_V(8); PG8_WAIT_L(0); PG8_BAR; PG8_MMA(1, 0, At, B0); PG8_MMA(1, 1, At, B1); PG8_BAR; PG8_SCHED;
            PG8_LDB(B0, 1, 0); PG8_LDB(B1, 1, 1); PG8_SCHED; PG8_LDA(At, 1, 0); PG8_STAGE(PG8_SA(0, 1), a2 + hstepA, voffA);
            PG8_WAIT_V(8); PG8_WAIT_L(0); PG8_BAR; PG8_MMA(0, 0, At, B0); PG8_MMA(0, 1, At, B1); PG8_BAR; PG8_SCHED;
            PG8_LDA(At, 1, 1); PG8_STAGE(PG8_SB(1, 0), b3, voffB); PG8_STAGE(PG8_SB(1, 1), b3 + hstepB, voffB); PG8_STAGE(PG8_SA(1, 0), a3, voffA);
            PG8_WAIT_V(8); PG8_WAIT_L(0); PG8_BAR; PG8_MMA(1, 0, At, B0); PG8_MMA(1, 1, At, B1); PG8_BAR; PG8_SCHED;
        }
        if (wr == 0) PG8_BAR;
        E(acc, cur, wr, wc, fr, fq);
        if (!has_next) break;
#pragma unroll
        for (int a = 0; a < 2; ++a)
#pragma unroll
            for (int b = 0; b < 2; ++b)
#pragma unroll
                for (int m = 0; m < 4; ++m)
#pragma unroll
                    for (int n = 0; n < 2; ++n) acc[a][b][m][n] = (f32x4){0.f, 0.f, 0.f, 0.f};
        cur = nxt; cA = nA; cB = nB; ++ui;
        if (wr == 1) PG8_BAR;
    }
    PG8_WAIT_V(0);
    PG8_BAR;
#undef PG8_SA
#undef PG8_SB
#undef PG8_STAGE
#undef PG8_LDA
#undef PG8_LDB
#undef PG8_MMA
#undef PG8_WAIT_V
#undef PG8_WAIT_L
#undef PG8_BAR
#undef PG8_SCHED
}

typedef f32x4 Acc[2][2][4][2];
__device__ __forceinline__ float row_rs(const float* SSP, int row, int nsl) {
    const f32x4 a = *(const f32x4*)(SSP + (size_t)row * 8); float s = (a[0] + a[1]) + (a[2] + a[3]);
    if (nsl == 8) { const f32x4 b = *(const f32x4*)(SSP + (size_t)row * 8 + 4); s += (b[0] + b[1]) + (b[2] + b[3]); }
    return __builtin_amdgcn_rsqf(s * (1.f / D) + EPS);
}
__device__ __forceinline__ void ss_publish(LAS float* ssl, float* SSP, int row0, int slot, int wr, int wc, int fr, int fq) {
    asm volatile("s_waitcnt lgkmcnt(0)" ::: "memory"); __builtin_amdgcn_s_barrier(); asm volatile("" ::: "memory");
    const int t = (wr * 4 + wc) * 64 + fq * 16 + fr;
    if (t < 256) SSP[(size_t)(row0 + t) * 8 + slot] = (ssl[t] + ssl[256 + t]) + (ssl[512 + t] + ssl[768 + t]);
}
struct EpiRes {
    float* X_; bf16_t* XB_; float* SS; LAS float* ssl;
    __device__ __forceinline__ void operator()(Acc& acc, const Unit& u, int wr, int wc, int fr, int fq) const {
        float* __restrict__ X = X_; bf16_t* __restrict__ XB = XB_;
#pragma unroll
        for (int ai = 0; ai < 2; ++ai)
#pragma unroll
            for (int m = 0; m < 4; ++m) { const int rl = ai * 128 + wr * 64 + m * 16 + fr, row = u.pm * 256 + rl; const size_t off = (size_t)row * D + u.pn * 256 + wc * 32 + 4 * fq; float ssum = 0.f;
#pragma unroll
                for (int bj = 0; bj < 2; ++bj)
#pragma unroll
                    for (int n = 0; n < 2; ++n) { f32x4* q = (f32x4*)(X + off + bj * 128 + n * 16); const f32x4 x = *q + acc[ai][bj][m][n]; *q = x;
                        *(u32x2*)(XB + off + bj * 128 + n * 16) = pack4(x); ssum += (x[0] * x[0] + x[1] * x[1]) + (x[2] * x[2] + x[3] * x[3]); }
                ssum = quad_sum(ssum); if (fq == 0) ssl[wc * 256 + rl] = ssum; }
        ss_publish(ssl, SS, u.pm * 256, u.pn, wr, wc, fr, fq);
    }
};
struct EpiStore {
    bf16_t* O; int ld; int mode;
    __device__ __forceinline__ void operator()(Acc& acc, const Unit& u, int wr, int wc, int fr, int fq) const {
        const bool act = mode == 1 && (u.pn < 2 || u.pn == 4 || u.pn == 5);
#pragma unroll
        for (int ai = 0; ai < 2; ++ai)
#pragma unroll
            for (int m = 0; m < 4; ++m) { bf16_t* rp = O + (size_t)(u.pm * 256 + ai * 128 + wr * 64 + m * 16 + fr) * ld + u.pn * 256 + wc * 32 + 4 * fq;
#pragma unroll
                for (int bj = 0; bj < 2; ++bj)
#pragma unroll
                    for (int n = 0; n < 2; ++n) { f32x4 v = acc[ai][bj][m][n];
                        if (act) { v[0] = gelu_t(v[0]); v[1] = gelu_t(v[1]); v[2] = gelu_t(v[2]); v[3] = gelu_t(v[3]); }
                        *(u32x2*)(rp + bj * 128 + n * 16) = pack4(v); } }
    }
};
struct EpiGate {
    float* X_; const bf16_t* PP_; const float* SS_;
    __device__ __forceinline__ void operator()(Acc& acc, const Unit& u, int wr, int wc, int fr, int fq) const {
        float* __restrict__ X = X_; const bf16_t* __restrict__ PP = PP_; const float* __restrict__ SS = SS_;
#pragma unroll
        for (int ai = 0; ai < 2; ++ai)
#pragma unroll
            for (int m = 0; m < 4; ++m) { const int row = u.pm * 256 + ai * 128 + wr * 64 + m * 16 + fr; const float rs = row_rs(SS, row, 4); const size_t off = (size_t)row * D + u.pn * 256 + wc * 32 + 4 * fq;
#pragma unroll
                for (int bj = 0; bj < 2; ++bj)
#pragma unroll
                    for (int n = 0; n < 2; ++n) { const f32x4 a = acc[ai][bj][m][n] * rs; const f32x4 pp = unpack4(*(const u32x2*)(PP + off + bj * 128 + n * 16));
                        f32x4* q = (f32x4*)(X + off + bj * 128 + n * 16); f32x4 x = *q;
                        x[0] += sigm(a[0]) * pp[0]; x[1] += sigm(a[1]) * pp[1]; x[2] += sigm(a[2]) * pp[2]; x[3] += sigm(a[3]) * pp[3]; *q = x; } }
    }
};
struct EpiGlu {
    float* X_; bf16_t* XB_; float* SS; LAS float* ssl;
    __device__ __forceinline__ void operator()(Acc& acc, const Unit& u, int wr, int wc, int fr, int fq) const {
        float* __restrict__ X = X_; bf16_t* __restrict__ XB = XB_;
#pragma unroll
        for (int ai = 0; ai < 2; ++ai)
#pragma unroll
            for (int m = 0; m < 4; ++m) { const int rl = ai * 128 + wr * 64 + m * 16 + fr, row = u.pm * 256 + rl; const size_t off = (size_t)row * D + u.pn * 128 + wc * 32 + 4 * fq; float ssum = 0.f;
#pragma unroll
                for (int n = 0; n < 2; ++n) { const f32x4 a = acc[ai][0][m][n], b = acc[ai][1][m][n]; f32x4* q = (f32x4*)(X + off + n * 16); f32x4 x = *q;
                    x[0] += a[0] * sigm(b[0]); x[1] += a[1] * sigm(b[1]); x[2] += a[2] * sigm(b[2]); x[3] += a[3] * sigm(b[3]); *q = x;
                    *(u32x2*)(XB + off + n * 16) = pack4(x); ssum += (x[0] * x[0] + x[1] * x[1]) + (x[2] * x[2] + x[3] * x[3]); }
                ssum = quad_sum(ssum); if (fq == 0) ssl[wc * 256 + rl] = ssum; }
        ss_publish(ssl, SS, u.pm * 256, u.pn, wr, wc, fr, fq);
    }
};
struct EpiE {
    float* Eo;
    __device__ __forceinline__ void operator()(Acc& acc, const Unit& u, int wr, int wc, int fr, int fq) const {
#pragma unroll
        for (int ai = 0; ai < 2; ++ai)
#pragma unroll
            for (int m = 0; m < 4; ++m) { float* rp = Eo + (size_t)(u.pm * 256 + ai * 128 + wr * 64 + m * 16 + fr) * 128 + wc * 32 + 4 * fq;
#pragma unroll
                for (int n = 0; n < 2; ++n) *(f32x4*)(rp + n * 16) = acc[ai][0][m][n]; }
    }
};
struct EpiY {
    const bf16_t* AG_; const float* Dv; bf16_t* Gm_;
    __device__ __forceinline__ void operator()(Acc& acc, const Unit& u, int wr, int wc, int fr, int fq) const {
        const bf16_t* __restrict__ AG = AG_; bf16_t* __restrict__ Gm = Gm_;
        const int g = u.pm >> 1, jj = u.pn & 1; const f32x4 d4 = *(const f32x4*)(Dv + g * 16 + 4 * fq);
#pragma unroll
        for (int ai = 0; ai < 2; ++ai)
#pragma unroll
            for (int m = 0; m < 4; ++m) { const int rowA = u.pm * 256 + ai * 128 + wr * 64 + m * 16 + fr; const int nchunk = rowA - g * 512;
#pragma unroll
                for (int bj = 0; bj < 2; ++bj)
#pragma unroll
                    for (int n = 0; n < 2; ++n) { const int sp = 16 * jj + 8 * bj + 2 * wc + n; const int t = nchunk * 32 + sp;
                        const f32x4 uu = unpack4(*(const u32x2*)(AG + (size_t)rowA * 640 + sp * 16 + 4 * fq));
                        f32x4 y = acc[ai][bj][m][n] + d4 * uu; y[0] = gelu_t(y[0]); y[1] = gelu_t(y[1]); y[2] = gelu_t(y[2]); y[3] = gelu_t(y[3]);
                        *(u32x2*)(Gm + (size_t)t * D + g * 16 + 4 * fq) = pack4(y); } }
    }
};
__device__ __forceinline__ float dpp_ror1(float v) { return __int_as_float(__builtin_amdgcn_update_dpp(0, __float_as_int(v), 0x121, 0xf, 0xf, false)); }
__device__ __forceinline__ float dpp_ror2(float v) { return __int_as_float(__builtin_amdgcn_update_dpp(0, __float_as_int(v), 0x122, 0xf, 0xf, false)); }
struct EpiConv {
    bf16_t* ACT; const float* cw; const float* cb; LAS unsigned char* xl; const float* SS; int nsl;
    __device__ __forceinline__ float rsg(int gr) const { return (gr >= 0 && gr < S) ? row_rs(SS, gr, nsl) : 0.f; }
    __device__ __forceinline__ void operator()(Acc& acc, const Unit& u, int wr, int wc, int fr, int fq) const {
        LAS f32x4* xb = (LAS f32x4*)xl + (wr * 128 + wc * 8 + fq * 2 + (fr - 14)); asm volatile("" : "+v"(xb));
        LAS float* wl = (LAS float*)(xl + 8448) + (32 * wc + 4 * fq); asm volatile("" : "+v"(wl));
        LAS float* rl = (LAS float*)(xl + 12544) + (64 * wr + fr); asm volatile("" : "+v"(rl));
        { const int t = (wr * 4 + wc) * 64 + fq * 16 + fr; if (t < 256) { ((LAS float*)(xl + 12544))[t] = rsg(254 * u.pm - 2 + t);
              const int k = t >> 5, c4 = (t & 31) * 4, kk = k & 3; const float* srcp = (kk == 3 ? cb : cw + kk * 2 * FF) + (k >> 2) * FF + 128 * u.pn + c4;
              *(LAS f32x4*)((LAS float*)(xl + 8448) + k * 128 + c4) = *(const f32x4*)srcp; } }
        if (fr >= 14) {
#pragma unroll
            for (int ai = 0; ai < 2; ++ai) {
                if (2 * ai + wr <= 2) { const float rs = rsg(254 * u.pm - 2 + 128 * ai + 64 * wr + 48 + fr);
#pragma unroll
                    for (int bj = 0; bj < 2; ++bj)
#pragma unroll
                        for (int n = 0; n < 2; ++n) xb[256 * ai + 64 * bj + 32 * n] = acc[ai][bj][3][n] * rs; } }
        }
        asm volatile("s_waitcnt lgkmcnt(0)" ::: "memory"); __builtin_amdgcn_s_barrier(); asm volatile("" ::: "memory");
        bf16_t* ab = ACT + (size_t)(254 * u.pm - 2 + 64 * wr + fr) * FF + 128 * u.pn + 32 * wc + 4 * fq;
#pragma unroll
        for (int ai = 0; ai < 2; ++ai) { const int s = 2 * ai + wr;
#pragma unroll
            for (int n = 0; n < 2; ++n) {
                asm volatile("" ::: "memory");
                const f32x4 wg0 = *(const LAS f32x4*)(wl + 16 * n), wg1 = *(const LAS f32x4*)(wl + 128 + 16 * n), wg2 = *(const LAS f32x4*)(wl + 256 + 16 * n), bg = *(const LAS f32x4*)(wl + 384 + 16 * n);
                const f32x4 wu0 = *(const LAS f32x4*)(wl + 512 + 16 * n), wu1 = *(const LAS f32x4*)(wl + 640 + 16 * n), wu2 = *(const LAS f32x4*)(wl + 768 + 16 * n), bu = *(const LAS f32x4*)(wl + 896 + 16 * n);
                f32x4 pg = (f32x4){0.f, 0.f, 0.f, 0.f}, pu = pg;
                if (s >= 1 && fr >= 14) { pg = xb[256 * ai - 128 + 32 * n]; pu = xb[256 * ai - 128 + 64 + 32 * n]; }
#pragma unroll
                for (int m = 0; m < 4; ++m) {
                    const int rt = 128 * ai + 64 * wr + 16 * m + fr; const int gr = 254 * u.pm - 2 + rt;
                    const float rs = rl[128 * ai + 16 * m];
                    const f32x4 cg_ = acc[ai][0][m][n] * rs, cu_ = acc[ai][1][m][n] * rs;
                    f32x4 hg, hu;
#pragma unroll
                    for (int e = 0; e < 4; ++e) {
                        const float t1g = fr == 15 ? pg[e] : cg_[e], t2g = fr >= 14 ? pg[e] : cg_[e];
                        const float t1u = fr == 15 ? pu[e] : cu_[e], t2u = fr >= 14 ? pu[e] : cu_[e];
                        const float p1g = dpp_ror1(t1g), p2g = dpp_ror2(t2g), p1u = dpp_ror1(t1u), p2u = dpp_ror2(t2u);
                        hg[e] = bg[e] + wg0[e] * p2g + wg1[e] * p1g + wg2[e] * cg_[e];
                        hu[e] = bu[e] + wu0[e] * p2u + wu1[e] * p1u + wu2[e] * cu_[e];
                    }
                    f32x4 o; o[0] = hg[0] * sigm(hg[0]) * hu[0]; o[1] = hg[1] * sigm(hg[1]) * hu[1]; o[2] = hg[2] * sigm(hg[2]) * hu[2]; o[3] = hg[3] * sigm(hg[3]) * hu[3];
                    if (rt >= 2 && gr < S) *(u32x2*)(ab + (size_t)(128 * ai + 16 * m) * FF + 16 * n) = pack4(o);
                    pg = cg_; pu = cu_;
                }
            }
        }
    }
};
}

constexpr size_t MiB = 1u << 20;
constexpr size_t WS_CL = 0, WS_CG = 524288, WS_GT = 1048576, WS_BAR = 1179648, BAR_BYTES = 16384, WS_SS = 1245184, ZERO_BYTES = 16384;
constexpr size_t WS_WIN = 3 * MiB;
constexpr size_t WS_WOUT = WS_WIN + 2ull * 2560 * 1024 * 2;
constexpr size_t WS_WGLU = WS_WOUT + 2ull * 1024 * 1024 * 2;
constexpr size_t WS_WUP = WS_WGLU + 2ull * 2048 * 1024 * 2;
constexpr size_t WS_WDN = WS_WUP + 4ull * 5632 * 1024 * 2;
constexpr size_t WS_WGT = WS_WDN + 4ull * 1024 * 2816 * 2;
constexpr size_t WS_WPR = WS_WGT + 4ull * 1024 * 1024 * 2;
constexpr size_t WS_HNA = WS_WPR + 4ull * 1024 * 256 * 2;
constexpr size_t WS_R = WS_HNA + (2ull + 16384 + 256) * 1024 * 2;
constexpr size_t WS_END = WS_R + 144 * MiB;
constexpr size_t R_Z = 0;
constexpr size_t R_AG = 0, R_TS = 40 * MiB, R_PS = 80 * MiB, R_E = 96 * MiB, R_G = 112 * MiB;
constexpr size_t R_ACT = 0;
constexpr size_t R_PB = 96 * MiB, R_PP = 104 * MiB;

#ifndef REPMASK
#define REPMASK 0u
#endif
#ifndef XSYNC
#define XSYNC 0
#endif
constexpr int LDS_BYTES = 147456, XL_OFF = 131072;

#define XB_TMO      128
#define XB_XCNT(j)  (256  + 64 * (j))
#define XB_XSUB(j)  (1280 + 64 * (j))
#define XB_XGEN(j)  (2304 + 64 * (j))
#define XB_TOP      3328
#define XB_TOPGEN   3392
#define XCD_BAR_WORDS 3456
#define XB_SPIN_CAP (1u << 18)
__device__ __forceinline__ unsigned xb_ld(unsigned* p)              { return __hip_atomic_load(p, __ATOMIC_RELAXED, __HIP_MEMORY_SCOPE_AGENT); }
__device__ __forceinline__ unsigned xb_add(unsigned* p, unsigned v) { return __hip_atomic_fetch_add(p, v, __ATOMIC_RELAXED, __HIP_MEMORY_SCOPE_AGENT); }
__device__ __forceinline__ unsigned xb_xcc_id() { return (unsigned)__builtin_amdgcn_s_getreg((3 << 11) | 20) & 0xFu; }
#define XB_SPIN(cond, bar) do { unsigned _sp = 0; while (cond) { __builtin_amdgcn_s_sleep(1); \
    if ((++_sp & 255u) == 0u) { if (xb_ld(&(bar)[XB_TMO])) break; if (_sp > XB_SPIN_CAP) { atomicAdd(&(bar)[XB_TMO], 1u); break; } } } } while (0)
struct XcdBarrier { unsigned* bar; unsigned x; volatile LAS unsigned* st; };
__device__ __forceinline__ XcdBarrier xcd_barrier_post(unsigned* bar, volatile LAS unsigned* st) {
    XcdBarrier b; b.bar = bar; b.x = xb_xcc_id(); b.st = st;
    if (threadIdx.x == 0) (void)xb_add(&bar[XB_XCNT(b.x)], 1u);
    return b;
}
__device__ __forceinline__ void xcd_barrier_complete(unsigned* bar, unsigned x, unsigned& nloc, unsigned& nx) {
    const unsigned G = gridDim.x * gridDim.y * gridDim.z;
    unsigned sum, cnt, mine, sp = 0u;
    for (;;) {
        sum = 0u; cnt = 0u; mine = 0u;
#pragma unroll
        for (unsigned j = 0; j < 16; ++j) { const unsigned c = xb_ld(&bar[XB_XCNT(j)]); sum += c; cnt += (c > 0u) ? 1u : 0u; mine = (j == x) ? c : mine; }
        if (sum == G) break;
        __builtin_amdgcn_s_sleep(1);
        if ((++sp & 255u) == 0u) { if (xb_ld(&bar[XB_TMO])) break; if (sp > XB_SPIN_CAP) { atomicAdd(&bar[XB_TMO], 1u); break; } }
    }
    nloc = mine > 0u ? mine : 1u; nx = cnt > 0u ? cnt : 1u;
}
__device__ __forceinline__ void xcd_barrier(unsigned* bar_, volatile LAS unsigned* st_) {
    XcdBarrier b; b.bar = bar_; b.x = xb_xcc_id(); b.st = st_;
    asm volatile("s_waitcnt vmcnt(0)" ::: "memory");
    __syncthreads();
    if (threadIdx.x == 0) {
        unsigned* bar = b.bar;
        __builtin_amdgcn_s_waitcnt(0);
        unsigned nloc = b.st[0], nx = b.st[1];
        if (nloc == 0u) { xcd_barrier_complete(bar, b.x, nloc, nx); b.st[0] = nloc; b.st[1] = nx; }
        const unsigned old = xb_add(&bar[XB_XSUB(b.x)], 1u);
        const unsigned gen = old / nloc;
        if (old + 1u == (gen + 1u) * nloc) {
            __builtin_amdgcn_fence(__ATOMIC_RELEASE, "agent");
            asm volatile("s_waitcnt vmcnt(0)" ::: "memory");
            const unsigned og = xb_add(&bar[XB_TOP], 1u);
            const unsigned tg = og / nx;
            if (og + 1u == (tg + 1u) * nx) xb_add(&bar[XB_TOPGEN], 1u);
            else XB_SPIN(xb_ld(&bar[XB_TOPGEN]) == tg, bar);
            __builtin_amdgcn_fence(__ATOMIC_ACQUIRE, "agent");
            xb_add(&bar[XB_XGEN(b.x)], 1u);
            asm volatile("s_waitcnt vmcnt(0)" ::: "memory");
        } else {
            XB_SPIN(xb_ld(&bar[XB_XGEN(b.x)]) == gen, bar);
            __builtin_amdgcn_fence(__ATOMIC_ACQUIRE, "agent");
            asm volatile("s_waitcnt vmcnt(0)" ::: "memory");
        }
    }
    __syncthreads();
}

struct Params { const float* in[27]; float* out; unsigned char* ws; };

__device__ __forceinline__ float load_row(const float* xrow, int lane, f32x4 (&v)[4]) {
    const f32x4* xr = (const f32x4*)xrow + lane; float ss = 0.f;
#pragma unroll
    for (int j = 0; j < 4; ++j) { v[j] = xr[64 * j]; ss += (v[j][0] * v[j][0] + v[j][1] * v[j][1]) + (v[j][2] * v[j][2] + v[j][3] * v[j][3]); }
    return __builtin_amdgcn_rsqf(wave_sum(ss) * (1.f / D) + EPS);
}

__device__ __forceinline__ void transpose_item(const float* W, int K, int ldw, bf16_t* WT, int n0, int drow0, int kb, LAS float* scr, int lane, const float* gain) {
    const int k0 = 64 * kb;
#pragma unroll 8
    for (int i = 0; i < 32; ++i) { const int kk = 2 * i + (lane >> 5); scr[kk * 33 + (lane & 31)] = W[(size_t)(k0 + kk) * ldw + n0 + (lane & 31)] * (gain ? gain[k0 + kk] : 1.f); }
    asm volatile("s_waitcnt lgkmcnt(0)" ::: "memory");
    const int c = lane & 7;
#pragma unroll
    for (int j = 0; j < 4; ++j) { const int n = (lane >> 3) + 8 * j; const LAS float* s = scr + (8 * c) * 33 + n;
        u32x4 o; o.x = cvt_pk_bf16(s[0 * 33], s[1 * 33]); o.y = cvt_pk_bf16(s[2 * 33], s[3 * 33]); o.z = cvt_pk_bf16(s[4 * 33], s[5 * 33]); o.w = cvt_pk_bf16(s[6 * 33], s[7 * 33]);
        *(u32x4*)(WT + (size_t)(drow0 + n) * K + k0 + 8 * c) = o; }
    asm volatile("s_waitcnt lgkmcnt(0)" ::: "memory");
}
__device__ __forceinline__ int dest_row(int mode, int n0, int half) {
    if (mode == 1) { const int seg = n0 >> 9, r = n0 & 511; const int ds = seg == 1 ? 2 : (seg == 2 ? 1 : seg); return ds * 512 + r; }
    if (mode == 2) { const int hi = n0 >= half, np = hi ? n0 - half : n0; return (np >> 7) * 256 + hi * 128 + (np & 127); }
    return n0;
}
__device__ __forceinline__ bool transpose_mat(int& r, const float* W, int K, int ldw, int ncols, bf16_t* WT, int mode, LAS float* scr, int lane, const float* gain = nullptr) {
    const int nblk = ncols / 32, items = (K / 64) * nblk;
    if (r >= items) { r -= items; return false; }
    const int kb = r / nblk, nb = r % nblk;
    transpose_item(W, K, ldw, WT, nb * 32, dest_row(mode, nb * 32, ncols / 2), kb, scr, lane, gain);
    return true;
}

__device__ __forceinline__ const float* in_ptr(const Params& P, int i) { asm volatile("" : "+s"(i)); return P.in[i]; }
__global__ void __launch_bounds__(512, 2) mega(Params P) {
    extern __shared__ __attribute__((aligned(16))) unsigned char lds_raw[];
    LAS unsigned char* lds = (LAS unsigned char*)lds_raw;
    cg::grid_group grid = cg::this_grid();
    const int G = gridDim.x, bid = blockIdx.x, NGW = G * 8;
#define PHASE_IDS int tid = threadIdx.x; asm volatile("" : "+v"(tid)); const int lane = tid & 63, wid = __builtin_amdgcn_readfirstlane(tid >> 6), gw = bid * 8 + wid; (void)lane; (void)gw;
    unsigned char* ws = P.ws;
    float* X = P.out;
    float* CL = (float*)(ws + WS_CL); float* CGm = (float*)(ws + WS_CG); float* GT = (float*)(ws + WS_GT);
    bf16_t* HNA = (bf16_t*)(ws + WS_HNA); bf16_t* HN = HNA + 2 * D;
    unsigned char* R = ws + WS_R;
    { volatile LAS unsigned* st0 = (volatile LAS unsigned*)(lds + XL_OFF + 8192); if (threadIdx.x < 2) st0[threadIdx.x] = 0u; __syncthreads(); }
    (void)xcd_barrier_post((unsigned*)(ws + WS_BAR), (volatile LAS unsigned*)(lds + XL_OFF + 8192));
#define GSYNC() xcd_barrier((unsigned*)(P.ws + WS_BAR), (volatile LAS unsigned*)(lds + XL_OFF + 8192))

    for (int rep_ = 0; rep_ < 1 + (int)((REPMASK >> 0) & 1u); ++rep_) { PHASE_IDS
        LAS float* scr = (LAS float*)(lds + wid * 16384);
        constexpr int I_IN = 16 * 80, I_OUT = 16 * 32, I_GLU = 16 * 64, I_UP = 16 * 176, I_DN = 44 * 32, I_GT = 16 * 32, I_PR = 4 * 32;
        constexpr int NIT = 2 * I_IN + 2 * I_OUT + 2 * I_GLU + 4 * I_UP + 4 * I_DN + 4 * I_GT + 4 * I_PR;
        for (int it = gw; it < NIT; it += NGW) {
            int r = it; bool done = false;
#pragma unroll 1
            for (int e = 0; e < 2 && !done; ++e) done = transpose_mat(r, in_ptr(P, 4) + (size_t)e * 1024 * 2568, 1024, 2568, 2560, (bf16_t*)(ws + WS_WIN) + (size_t)e * 2560 * 1024, 1, scr, lane);
#pragma unroll 1
            for (int e = 0; e < 2 && !done; ++e) done = transpose_mat(r, in_ptr(P, 11) + (size_t)e * 1024 * 1024, 1024, 1024, 1024, (bf16_t*)(ws + WS_WOUT) + (size_t)e * 1024 * 1024, 0, scr, lane);
#pragma unroll 1
            for (int e = 0; e < 2 && !done; ++e) done = transpose_mat(r, in_ptr(P, 20) + (size_t)e * 1024 * 2048, 1024, 2048, 2048, (bf16_t*)(ws + WS_WGLU) + (size_t)e * 2048 * 1024, 2, scr, lane);
#pragma unroll 1
            for (int e = 0; e < 4 && !done; ++e) done = transpose_mat(r, in_ptr(P, 21) + (size_t)e * 1024 * 5632, 1024, 5632, 5632, (bf16_t*)(ws + WS_WUP) + (size_t)e * 5632 * 1024, 2, scr, lane, in_ptr(P, 3) + e * D);
#pragma unroll 1
            for (int e = 0; e < 4 && !done; ++e) done = transpose_mat(r, in_ptr(P, 24) + (size_t)e * 2816 * 1024, 2816, 1024, 1024, (bf16_t*)(ws + WS_WDN) + (size_t)e * 1024 * 2816, 0, scr, lane);
#pragma unroll 1
            for (int e = 0; e < 4 && !done; ++e) done = transpose_mat(r, in_ptr(P, 26) + (size_t)e * 1024 * 1024, 1024, 1024, 1024, (bf16_t*)(ws + WS_WGT) + (size_t)e * 1024 * 1024, 0, scr, lane);
#pragma unroll 1
            for (int e = 0; e < 4 && !done; ++e) done = transpose_mat(r, in_ptr(P, 25) + (size_t)e * 256 * 1024, 256, 1024, 1024, (bf16_t*)(ws + WS_WPR) + (size_t)e * 1024 * 256, 0, scr, lane);
        }
        for (int m = gw; m < S; m += NGW) { const f32x4* s = (const f32x4*)(in_ptr(P, 0) + (size_t)m * D) + lane; f32x4* d = (f32x4*)(X + (size_t)m * D) + lane;
#pragma unroll
            for (int j = 0; j < 4; ++j) d[64 * j] = s[64 * j]; }
        if (bid == 0) for (int i = tid; i < 2 * D / 2; i += 512) ((unsigned*)HNA)[i] = 0u;
    }
    grid.sync();

#pragma unroll 1
    for (int L = 0; L < 4; ++L) {
        const int e = L >> 1;
        if ((L & 1) == 0) {
            for (int rep_ = 0; rep_ < 1 + (int)((REPMASK >> 1) & 1u); ++rep_) { PHASE_IDS
                const float* gmix = in_ptr(P, 2) + L * D; const float* Win = in_ptr(P, 4) + (size_t)e * 1024 * 2568; const float* bfg = in_ptr(P, 5) + e * 8;
                f32x4 wfa[16], wfb[16];
#pragma unroll
                for (int j = 0; j < 4; ++j)
#pragma unroll
                    for (int i = 0; i < 4; ++i) { const float* wp = Win + (size_t)(4 * lane + 256 * j + i) * 2568 + 2560; wfa[j * 4 + i] = *(const f32x4*)wp; wfb[j * 4 + i] = *(const f32x4*)(wp + 4); }
                float bb[8];
#pragma unroll
                for (int h = 0; h < 8; ++h) bb[h] = bfg[h];
                for (int gi = gw; gi < 2048; gi += NGW) {
                    float cum[8];
#pragma unroll
                    for (int h = 0; h < 8; ++h) cum[h] = 0.f;
#pragma unroll 1
                    for (int rr = 0; rr < 8; ++rr) {
                        const int t = 8 * gi + rr; f32x4 v[4]; const float rs = load_row(X + (size_t)t * D, lane, v);
                        f32x4 fa = (f32x4){0.f, 0.f, 0.f, 0.f}, fb = fa;
#pragma unroll
                        for (int j = 0; j < 4; ++j) { const f32x4 gg = *((const f32x4*)gmix + lane + 64 * j); v[j] = v[j] * rs * gg;
                            *((u32x2*)(HN + (size_t)t * D) + lane + 64 * j) = pack4(v[j]);
#pragma unroll
                            for (int i = 0; i < 4; ++i) { fa += wfa[j * 4 + i] * v[j][i]; fb += wfb[j * 4 + i] * v[j][i]; } }
                        float f[8] = {fa[0], fa[1], fa[2], fa[3], fb[0], fb[1], fb[2], fb[3]};
#pragma unroll
                        for (int h = 0; h < 8; ++h) { const float z = wave_sum(f[h]) + bb[h]; const float ls = z >= 0.f ? -log1pf(expf(-z)) : z - log1pf(expf(z)); cum[h] += ls * LOG2E; }
                        if (lane == 0) { *(f32x4*)(CL + (size_t)t * 8) = (f32x4){cum[0], cum[1], cum[2], cum[3]}; *(f32x4*)(CL + (size_t)t * 8 + 4) = (f32x4){cum[4], cum[5], cum[6], cum[7]}; }
                    }
                    if (lane == 0) { *(f32x4*)(GT + (size_t)gi * 8) = (f32x4){cum[0], cum[1], cum[2], cum[3]}; *(f32x4*)(GT + (size_t)gi * 8 + 4) = (f32x4){cum[4], cum[5], cum[6], cum[7]}; }
                }
            }
            GSYNC();
            for (int rep_ = 0; rep_ < 1 + (int)((REPMASK >> 2) & 1u); ++rep_) { PHASE_IDS
                pg8::Gemm g{HN, (const bf16_t*)(ws + WS_WIN) + (size_t)e * 2560 * 1024, 1024, 1024, 256};
                pg8::StaticOrder so; so.init(64, 10, G, bid);
                pg8::EpiStore E{(bf16_t*)(R + R_Z), ZW, 1};
                pg8::gemm_phase(lds, g, so, E);
            }
            GSYNC();
            for (int rep_ = 0; rep_ < 1 + (int)((REPMASK >> 3) & 1u); ++rep_) { PHASE_IDS
                bf16_t* Z = (bf16_t*)(R + R_Z);
                const float* gq = in_ptr(P, 6) + e * 64; const float* gk = in_ptr(P, 7) + e * 64;
                LAS float* CT = (LAS float*)(lds + 98304); LAS float* BT = CT + 2048; LAS float* OFF = BT + 512;
                __syncthreads();
                { const int ckk = tid >> 1, hq = (tid & 1) * 4; f32x4 s = (f32x4){0.f, 0.f, 0.f, 0.f};
#pragma unroll
                  for (int i = 0; i < 8; ++i) s += *(const f32x4*)(GT + (size_t)(8 * ckk + i) * 8 + hq);
                  *(LAS f32x4*)(CT + ckk * 8 + hq) = s; }
                __syncthreads();
                { const int h = tid & 7, b4 = tid >> 3; BT[b4 * 8 + h] = (CT[(4 * b4) * 8 + h] + CT[(4 * b4 + 1) * 8 + h]) + (CT[(4 * b4 + 2) * 8 + h] + CT[(4 * b4 + 3) * 8 + h]); }
                __syncthreads();
                { const int h = tid & 7, b4 = tid >> 3; float o_ = 0.f;
                  for (int i = 0; i < b4; ++i) o_ += BT[i * 8 + h];
#pragma unroll
                  for (int i = 0; i < 4; ++i) { OFF[(4 * b4 + i) * 8 + h] = o_; o_ += CT[(4 * b4 + i) * 8 + h]; } }
                __syncthreads();
                for (int ck = bid; ck < 256; ck += G) {
                    { const int h = tid & 7, tok = tid >> 3; float off = OFF[ck * 8 + h];
                      const int gl = tok >> 3;
                      for (int i2 = 0; i2 < gl; ++i2) off += GT[(size_t)(8 * ck + i2) * 8 + h];
                      const int t = 64 * ck + tok; CGm[(size_t)t * 8 + h] = CL[(size_t)t * 8 + h] + off; }
#pragma unroll 1
                    for (int ps = 0; ps < 16; ++ps) {
                        const int pair = ps * 64 + (tid >> 3), sub = tid & 7; const int tok = pair >> 4, hh = (pair >> 1) & 7, isk = pair & 1;
                        bf16_t* ptr = Z + (size_t)(64 * ck + tok) * ZW + (isk ? 1536 : 512) + hh * 64 + sub * 8;
                        const u32x4 w = *(const u32x4*)ptr; float v[8];
                        v[0] = bf2f(w.x & 0xffffu); v[1] = bf2f(w.x >> 16); v[2] = bf2f(w.y & 0xffffu); v[3] = bf2f(w.y >> 16); v[4] = bf2f(w.z & 0xffffu); v[5] = bf2f(w.z >> 16); v[6] = bf2f(w.w & 0xffffu); v[7] = bf2f(w.w >> 16);
                        float ss = 0.f;
#pragma unroll
                        for (int i = 0; i < 8; ++i) ss += v[i] * v[i];
                        ss = x3_sum(ss);
                        const float rs = (__builtin_amdgcn_rsqf(ss * (1.f / 64.f) + EPS)) * (isk ? 1.f : 0.125f * LOG2E);
                        const float* gp = (isk ? gk : gq) + sub * 8;
#pragma unroll
                        for (int i = 0; i < 8; ++i) v[i] = v[i] * rs * gp[i];
                        u32x4 o; o.x = cvt_pk_bf16(v[0], v[1]); o.y = cvt_pk_bf16(v[2], v[3]); o.z = cvt_pk_bf16(v[4], v[5]); o.w = cvt_pk_bf16(v[6], v[7]);
                        { int rp_ = rep_; asm volatile("" : "+v"(rp_)); if (rp_) o = w; }
                        *(u32x4*)ptr = o;
                    }
                    { LAS bf16_t* LT = (LAS bf16_t*)(lds + 1024); bf16_t* VTg = (bf16_t*)(R + 80 * MiB);
                      __syncthreads();
#pragma unroll 1
                      for (int k = 0; k < 8; ++k) { const int idx = tid + 512 * k; const int tok = idx & 63, cc = idx >> 6;
                          const u32x4 w = *(const u32x4*)(Z + (size_t)(64 * ck + tok) * ZW + 2048 + cc * 8); LAS bf16_t* lt = LT + (cc * 8) * 72 + tok;
                          lt[0 * 72] = (bf16_t)(w.x & 0xffffu); lt[1 * 72] = (bf16_t)(w.x >> 16); lt[2 * 72] = (bf16_t)(w.y & 0xffffu); lt[3 * 72] = (bf16_t)(w.y >> 16);
                          lt[4 * 72] = (bf16_t)(w.z & 0xffffu); lt[5 * 72] = (bf16_t)(w.z >> 16); lt[6 * 72] = (bf16_t)(w.w & 0xffffu); lt[7 * 72] = (bf16_t)(w.w >> 16); }
                      __syncthreads();
#pragma unroll 1
                      for (int k = 0; k < 8; ++k) { const int idx = tid + 512 * k; const int c = idx >> 3, part = idx & 7;
                          *(u32x4*)(VTg + (size_t)c * S + 64 * ck + part * 8) = *(const LAS u32x4*)(LT + c * 72 + part * 8); }
                    }
                }
                LAS bf16_t* Wsm = (LAS bf16_t*)lds; LAS bf16_t* VT = (LAS bf16_t*)(lds + 34816);
                const float* wsp = in_ptr(P, 9) + (size_t)e * 4 * 128 * 128; const float* bsp = in_ptr(P, 10) + e * 512; const float* vg = in_ptr(P, 8) + e * 512;
                for (int it = bid; it < 512; it += G) {
                    const int n = it >> 2, g = it & 3;
                    __syncthreads();
                    for (int idx = tid; idx < 128 * 32; idx += 512) { const int t = idx >> 5, s4 = (idx & 31) * 4; f32x4 w = *(const f32x4*)(wsp + ((size_t)g * 128 + t) * 128 + s4);
#pragma unroll
                        for (int i = 0; i < 4; ++i) if (s4 + i > t) w[i] = 0.f;
                        *(LAS u32x2*)(Wsm + t * 136 + s4) = pack4(w); }
                    { const int tok = tid >> 2, part = tid & 3; const bf16_t* vp = Z + (size_t)(128 * n + tok) * ZW + 1024 + g * 128 + part * 32;
                      float v[32]; float ss = 0.f;
#pragma unroll
                      for (int q = 0; q < 4; ++q) { const u32x4 w = *(const u32x4*)(vp + q * 8);
                          v[q * 8 + 0] = bf2f(w.x & 0xffffu); v[q * 8 + 1] = bf2f(w.x >> 16); v[q * 8 + 2] = bf2f(w.y & 0xffffu); v[q * 8 + 3] = bf2f(w.y >> 16);
                          v[q * 8 + 4] = bf2f(w.z & 0xffffu); v[q * 8 + 5] = bf2f(w.z >> 16); v[q * 8 + 6] = bf2f(w.w & 0xffffu); v[q * 8 + 7] = bf2f(w.w >> 16); }
#pragma unroll
                      for (int i = 0; i < 32; ++i) ss += v[i] * v[i];
                      ss = x2_sum(ss);
                      const float rs = __builtin_amdgcn_rsqf(ss * (1.f / 128.f) + EPS);
#pragma unroll
                      for (int i = 0; i < 32; ++i) { const int c = part * 32 + i; const float y = v[i] * rs * vg[g * 128 + c]; VT[c * 136 + tok] = (bf16_t)(cvt_pk_bf16(y, 0.f) & 0xffffu); } }
                    __syncthreads();
                    const int l15 = lane & 15, quad = lane >> 4;
                    f32x4 acc[8];
#pragma unroll
                    for (int cb = 0; cb < 8; ++cb) acc[cb] = (f32x4){0.f, 0.f, 0.f, 0.f};
                    for (int ks = 0; ks <= (wid >> 1); ++ks) {
                        const bf16x8 a = *(const LAS bf16x8*)(Wsm + (16 * wid + l15) * 136 + 32 * ks + quad * 8);
#pragma unroll
                        for (int cb = 0; cb < 8; ++cb) { const bf16x8 b = *(const LAS bf16x8*)(VT + (16 * cb + l15) * 136 + 32 * ks + quad * 8);
                            acc[cb] = __builtin_amdgcn_mfma_f32_16x16x32_bf16(b, a, acc[cb], 0, 0, 0); }
                    }
                    const int t = 16 * wid + l15; const float bs = bsp[g * 128 + t];
                    bf16_t* up = Z + (size_t)(128 * n + t) * ZW + g * 128 + quad * 4;
#pragma unroll
                    for (int cb = 0; cb < 8; ++cb) { const f32x4 uu = unpack4(*(const u32x2*)(up + 16 * cb)); f32x4 y = uu * (acc[cb] + bs); { int rp_ = rep_; asm volatile("" : "+v"(rp_)); if (rp_) y = uu; } *(u32x2*)(up + 16 * cb) = pack4(y); }
                }
            }
            GSYNC();
            for (int rep_ = 0; rep_ < 1 + (int)((REPMASK >> 4) & 1u); ++rep_) { PHASE_IDS
                bf16_t* Z = (bf16_t*)(R + R_Z); const bf16_t* VTg = (const bf16_t*)(R + 80 * MiB);
                const int l15 = lane & 15, quad = lane >> 4;
                const float Gq = wave_max(fabsf(in_ptr(P, 6)[e * 64 + lane])), Gk = wave_max(fabsf(in_ptr(P, 7)[e * 64 + lane]));
                const float thr = -(40.f + 2.f * 8.f * Gq * Gk * LOG2E);
                int hord = 0;
                { float tot[8];
#pragma unroll
                  for (int hh = 0; hh < 8; ++hh) tot[hh] = CGm[(size_t)(S - 1) * 8 + hh];
#pragma unroll
                  for (int hh = 0; hh < 8; ++hh) { int rank = 0;
#pragma unroll
                      for (int h2 = 0; h2 < 8; ++h2) rank += (tot[h2] > tot[hh] || (tot[h2] == tot[hh] && h2 < hh)) ? 1 : 0;
                      hord |= hh << (4 * rank); } }
                for (int item = bid; item < 512; item += G) {
                    const int half = (item >> 8) & 1, rk = half ? 7 - (item & 7) : (item & 7);
                    const int qb2 = 63 - (item >> 3), h = (hord >> (4 * rk)) & 7; const int q0 = 256 * qb2, qw = q0 + 32 * wid;
                    bf16x8 qf[2][2]; float c2q[2];
#pragma unroll
                    for (int rb = 0; rb < 2; ++rb) { const bf16_t* Qp = Z + (size_t)(qw + 16 * rb + l15) * ZW + 512 + 64 * h;
                        qf[rb][0] = *(const bf16x8*)(Qp + quad * 8); qf[rb][1] = *(const bf16x8*)(Qp + 32 + quad * 8); c2q[rb] = CGm[(size_t)(qw + 16 * rb + l15) * 8 + h]; }
                    const float c2q0 = CGm[(size_t)q0 * 8 + h];
                    float mrun[2] = {-1e30f, -1e30f}, lrun[2] = {0.f, 0.f}; f32x4 o[2][4];
#pragma unroll
                    for (int rb = 0; rb < 2; ++rb)
#pragma unroll
                        for (int db = 0; db < 4; ++db) o[rb][db] = (f32x4){0.f, 0.f, 0.f, 0.f};
                    const bf16_t* kbase = Z + (size_t)(tid >> 3) * ZW + 1536 + 64 * h + (tid & 7) * 8;
                    const bf16_t* vbase = VTg + (size_t)(h * 64 + (tid >> 3)) * S + (tid & 7) * 8;
                    const float* cbase = CGm + (size_t)lane * 8 + h;
                    u32x4 kreg, vreg; float ckreg;
#define ATT_LOAD(jj) do { kreg = *(const u32x4*)(kbase + (size_t)(64 * (jj)) * ZW); vreg = *(const u32x4*)(vbase + 64 * (jj)); ckreg = cbase[(size_t)(64 * (jj)) * 8]; } while (0)
#define ATT_STORE(bb) do { LAS unsigned char* lb = lds + (bb) * 18688; *(LAS u32x4*)(lb + ((tid >> 3) * 72 + (tid & 7) * 8) * 2) = kreg; *(LAS u32x4*)(lb + 9216 + ((tid >> 3) * 72 + (tid & 7) * 8) * 2) = vreg; if (wid == 0) ((LAS float*)(lb + 18432))[lane] = ckreg; } while (0)
                    int j = 4 * qb2 + 3;
                    ATT_LOAD(j); ATT_STORE(j & 1); ATT_LOAD(j - 1);
                    __syncthreads();
                    for (; j >= 0; --j) {
                        const int b = j & 1;
                        if (j > 0) { ATT_STORE(b ^ 1); if (j > 1) ATT_LOAD(j - 2); }
                        const LAS bf16_t* Ks = (const LAS bf16_t*)(lds + b * 18688); const LAS bf16_t* VT = (const LAS bf16_t*)(lds + b * 18688 + 9216); const LAS float* Ck = (const LAS float*)(lds + b * 18688 + 18432);
                        const bool stop = (64 * j + 63 < q0) && ((c2q0 - Ck[63]) < thr);
                        if (!stop && !(64 * j > qw + 31)) {
                            f32x4 s[2][4];
#pragma unroll
                            for (int kb = 0; kb < 4; ++kb) {
                                const LAS bf16_t* kp = Ks + (16 * kb + l15) * 72 + quad * 8;
                                const bf16x8 k0 = *(const LAS bf16x8*)kp, k1 = *(const LAS bf16x8*)(kp + 32);
                                const f32x4 ck4 = *(const LAS f32x4*)(Ck + 16 * kb + quad * 4);
#pragma unroll
                                for (int rb = 0; rb < 2; ++rb) {
                                    f32x4 z = (f32x4){0.f, 0.f, 0.f, 0.f};
                                    z = __builtin_amdgcn_mfma_f32_16x16x32_bf16(k0, qf[rb][0], z, 0, 0, 0);
                                    z = __builtin_amdgcn_mfma_f32_16x16x32_bf16(k1, qf[rb][1], z, 0, 0, 0);
                                    s[rb][kb] = z + (c2q[rb] - ck4);
                                }
                            }
                            if (64 * j + 63 > qw) {
#pragma unroll
                                for (int rb = 0; rb < 2; ++rb)
#pragma unroll
                                    for (int kb = 0; kb < 4; ++kb)
#pragma unroll
                                        for (int jj = 0; jj < 4; ++jj) if (64 * j + 16 * kb + 4 * quad + jj > qw + 16 * rb + l15) s[rb][kb][jj] = -1e30f;
                            }
                            bf16x8 pb[2][2];
#pragma unroll
                            for (int rb = 0; rb < 2; ++rb) {
                                float mx = -1e30f;
#pragma unroll
                                for (int kb = 0; kb < 4; ++kb) mx = fmaxf(fmaxf(mx, fmaxf(s[rb][kb][0], s[rb][kb][1])), fmaxf(s[rb][kb][2], s[rb][kb][3]));
                                mx = quad_max(mx);
                                if (__builtin_amdgcn_ballot_w64(mx > mrun[rb]) != 0ull) {
                                    const float mn_ = fmaxf(mrun[rb], mx); const float alpha = __builtin_amdgcn_exp2f(mrun[rb] - mn_); mrun[rb] = mn_; lrun[rb] *= alpha;
#pragma unroll
                                    for (int db = 0; db < 4; ++db) o[rb][db] = o[rb][db] * alpha;
                                }
                                const float mn = mrun[rb];
                                float ls = 0.f;
#pragma unroll
                                for (int kb = 0; kb < 4; ++kb)
#pragma unroll
                                    for (int jj = 0; jj < 4; ++jj) { s[rb][kb][jj] = __builtin_amdgcn_exp2f(s[rb][kb][jj] - mn); ls += s[rb][kb][jj]; }
                                lrun[rb] += ls;
#pragma unroll
                                for (int kk = 0; kk < 2; ++kk) { u32x4 pw; pw.x = cvt_pk_bf16(s[rb][2 * kk][0], s[rb][2 * kk][1]); pw.y = cvt_pk_bf16(s[rb][2 * kk][2], s[rb][2 * kk][3]);
                                    pw.z = cvt_pk_bf16(s[rb][2 * kk + 1][0], s[rb][2 * kk + 1][1]); pw.w = cvt_pk_bf16(s[rb][2 * kk + 1][2], s[rb][2 * kk + 1][3]); pb[rb][kk] = __builtin_bit_cast(bf16x8, pw); }
                            }
#pragma unroll
                            for (int kk = 0; kk < 2; ++kk)
#pragma unroll
                                for (int db = 0; db < 4; ++db) {
                                    const LAS bf16_t* vp = VT + (16 * db + l15) * 72 + 32 * kk + quad * 4;
                                    u32x4 vw; const u32x2 va = *(const LAS u32x2*)vp, vb = *(const LAS u32x2*)(vp + 16); vw.x = va.x; vw.y = va.y; vw.z = vb.x; vw.w = vb.y;
                                    const bf16x8 vf = __builtin_bit_cast(bf16x8, vw);
                                    o[0][db] = __builtin_amdgcn_mfma_f32_16x16x32_bf16(vf, pb[0][kk], o[0][db], 0, 0, 0);
                                    o[1][db] = __builtin_amdgcn_mfma_f32_16x16x32_bf16(vf, pb[1][kk], o[1][db], 0, 0, 0);
                                }
                        }
                        __syncthreads();
                        if (stop) break;
                    }
#undef ATT_LOAD
#undef ATT_STORE
#pragma unroll
                    for (int rb = 0; rb < 2; ++rb) {
                        const float lr = quad_sum(lrun[rb]);
                        const float inv = 1.0f / lr;
                        bf16_t* Op = Z + (size_t)(qw + 16 * rb + l15) * ZW + 512 + 64 * h + 4 * quad;
#pragma unroll
                        for (int db = 0; db < 4; ++db) *(u32x2*)(Op + 16 * db) = pack4(o[rb][db] * inv);
                    }
                }
            }
            GSYNC();
            for (int rep_ = 0; rep_ < 1 + (int)((REPMASK >> 5) & 1u); ++rep_) { PHASE_IDS
                pg8::Gemm g{(const bf16_t*)(R + R_Z), (const bf16_t*)(ws + WS_WOUT) + (size_t)e * 1024 * 1024, 1024, ZW, 256};
                pg8::StaticOrder so; so.init(64, 4, G, bid);
                pg8::EpiRes E{X, HN, (float*)(ws + WS_SS), (LAS float*)(lds + XL_OFF + 8448)};
                pg8::gemm_phase(lds, g, so, E);
            }
            GSYNC();
        } else {
            for (int rep_ = 0; rep_ < 1 + (int)((REPMASK >> 6) & 1u); ++rep_) { PHASE_IDS
                bf16_t* AG = (bf16_t*)(R + R_AG); bf16_t* TS = (bf16_t*)(R + R_TS); bf16_t* PS = (bf16_t*)(R + R_PS);
                const float* gmix = in_ptr(P, 2) + L * D;
                for (int t = gw; t < S; t += NGW) { f32x4 v[4]; const float rs = load_row(X + (size_t)t * D, lane, v);
#pragma unroll
                    for (int j = 0; j < 4; ++j) { const f32x4 gg = *((const f32x4*)gmix + lane + 64 * j); v[j] = v[j] * rs * gg; const int d = 4 * lane + 256 * j; const int g = d >> 4, c = d & 15;
                        *(u32x2*)(AG + (size_t)(g * 512 + (t >> 5)) * 640 + (t & 31) * 16 + c) = pack4(v[j]); } }
                const float* a_re = in_ptr(P, 12) + e * 4096; const float* a_im = in_ptr(P, 13) + e * 4096; const float* ldt = in_ptr(P, 14) + e * 64;
                const float* b_re = in_ptr(P, 15) + (size_t)e * 65536; const float* b_im = in_ptr(P, 16) + (size_t)e * 65536; const float* c_re = in_ptr(P, 17) + (size_t)e * 65536; const float* c_im = in_ptr(P, 18) + (size_t)e * 65536;
                LAS float* Wr = (LAS float*)lds; LAS float* Wi = Wr + 64; LAS float* Pr = Wr + 128; LAS float* Pi = Wr + 192;
                for (int it = bid; it < 2048; it += G) {
                    const int g = it >> 5, j = it & 31;
                    __syncthreads();
                    if (tid < 64) { const int p = tid; const float dt = expf(ldt[g]), lr = a_re[g * 64 + p], li = a_im[g * 64 + p];
                        float s1, c1; sincosf(li * dt, &s1, &c1); const float e1 = expf(lr * dt); const float abr = e1 * c1, abi = e1 * s1;
                        const float den = lr * lr + li * li, nr = abr - 1.0f, ni = abi; const float cr = (nr * lr + ni * li) / den, ci = (ni * lr - nr * li) / den;
                        float sj, cj; sincosf((float)j * (li * dt), &sj, &cj); const float ej = expf((float)j * (lr * dt)); const float ajr = ej * cj, aji = ej * sj;
                        Wr[p] = ajr * cr - aji * ci; Wi[p] = ajr * ci + aji * cr;
                        float sp, cp; sincosf((float)(j + 1) * (li * dt), &sp, &cp); const float ep = expf((float)(j + 1) * (lr * dt)); Pr[p] = ep * cp; Pi[p] = ep * sp; }
                    __syncthreads();
                    if (tid < 256) { const int c = tid >> 4, cq = tid & 15; float acc = 0.f;
                        for (int p = 0; p < 64; ++p) { const float Cr = c_re[((size_t)g * 16 + c) * 64 + p], Ci = c_im[((size_t)g * 16 + c) * 64 + p]; const float wr_ = Wr[p], wi_ = Wi[p];
                            const float cwr = Cr * wr_ - Ci * wi_, cwi = Cr * wi_ + Ci * wr_; const float br = b_re[((size_t)g * 64 + p) * 16 + cq], bi = b_im[((size_t)g * 64 + p) * 16 + cq];
                            acc += cwr * br - cwi * bi; }
                        const bf16_t kv = (bf16_t)(cvt_pk_bf16(acc, 0.f) & 0xffffu);
                        for (int s = 0; s + j < 32; ++s) { TS[(size_t)(g * 512 + (j + s) * 16 + c) * 640 + s * 16 + cq] = kv; if (j >= 1) TS[(size_t)(g * 512 + s * 16 + c) * 640 + (s + j) * 16 + cq] = 0; }
                    } else {
#pragma unroll 1
                        for (int k = 0; k < 8; ++k) { const int idx = (tid - 256) + 256 * k; const int c = idx >> 7, rp = idx & 127, p = rp & 63;
                            const float Cr = c_re[((size_t)g * 16 + c) * 64 + p], Ci = c_im[((size_t)g * 16 + c) * 64 + p];
                            const float val = (rp < 64) ? (Cr * Pr[p] - Ci * Pi[p]) : -(Cr * Pi[p] + Ci * Pr[p]);
                            TS[(size_t)(g * 512 + j * 16 + c) * 640 + 512 + rp] = (bf16_t)(cvt_pk_bf16(val, 0.f) & 0xffffu); }
                    }
                    { const int s = 31 - j;
#pragma unroll 1
                      for (int k = 0; k < 4; ++k) { const int idx = tid + 512 * k; const int rp = idx >> 4, cq = idx & 15, p = rp & 63;
                          const float br = b_re[((size_t)g * 64 + p) * 16 + cq], bi = b_im[((size_t)g * 64 + p) * 16 + cq];
                          const float val = (rp < 64) ? (Wr[p] * br - Wi[p] * bi) : (Wr[p] * bi + Wi[p] * br);
                          PS[(size_t)(g * 256 + rp) * 512 + s * 16 + cq] = (bf16_t)(cvt_pk_bf16(val, 0.f) & 0xffffu);
                          PS[(size_t)(g * 256 + 128 + rp) * 512 + s * 16 + cq] = 0; } }
                }
            }
            GSYNC();
            for (int rep_ = 0; rep_ < 1 + (int)((REPMASK >> 7) & 1u); ++rep_) { PHASE_IDS
                pg8::Gemm g{(const bf16_t*)(R + R_AG), (const bf16_t*)(R + R_PS), 512, 640, 256};
                pg8::OrderS5E so{G, bid};
                pg8::EpiE E{(float*)(R + R_E)};
                pg8::gemm_phase(lds, g, so, E);
            }
            GSYNC();
            for (int rep_ = 0; rep_ < 1 + (int)((REPMASK >> 8) & 1u); ++rep_) { PHASE_IDS
                bf16_t* AG = (bf16_t*)(R + R_AG); const float* Eb = (const float*)(R + R_E);
                const float* a_re = in_ptr(P, 12) + e * 4096; const float* a_im = in_ptr(P, 13) + e * 4096; const float* ldt = in_ptr(P, 14) + e * 64;
                LAS float* Tr = (LAS float*)lds; LAS float* Ti = Tr + 512;
                for (int g = bid; g < 64; g += G) {
                    const int p = lane, seg = wid;
                    const float dt = expf(ldt[g]), lr = a_re[g * 64 + p], li = a_im[g * 64 + p];
                    float sA, cA; sincosf(32.f * (li * dt), &sA, &cA); const float eA = expf(32.f * (lr * dt)); const float ar = eA * cA, ai = eA * sA;
                    float sB, cB; sincosf(2048.f * (li * dt), &sB, &cB); const float eB = expf(2048.f * (lr * dt)); const float br = eB * cB, bi = eB * sB;
                    float xr = 0.f, xi = 0.f;
#pragma unroll 8
                    for (int n = 64 * seg; n < 64 * seg + 64; ++n) { const float er = Eb[(size_t)(g * 512 + n) * 128 + p], ei = Eb[(size_t)(g * 512 + n) * 128 + 64 + p];
                        const float nr = ar * xr - ai * xi + er, ni = ar * xi + ai * xr + ei; xr = nr; xi = ni; }
                    __syncthreads();
                    Tr[seg * 64 + p] = xr; Ti[seg * 64 + p] = xi;
                    __syncthreads();
                    xr = 0.f; xi = 0.f;
                    for (int s2 = 0; s2 < seg; ++s2) { const float nr = br * xr - bi * xi + Tr[s2 * 64 + p], ni = br * xi + bi * xr + Ti[s2 * 64 + p]; xr = nr; xi = ni; }
#pragma unroll 8
                    for (int n = 64 * seg; n < 64 * seg + 64; ++n) { const float er = Eb[(size_t)(g * 512 + n) * 128 + p], ei = Eb[(size_t)(g * 512 + n) * 128 + 64 + p];
                        bf16_t* sp = AG + (size_t)(g * 512 + n) * 640 + 512 + p; sp[0] = (bf16_t)(cvt_pk_bf16(xr, 0.f) & 0xffffu); sp[64] = (bf16_t)(cvt_pk_bf16(xi, 0.f) & 0xffffu);
                        const float nr = ar * xr - ai * xi + er, ni = ar * xi + ai * xr + ei; xr = nr; xi = ni; }
                }
            }
            GSYNC();
            for (int rep_ = 0; rep_ < 1 + (int)((REPMASK >> 9) & 1u); ++rep_) { PHASE_IDS
                pg8::Gemm g{(const bf16_t*)(R + R_AG), (const bf16_t*)(R + R_TS), 640, 640, 256};
                pg8::OrderS5Y so{G, bid};
                pg8::EpiY E{(const bf16_t*)(R + R_AG), in_ptr(P, 19) + e * D, (bf16_t*)(R + R_G)};
                pg8::gemm_phase(lds, g, so, E);
            }
            GSYNC();
            for (int rep_ = 0; rep_ < 1 + (int)((REPMASK >> 10) & 1u); ++rep_) { PHASE_IDS
                pg8::Gemm g{(const bf16_t*)(R + R_G), (const bf16_t*)(ws + WS_WGLU) + (size_t)e * 2048 * 1024, 1024, 1024, 256};
                pg8::StaticOrder so; so.init(64, 8, G, bid);
                pg8::EpiGlu E{X, HN, (float*)(ws + WS_SS), (LAS float*)(lds + XL_OFF + 8448)};
                pg8::gemm_phase(lds, g, so, E);
            }
            GSYNC();
        }
        for (int rep_ = 0; rep_ < 1 + (int)((REPMASK >> 12) & 1u); ++rep_) { PHASE_IDS
            { const float* pin = in_ptr(P, 1) + (size_t)L * S * 256; bf16_t* PB = (bf16_t*)(R + R_PB);
              for (int t = gw; t < S; t += NGW) { const f32x4 pv = *((const f32x4*)(pin + (size_t)t * 256) + lane); *((u32x2*)(PB + (size_t)t * 256) + lane) = pack4(pv); } }
            pg8::Gemm g{HNA, (const bf16_t*)(ws + WS_WUP) + (size_t)L * 5632 * 1024, 1024, 1024, 254};
            pg8::StaticOrder so; so.init(65, 22, G, bid);
            pg8::EpiConv E{(bf16_t*)(R + R_ACT), in_ptr(P, 22) + (size_t)L * 3 * 5632, in_ptr(P, 23) + (size_t)L * 5632, lds + XL_OFF, (const float*)(ws + WS_SS), (L & 1) ? 8 : 4};
            pg8::gemm_phase(lds, g, so, E);
        }
        GSYNC();
        for (int rep_ = 0; rep_ < 1 + (int)((REPMASK >> 13) & 1u); ++rep_) { PHASE_IDS
            pg8::Gemm g{(const bf16_t*)(R + R_ACT), (const bf16_t*)(ws + WS_WDN) + (size_t)L * 1024 * 2816, 2816, 2816, 256};
            pg8::StaticOrder so; so.init(64, 4, G, bid);
            pg8::EpiRes E{X, HN, (float*)(ws + WS_SS) + (size_t)S * 8, (LAS float*)(lds + XL_OFF + 8448)};
            pg8::gemm_phase(lds, g, so, E);
        }
        GSYNC();
        for (int rep_ = 0; rep_ < 1 + (int)((REPMASK >> 15) & 1u); ++rep_) { PHASE_IDS
            pg8::StaticOrder so; so.init(64, 4, G, bid);
            { pg8::Gemm g{(const bf16_t*)(R + R_PB), (const bf16_t*)(ws + WS_WPR) + (size_t)L * 1024 * 256, 256, 256, 256};
              pg8::EpiStore E{(bf16_t*)(R + R_PP), D, 0};
              pg8::gemm_phase(lds, g, so, E); }
            asm volatile("s_waitcnt vmcnt(0)" ::: "memory"); __syncthreads();
            { pg8::Gemm g{HN, (const bf16_t*)(ws + WS_WGT) + (size_t)L * 1024 * 1024, 1024, 1024, 256};
              pg8::EpiGate E{X, (const bf16_t*)(R + R_PP), (const float*)(ws + WS_SS) + (size_t)S * 8};
              pg8::gemm_phase(lds, g, so, E); }
        }
        GSYNC();
        for (int xs = 0; xs < XSYNC; ++xs) GSYNC();
    }
}

extern "C" void kernel_launch(void* const* d_in, const int* in_sizes, int n_in, void* d_out, int out_size, void* d_ws, size_t ws_size, hipStream_t stream) {
    static int grid = 0;
    if (grid == 0) {
        if (n_in != 27 || out_size != S * D || ws_size < WS_END) { fprintf(stderr, "kernel_launch: unexpected shapes (n_in %d out %d ws %zu need %zu)\n", n_in, out_size, ws_size, (size_t)WS_END); grid = -1; return; }
        int dev = 0, cus = 0, per_cu = 0;
        hipGetDevice(&dev); hipDeviceGetAttribute(&cus, hipDeviceAttributeMultiprocessorCount, dev);
        hipFuncSetAttribute((const void*)mega, hipFuncAttributeMaxDynamicSharedMemorySize, LDS_BYTES);
        hipOccupancyMaxActiveBlocksPerMultiprocessor(&per_cu, (const void*)mega, 512, LDS_BYTES);
        if (per_cu < 1) per_cu = 1;
        grid = cus * per_cu;
    }
    if (grid < 0) return;
    Params p{};
    for (int i = 0; i < 27; ++i) p.in[i] = (const float*)d_in[i];
    p.out = (float*)d_out; p.ws = (unsigned char*)d_ws;
    hipMemsetAsync((char*)d_ws + WS_BAR, 0, ZERO_BYTES, stream);
    void* args[] = {&p};
    hipError_t err = hipLaunchCooperativeKernel((const void*)mega, dim3(grid), dim3(512), args, LDS_BYTES, stream);
    if (err != hipSuccess) fprintf(stderr, "cooperative launch failed: %s (grid %d)\n", hipGetErrorString(err), grid);
}
```

```cpp
#include <hip/hip_runtime.h>
#include <hip/hip_cooperative_groups.h>
#include <cstdio>
#include <cstdint>
namespace cg = cooperative_groups;

#define LAS __attribute__((address_space(3)))
typedef unsigned short bf16_t;
typedef short bf16x8 __attribute__((ext_vector_type(8)));
typedef float f32x4 __attribute__((ext_vector_type(4)));
typedef unsigned u32x4 __attribute__((ext_vector_type(4)));
typedef unsigned u32x2 __attribute__((ext_vector_type(2)));

constexpr int S = 16384, D = 1024, FF = 2816, ZW = 2560;
constexpr float EPS = 1e-6f;
constexpr float LOG2E = 1.4426950408889634f;

__device__ __forceinline__ float zero_f() { float z; asm volatile("v_mov_b32 %0, 0" : "=v"(z)); return z; }
__device__ __forceinline__ unsigned cvt_pk_bf16(float lo, float hi) { unsigned r; asm volatile("v_cvt_pk_bf16_f32 %0, %1, %2" : "=v"(r) : "v"(lo), "v"(hi)); return r; }
__device__ __forceinline__ float bf2f(unsigned b) { return __uint_as_float(b << 16); }
__device__ __forceinline__ float sigm(float z) { return __builtin_amdgcn_rcpf(1.f + __builtin_amdgcn_exp2f(-LOG2E * z)); }
__device__ __forceinline__ float gelu_t(float x) { const float z = 1.5957691216057308f * (x + 0.044715f * x * x * x); return x * sigm(z); }
__device__ __forceinline__ u32x2 pack4(f32x4 v) { u32x2 w; w.x = cvt_pk_bf16(v[0], v[1]); w.y = cvt_pk_bf16(v[2], v[3]); return w; }
__device__ __forceinline__ f32x4 unpack4(u32x2 w) { return (f32x4){bf2f(w.x & 0xffffu), bf2f(w.x >> 16), bf2f(w.y & 0xffffu), bf2f(w.y >> 16)}; }
#define DPPF(v, ctrl) __int_as_float(__builtin_amdgcn_update_dpp(0, __float_as_int(v), (ctrl), 0xf, 0xf, false))
__device__ __forceinline__ float x1_sum(float v) { return v + DPPF(v, 0xB1); }
__device__ __forceinline__ float x2_sum(float v) { v += DPPF(v, 0xB1); return v + DPPF(v, 0x4E); }
__device__ __forceinline__ float x3_sum(float v) { v = x2_sum(v); return v + DPPF(v, 0x141); }
__device__ __forceinline__ float row_sum(float v) { v = x3_sum(v); return v + DPPF(v, 0x140); }
__device__ __forceinline__ float row_max(float v) { v = fmaxf(v, DPPF(v, 0xB1)); v = fmaxf(v, DPPF(v, 0x4E)); v = fmaxf(v, DPPF(v, 0x141)); return fmaxf(v, DPPF(v, 0x140)); }
__device__ __forceinline__ float max3f(float a, float b, float c) { float r; asm("v_max3_f32 %0, %1, %2, %3" : "=v"(r) : "v"(a), "v"(b), "v"(c)); return r; }
__device__ __forceinline__ float quad_max(float v) {
    auto a = __builtin_amdgcn_permlane16_swap(__float_as_uint(v), __float_as_uint(v), false, false); v = fmaxf(__uint_as_float(a[0]), __uint_as_float(a[1]));
    auto b = __builtin_amdgcn_permlane32_swap(__float_as_uint(v), __float_as_uint(v), false, false); return fmaxf(__uint_as_float(b[0]), __uint_as_float(b[1]));
}
__device__ __forceinline__ float quad_sum(float v) {
    auto a = __builtin_amdgcn_permlane16_swap(__float_as_uint(v), __float_as_uint(v), false, false); v = __uint_as_float(a[0]) + __uint_as_float(a[1]);
    auto b = __builtin_amdgcn_permlane32_swap(__float_as_uint(v), __float_as_uint(v), false, false); return __uint_as_float(b[0]) + __uint_as_float(b[1]);
}
__device__ __forceinline__ float wave_min(float v) { return -quad_max(row_max(-v)); }
__device__ __forceinline__ float wave_sum(float v) { return quad_sum(row_sum(v)); }
__device__ __forceinline__ float wave_max(float v) { return quad_max(row_max(v)); }

namespace pg8 {
constexpr int BM = 256, BK = 64, HALF = 128, HTB = HALF * BK * 2, STAGE_BYTES = 8 * HTB, NXCD = 8, WGM = 8;
__host__ __device__ __forceinline__ int lds_byte(int r, int c) { const int st = (r >> 4) * 2 + (c >> 5), rr = r & 15, cc = c & 31, ob = rr * 64 + cc * 2; return st * 1024 + (ob ^ (((ob >> 9) & 1) << 5)); }
__host__ __device__ __forceinline__ void stage_rc(int b, int& R, int& C) { const int st = b / 1024, sb = b % 1024, swz = sb ^ (((sb >> 9) & 1) << 5); R = (st >> 1) * 16 + swz / 64; C = (st & 1) * 32 + (swz % 64) / 2; }
struct Unit { int pm, pn; };
struct Gemm { const bf16_t* A; const bf16_t* Bt; int K, lda, arows; };

struct StaticOrder {
    int nM, nN, nwg, G, c;
    __device__ void init(int nM_, int nN_, int G_, int c_) { nM = nM_; nN = nN_; nwg = nM * nN; G = G_; c = c_; }
    __device__ bool next(int i, Unit& u) const {
        const long L = (long)i * G + c; if (L >= nwg) return false;
        int wgid = (int)L; { const int q = nwg / NXCD, r = nwg % NXCD, xcd = wgid % NXCD, off = wgid / NXCD; wgid = (xcd < r ? xcd * (q + 1) : r * (q + 1) + (xcd - r) * q) + off; }
        const int nig = WGM * nN, gid = wgid / nig, fm = gid * WGM, gsz = (nM - fm) < WGM ? (nM - fm) : WGM;
        u.pm = fm + ((wgid % nig) % gsz); u.pn = (wgid % nig) / gsz; return true;
    }
};
struct OrderSpare {
    int G, c, r; __device__ void init(int G_, int c_, int nprev) { G = G_; c = c_; r = nprev % G_; }
    __device__ bool next(int i, Unit& u) const { const int w = r ? c - r : c, nsp = r ? G - r : G; if (w < 0) return false; const int L = w + nsp * i; if (L >= 256) return false; u.pm = L >> 2; u.pn = L & 3; return true; }
};
struct OrderS5E { int G, c; __device__ bool next(int i, Unit& u) const { const int L = i * G + c; if (L >= 128) return false; u.pm = L; u.pn = L >> 1; return true; } };
struct OrderS5Y { int G, c; __device__ bool next(int i, Unit& u) const { const int L = i * G + c; if (L >= 256) return false; const int g = L >> 2; u.pm = 2 * g + ((L >> 1) & 1); u.pn = 2 * g + (L & 1); return true; } };

template <class Epi, class Sched>
__device__ __forceinline__ void gemm_phase(LAS unsigned char* lds, const Gemm g, const Sched& S, const Epi& E, int wid_) {
    int lane_; asm volatile("v_mbcnt_lo_u32_b32 %0, -1, 0\n\tv_mbcnt_hi_u32_b32 %0, -1, %0" : "=v"(lane_));
    const int wid = __builtin_amdgcn_readfirstlane(wid_), lane = lane_, tid = wid * 64 + lane, wr = wid >> 2, wc = wid & 3, fr = lane & 15, fq = lane >> 4;
    const int K = g.K, nt = K / BK, lda = g.lda;
    unsigned voffA[2], voffB[2];
#pragma unroll
    for (int i = 0; i < 2; ++i) { int R, C; stage_rc(tid * 16 + i * 8192, R, C); voffA[i] = (unsigned)(R * lda + C) * 2u; voffB[i] = (unsigned)(R * K + C) * 2u; }
    const size_t kstep = (size_t)(BK * 2);
    const size_t hstepA = (size_t)HALF * lda * 2, hstepB = (size_t)HALF * K * 2;
    const size_t tstepA = (size_t)g.arows * lda * 2, tstepB = 2 * hstepB;
    const unsigned ldsw = (unsigned)wid * 1024u;
    const int aoff = lds_byte(wr * 64 + fr, fq * 8), boff = lds_byte(wc * 32 + fr, fq * 8);
#define PG8_SA(b, h) (((b) * 2 + (h)) * HTB)
#define PG8_SB(b, h) ((4 + (b) * 2 + (h)) * HTB)
#define PG8_STAGE(bufoff, gbase, voff) do { _Pragma("unroll") for (int _i = 0; _i < 2; ++_i) \
        __builtin_amdgcn_global_load_lds((const unsigned*)((const char*)(gbase) + (voff)[_i]), (LAS unsigned*)(lds + (bufoff) + ldsw + _i * 8192), 16, 0, 0); } while (0)
#define PG8_LDA(dst, b, h) do { _Pragma("unroll") for (int m = 0; m < 4; ++m) _Pragma("unroll") for (int k = 0; k < 2; ++k) dst[m][k] = *(const LAS bf16x8*)(lds + PG8_SA(b, h) + aoff + m * 2048 + k * 1024); } while (0)
#define PG8_LDB(dst, b, h) do { _Pragma("unroll") for (int n = 0; n < 2; ++n) _Pragma("unroll") for (int k = 0; k < 2; ++k) dst[n][k] = *(const LAS bf16x8*)(lds + PG8_SB(b, h) + boff + n * 2048 + k * 1024); } while (0)
#define PG8_MMA(ai, bj, At, Bt) do { __builtin_amdgcn_s_setprio(1); _Pragma("unroll") for (int m = 0; m < 4; ++m) _Pragma("unroll") for (int n = 0; n < 2; ++n) _Pragma("unroll") for (int k = 0; k < 2; ++k) \
        acc[ai][bj][m][n] = __builtin_amdgcn_mfma_f32_16x16x32_bf16(Bt[n][k], At[m][k], acc[ai][bj][m][n], 0, 0, 0); __builtin_amdgcn_s_setprio(0); } while (0)
#define PG8_WAIT_V(n) asm volatile("s_waitcnt vmcnt(" #n ")" ::: "memory")
#define PG8_WAIT_L(n) asm volatile("s_waitcnt lgkmcnt(" #n ")" ::: "memory")
#define PG8_BAR __builtin_amdgcn_s_barrier()
#define PG8_SCHED __builtin_amdgcn_sched_barrier(0)
    Unit cur, nxt; int ui = 0;
    if (!S.next(0, cur)) return;
    f32x4 acc[2][2][4][2];
    float zr_; asm volatile("v_mov_b32 %0, 0" : "=v"(zr_));
#pragma unroll
    for (int a = 0; a < 2; ++a)
#pragma unroll
        for (int b = 0; b < 2; ++b)
#pragma unroll
            for (int m = 0; m < 4; ++m)
#pragma unroll
                for (int n = 0; n < 2; ++n) acc[a][b][m][n] = (f32x4){zr_, zr_, zr_, zr_};
    bf16x8 At[4][2], B0[2][2], B1[2][2];
    const char* cA = (const char*)g.A + (size_t)cur.pm * tstepA; const char* cB = (const char*)g.Bt + (size_t)cur.pn * tstepB;
    PG8_STAGE(PG8_SB(0, 0), cB, voffB); PG8_STAGE(PG8_SB(0, 1), cB + hstepB, voffB); PG8_STAGE(PG8_SA(0, 0), cA, voffA); PG8_STAGE(PG8_SA(0, 1), cA + hstepA, voffA);
    if (wr == 1) PG8_BAR;
    PG8_WAIT_V(2); PG8_BAR;
    PG8_STAGE(PG8_SB(1, 0), cB + kstep, voffB); PG8_STAGE(PG8_SA(1, 0), cA + kstep, voffA); PG8_STAGE(PG8_SB(1, 1), cB + hstepB + kstep, voffB);
    PG8_WAIT_V(6); PG8_BAR;
    for (;;) {
        const bool has_next = S.next(ui + 1, nxt);
        const char* nA = has_next ? (const char*)g.A + (size_t)nxt.pm * tstepA : cA; const char* nB = has_next ? (const char*)g.Bt + (size_t)nxt.pn * tstepB : cB;
        for (int t = 0; t < nt; t += 2) {
            const bool last = (t == nt - 2);
            const char* a1 = cA + (size_t)(t + 1) * kstep;
            const char* a2 = last ? nA : cA + (size_t)(t + 2) * kstep; const char* b2 = last ? nB : cB + (size_t)(t + 2) * kstep;
            const char* a3 = a2 + kstep; const char* b3 = b2 + kstep;
            PG8_LDB(B0, 0, 0); PG8_LDB(B1, 0, 1); PG8_SCHED; PG8_LDA(At, 0, 0); PG8_STAGE(PG8_SA(1, 1), a1 + hstepA, voffA);
            PG8_WAIT_V(8); PG8_WAIT_L(0); PG8_BAR; PG8_MMA(0, 0, At, B0); PG8_MMA(0, 1, At, B1); PG8_BAR; PG8_SCHED;
            PG8_LDA(At, 0, 1); PG8_STAGE(PG8_SB(0, 0), b2, voffB); PG8_STAGE(PG8_SB(0, 1), b2 + hstepB, voffB); PG8_STAGE(PG8_SA(0, 0), a2, voffA);
            PG8_WAIT_V(8); PG8_WAIT_L(0); PG8_BAR; PG8_MMA(1, 0, At, B0); PG8_MMA(1, 1, At, B1); PG8_BAR; PG8_SCHED;
            PG8_LDB(B0, 1, 0); PG8_LDB(B1, 1, 1); PG8_SCHED; PG8_LDA(At, 1, 0); PG8_STAGE(PG8_SA(0, 1), a2 + hstepA, voffA);
            PG8_WAIT_V(8); PG8_WAIT_L(0); PG8_BAR; PG8_MMA(0, 0, At, B0); PG8_MMA(0, 1, At, B1); PG8_BAR; PG8_SCHED;
            PG8_LDA(At, 1, 1); PG8_STAGE(PG8_SB(1, 0), b3, voffB); PG8_STAGE(PG8_SB(1, 1), b3 + hstepB, voffB); PG8_STAGE(PG8_SA(1, 0), a3, voffA);
            PG8_WAIT_V(8); PG8_WAIT_L(0); PG8_BAR; PG8_MMA(1, 0, At, B0); PG8_MMA(1, 1, At, B1); PG8_BAR; PG8_SCHED;
        }
        if (wr == 0) PG8_BAR;
        E(acc, cur, wr, wc, fr, fq);
        if (!has_next) break;
        asm volatile("v_mov_b32 %0, 0" : "=v"(zr_));
#pragma unroll
        for (int a = 0; a < 2; ++a)
#pragma unroll
            for (int b = 0; b < 2; ++b)
#pragma unroll
                for (int m = 0; m < 4; ++m)
#pragma unroll
                    for (int n = 0; n < 2; ++n) acc[a][b][m][n] = (f32x4){zr_, zr_, zr_, zr_};
        cur = nxt; cA = nA; cB = nB; ++ui;
        if (wr == 1) PG8_BAR;
    }
    PG8_WAIT_V(0);
    PG8_BAR;
#undef PG8_SA
#undef PG8_SB
#undef PG8_STAGE
#undef PG8_LDA
#undef PG8_LDB
#undef PG8_MMA
#undef PG8_WAIT_V
#undef PG8_WAIT_L
#undef PG8_BAR
#undef PG8_SCHED
}

typedef f32x4 Acc[2][2][4][2];
__device__ __forceinline__ float row_rs(const float* SSP, int row, int nsl) {
    const f32x4 a = *(const f32x4*)(SSP + (size_t)row * 8); float s = (a[0] + a[1]) + (a[2] + a[3]);
    if (nsl == 8) { const f32x4 b = *(const f32x4*)(SSP + (size_t)row * 8 + 4); s += (b[0] + b[1]) + (b[2] + b[3]); }
    return __builtin_amdgcn_rsqf(s * (1.f / D) + EPS);
}
__device__ __forceinline__ void ss_publish(LAS float* ssl, float* SSP, int row0, int slot, int wr, int wc, int fr, int fq) {
    asm volatile("s_waitcnt lgkmcnt(0)" ::: "memory"); __builtin_amdgcn_s_barrier(); asm volatile("" ::: "memory");
    const int t = (wr * 4 + wc) * 64 + fq * 16 + fr;
    if (t < 256) SSP[(size_t)(row0 + t) * 8 + slot] = (ssl[t] + ssl[256 + t]) + (ssl[512 + t] + ssl[768 + t]);
}
struct EpiRes {
    float* X_; bf16_t* XB_; float* SS; LAS float* ssl;
    __device__ __forceinline__ void operator()(Acc& acc, const Unit& u, int wr, int wc, int fr, int fq) const {
        float* __restrict__ X = X_; bf16_t* __restrict__ XB = XB_;
#pragma unroll
        for (int ai = 0; ai < 2; ++ai)
#pragma unroll
            for (int m = 0; m < 4; ++m) { const int rl = ai * 128 + wr * 64 + m * 16 + fr, row = u.pm * 256 + rl; const size_t off = (size_t)row * D + u.pn * 256 + wc * 32 + 4 * fq; float ssum = 0.f;
#pragma unroll
                for (int bj = 0; bj < 2; ++bj)
#pragma unroll
                    for (int n = 0; n < 2; ++n) { f32x4* q = (f32x4*)(X + off + bj * 128 + n * 16); const f32x4 x = *q + acc[ai][bj][m][n]; *q = x;
                        *(u32x2*)(XB + off + bj * 128 + n * 16) = pack4(x); ssum += (x[0] * x[0] + x[1] * x[1]) + (x[2] * x[2] + x[3] * x[3]); }
                ssum = quad_sum(ssum); if (fq == 0) ssl[wc * 256 + rl] = ssum; }
        ss_publish(ssl, SS, u.pm * 256, u.pn, wr, wc, fr, fq);
    }
};
struct EpiStore {
    bf16_t* O; int ld; int mode;
    __device__ __forceinline__ void operator()(Acc& acc, const Unit& u, int wr, int wc, int fr, int fq) const {
        const bool act = mode == 1 && (u.pn < 2 || u.pn == 4 || u.pn == 5);
#pragma unroll
        for (int ai = 0; ai < 2; ++ai)
#pragma unroll
            for (int m = 0; m < 4; ++m) { bf16_t* rp = O + (size_t)(u.pm * 256 + ai * 128 + wr * 64 + m * 16 + fr) * ld + u.pn * 256 + wc * 32 + 4 * fq;
#pragma unroll
                for (int bj = 0; bj < 2; ++bj)
#pragma unroll
                    for (int n = 0; n < 2; ++n) { f32x4 v = acc[ai][bj][m][n];
                        if (act) { v[0] = gelu_t(v[0]); v[1] = gelu_t(v[1]); v[2] = gelu_t(v[2]); v[3] = gelu_t(v[3]); }
                        *(u32x2*)(rp + bj * 128 + n * 16) = pack4(v); } }
    }
};
struct EpiGate {
    float* X_; const bf16_t* PP_; const float* SS_;
    __device__ __forceinline__ void operator()(Acc& acc, const Unit& u, int wr, int wc, int fr, int fq) const {
        float* __restrict__ X = X_; const bf16_t* __restrict__ PP = PP_; const float* __restrict__ SS = SS_;
#pragma unroll
        for (int ai = 0; ai < 2; ++ai)
#pragma unroll
            for (int m = 0; m < 4; ++m) { const int row = u.pm * 256 + ai * 128 + wr * 64 + m * 16 + fr; const float rs = row_rs(SS, row, 4); const size_t off = (size_t)row * D + u.pn * 256 + wc * 32 + 4 * fq;
#pragma unroll
                for (int bj = 0; bj < 2; ++bj)
#pragma unroll
                    for (int n = 0; n < 2; ++n) { const f32x4 a = acc[ai][bj][m][n] * rs; const f32x4 pp = unpack4(*(const u32x2*)(PP + off + bj * 128 + n * 16));
                        f32x4* q = (f32x4*)(X + off + bj * 128 + n * 16); f32x4 x = *q;
                        x[0] += sigm(a[0]) * pp[0]; x[1] += sigm(a[1]) * pp[1]; x[2] += sigm(a[2]) * pp[2]; x[3] += sigm(a[3]) * pp[3]; *q = x; } }
    }
};
struct EpiGlu {
    float* X_; bf16_t* XB_; float* SS; LAS float* ssl;
    __device__ __forceinline__ void operator()(Acc& acc, const Unit& u, int wr, int wc, int fr, int fq) const {
        float* __restrict__ X = X_; bf16_t* __restrict__ XB = XB_;
#pragma unroll
        for (int ai = 0; ai < 2; ++ai)
#pragma unroll
            for (int m = 0; m < 4; ++m) { const int rl = ai * 128 + wr * 64 + m * 16 + fr, row = u.pm * 256 + rl; const size_t off = (size_t)row * D + u.pn * 128 + wc * 32 + 4 * fq; float ssum = 0.f;
#pragma unroll
                for (int n = 0; n < 2; ++n) { const f32x4 a = acc[ai][0][m][n], b = acc[ai][1][m][n]; f32x4* q = (f32x4*)(X + off + n * 16); f32x4 x = *q;
                    x[0] += a[0] * sigm(b[0]); x[1] += a[1] * sigm(b[1]); x[2] += a[2] * sigm(b[2]); x[3] += a[3] * sigm(b[3]); *q = x;
                    *(u32x2*)(XB + off + n * 16) = pack4(x); ssum += (x[0] * x[0] + x[1] * x[1]) + (x[2] * x[2] + x[3] * x[3]); }
                ssum = quad_sum(ssum); if (fq == 0) ssl[wc * 256 + rl] = ssum; }
        ss_publish(ssl, SS, u.pm * 256, u.pn, wr, wc, fr, fq);
    }
};
struct EpiE {
    float* Eo;
    __device__ __forceinline__ void operator()(Acc& acc, const Unit& u, int wr, int wc, int fr, int fq) const {
#pragma unroll
        for (int ai = 0; ai < 2; ++ai)
#pragma unroll
            for (int m = 0; m < 4; ++m) { float* rp = Eo + (size_t)(u.pm * 256 + ai * 128 + wr * 64 + m * 16 + fr) * 128 + wc * 32 + 4 * fq;
#pragma unroll
                for (int n = 0; n < 2; ++n) *(f32x4*)(rp + n * 16) = acc[ai][0][m][n]; }
    }
};
struct EpiY {
    const bf16_t* AG_; const float* Dv; bf16_t* Gm_;
    __device__ __forceinline__ void operator()(Acc& acc, const Unit& u, int wr, int wc, int fr, int fq) const {
        const bf16_t* __restrict__ AG = AG_; bf16_t* __restrict__ Gm = Gm_;
        const int g = u.pm >> 1, jj = u.pn & 1; const f32x4 d4 = *(const f32x4*)(Dv + g * 16 + 4 * fq);
#pragma unroll
        for (int ai = 0; ai < 2; ++ai)
#pragma unroll
            for (int m = 0; m < 4; ++m) { const int rowA = u.pm * 256 + ai * 128 + wr * 64 + m * 16 + fr; const int nchunk = rowA - g * 512;
#pragma unroll
                for (int bj = 0; bj < 2; ++bj)
#pragma unroll
                    for (int n = 0; n < 2; ++n) { const int sp = 16 * jj + 8 * bj + 2 * wc + n; const int t = nchunk * 32 + sp;
                        const f32x4 uu = unpack4(*(const u32x2*)(AG + (size_t)rowA * 640 + sp * 16 + 4 * fq));
                        f32x4 y = acc[ai][bj][m][n] + d4 * uu; y[0] = gelu_t(y[0]); y[1] = gelu_t(y[1]); y[2] = gelu_t(y[2]); y[3] = gelu_t(y[3]);
                        *(u32x2*)(Gm + (size_t)t * D + g * 16 + 4 * fq) = pack4(y); } }
    }
};
__device__ __forceinline__ float dpp_ror1(float v) { return __int_as_float(__builtin_amdgcn_update_dpp(0, __float_as_int(v), 0x121, 0xf, 0xf, false)); }
__device__ __forceinline__ float dpp_ror2(float v) { return __int_as_float(__builtin_amdgcn_update_dpp(0, __float_as_int(v), 0x122, 0xf, 0xf, false)); }
struct EpiConv {
    bf16_t* ACT; const float* cw; const float* cb; LAS unsigned char* xl; const float* SS; int nsl;
    __device__ __forceinline__ float rsg(int gr) const { return (gr >= 0 && gr < S) ? row_rs(SS, gr, nsl) : 0.f; }
    __device__ __forceinline__ void operator()(Acc& acc, const Unit& u, int wr, int wc, int fr, int fq) const {
        LAS f32x4* xb = (LAS f32x4*)xl + (wr * 128 + wc * 8 + fq * 2 + (fr - 14)); asm volatile("" : "+v"(xb));
        LAS float* wl = (LAS float*)(xl + 8448) + (32 * wc + 4 * fq); asm volatile("" : "+v"(wl));
        LAS float* rl = (LAS float*)(xl + 12544) + (64 * wr + fr); asm volatile("" : "+v"(rl));
        { const int t = (wr * 4 + wc) * 64 + fq * 16 + fr; if (t < 256) { ((LAS float*)(xl + 12544))[t] = rsg(254 * u.pm - 2 + t);
              const int k = t >> 5, c4 = (t & 31) * 4, kk = k & 3; const float* srcp = (kk == 3 ? cb : cw + kk * 2 * FF) + (k >> 2) * FF + 128 * u.pn + c4;
              *(LAS f32x4*)((LAS float*)(xl + 8448) + k * 128 + c4) = *(const f32x4*)srcp; } }
        if (fr >= 14) {
#pragma unroll
            for (int ai = 0; ai < 2; ++ai) {
                if (2 * ai + wr <= 2) { const float rs = rsg(254 * u.pm - 2 + 128 * ai + 64 * wr + 48 + fr);
#pragma unroll
                    for (int bj = 0; bj < 2; ++bj)
#pragma unroll
                        for (int n = 0; n < 2; ++n) xb[256 * ai + 64 * bj + 32 * n] = acc[ai][bj][3][n] * rs; } }
        }
        asm volatile("s_waitcnt lgkmcnt(0)" ::: "memory"); __builtin_amdgcn_s_barrier(); asm volatile("" ::: "memory");
        int frl = fr; asm volatile("" : "+v"(frl));
        bf16_t* ab = ACT + (size_t)(254 * u.pm - 2 + 64 * wr + frl) * FF + 128 * u.pn + 32 * wc + 4 * fq;
#pragma unroll
        for (int ai = 0; ai < 2; ++ai) { const int s = 2 * ai + wr;
#pragma unroll
            for (int n = 0; n < 2; ++n) {
                asm volatile("" ::: "memory");
                const f32x4 wg0 = *(const LAS f32x4*)(wl + 16 * n), wg1 = *(const LAS f32x4*)(wl + 128 + 16 * n), wg2 = *(const LAS f32x4*)(wl + 256 + 16 * n), bg = *(const LAS f32x4*)(wl + 384 + 16 * n);
                const f32x4 wu0 = *(const LAS f32x4*)(wl + 512 + 16 * n), wu1 = *(const LAS f32x4*)(wl + 640 + 16 * n), wu2 = *(const LAS f32x4*)(wl + 768 + 16 * n), bu = *(const LAS f32x4*)(wl + 896 + 16 * n);
                float z0_; asm volatile("v_mov_b32 %0, 0" : "=v"(z0_));
                f32x4 pg = (f32x4){z0_, z0_, z0_, z0_}, pu = pg;
                if (s >= 1 && fr >= 14) { pg = xb[256 * ai - 128 + 32 * n]; pu = xb[256 * ai - 128 + 64 + 32 * n]; }
#pragma unroll
                for (int m = 0; m < 4; ++m) {
                    const int rt = 128 * ai + 64 * wr + 16 * m + fr; const int gr = 254 * u.pm - 2 + rt;
                    const float rs = rl[128 * ai + 16 * m];
                    const f32x4 cg_ = acc[ai][0][m][n] * rs, cu_ = acc[ai][1][m][n] * rs;
                    f32x4 T1g, T2g, T1u, T2u, P1g, P2g, P1u, P2u;
#pragma unroll
                    for (int e = 0; e < 4; ++e) { T1g[e] = fr == 15 ? pg[e] : cg_[e]; T2g[e] = fr >= 14 ? pg[e] : cg_[e]; T1u[e] = fr == 15 ? pu[e] : cu_[e]; T2u[e] = fr >= 14 ? pu[e] : cu_[e]; }
#pragma unroll
                    for (int e = 0; e < 4; ++e) { P1g[e] = dpp_ror1(T1g[e]); P2g[e] = dpp_ror2(T2g[e]); P1u[e] = dpp_ror1(T1u[e]); P2u[e] = dpp_ror2(T2u[e]); }
                    const f32x4 hg = bg + wg0 * P2g + wg1 * P1g + wg2 * cg_;
                    const f32x4 hu = bu + wu0 * P2u + wu1 * P1u + wu2 * cu_;
                    f32x4 ex = hg * (-LOG2E);
#pragma unroll
                    for (int e = 0; e < 4; ++e) ex[e] = __builtin_amdgcn_exp2f(ex[e]);
                    ex = ex + 1.0f;
#pragma unroll
                    for (int e = 0; e < 4; ++e) ex[e] = __builtin_amdgcn_rcpf(ex[e]);
                    const f32x4 o = (hg * hu) * ex;
                    if (rt >= 2 && gr < S) *(u32x2*)(ab + (size_t)(128 * ai + 16 * m) * FF + 16 * n) = pack4(o);
                    pg = cg_; pu = cu_;
                }
            }
        }
    }
};
}

constexpr size_t MiB = 1u << 20;
constexpr size_t WS_CL = 0, WS_CG = 524288, WS_GT = 1048576, WS_BAR = 1179648, BAR_BYTES = 16384, WS_SS = 1245184, ZERO_BYTES = 16384;
constexpr size_t WS_WIN = 3 * MiB;
constexpr size_t WS_WOUT = WS_WIN + 2ull * 2560 * 1024 * 2;
constexpr size_t WS_WGLU = WS_WOUT + 2ull * 1024 * 1024 * 2;
constexpr size_t WS_WUP = WS_WGLU + 2ull * 2048 * 1024 * 2;
constexpr size_t WS_WDN = WS_WUP + 4ull * 5632 * 1024 * 2;
constexpr size_t WS_WGT = WS_WDN + 4ull * 1024 * 2816 * 2;
constexpr size_t WS_WPR = WS_WGT + 4ull * 1024 * 1024 * 2;
constexpr size_t WS_HNA = WS_WPR + 4ull * 1024 * 256 * 2;
constexpr size_t WS_R = WS_HNA + (2ull + 16384 + 256) * 1024 * 2;
constexpr size_t WS_END = WS_R + 144 * MiB;
constexpr size_t R_Z = 0;
constexpr size_t R_AG = 0, R_TS = 40 * MiB, R_PS = 80 * MiB, R_E = 96 * MiB, R_G = 112 * MiB;
constexpr size_t R_ACT = 0;
constexpr size_t R_PB = 96 * MiB, R_PP = 104 * MiB;

#ifndef REPMASK
#define REPMASK 0u
#endif
#ifndef XSYNC
#define XSYNC 0
#endif
constexpr int LDS_BYTES = 147456, XL_OFF = 131072;

#define XB_TMO      128
#define XB_XCNT(j)  (256  + 64 * (j))
#define XB_XSUB(j)  (1280 + 64 * (j))
#define XB_XGEN(j)  (2304 + 64 * (j))
#define XB_TOP      3328
#define XB_TOPGEN   3392
#define XCD_BAR_WORDS 3456
#define XB_SPIN_CAP (1u << 18)
__device__ __forceinline__ unsigned xb_ld(unsigned* p)              { return __hip_atomic_load(p, __ATOMIC_RELAXED, __HIP_MEMORY_SCOPE_AGENT); }
__device__ __forceinline__ unsigned xb_add(unsigned* p, unsigned v) { return __hip_atomic_fetch_add(p, v, __ATOMIC_RELAXED, __HIP_MEMORY_SCOPE_AGENT); }
__device__ __forceinline__ unsigned xb_xcc_id() { return (unsigned)__builtin_amdgcn_s_getreg((3 << 11) | 20) & 0xFu; }
#define XB_SPIN(cond, bar) do { unsigned _sp = 0; while (cond) { __builtin_amdgcn_s_sleep(1); \
    if ((++_sp & 255u) == 0u) { if (xb_ld(&(bar)[XB_TMO])) break; if (_sp > XB_SPIN_CAP) { atomicAdd(&(bar)[XB_TMO], 1u); break; } } } } while (0)
struct XcdBarrier { unsigned* bar; unsigned x; volatile LAS unsigned* st; };
__device__ __forceinline__ XcdBarrier xcd_barrier_post(unsigned* bar, volatile LAS unsigned* st) {
    XcdBarrier b; b.bar = bar; b.x = xb_xcc_id(); b.st = st;
    if (threadIdx.x == 0) (void)xb_add(&bar[XB_XCNT(b.x)], 1u);
    return b;
}
__device__ __forceinline__ void xcd_barrier_complete(unsigned* bar, unsigned x, unsigned& nloc, unsigned& nx) {
    const unsigned G = gridDim.x * gridDim.y * gridDim.z;
    unsigned sum, cnt, mine, sp = 0u;
    for (;;) {
        sum = 0u; cnt = 0u; mine = 0u;
#pragma unroll
        for (unsigned j = 0; j < 16; ++j) { const unsigned c = xb_ld(&bar[XB_XCNT(j)]); sum += c; cnt += (c > 0u) ? 1u : 0u; mine = (j == x) ? c : mine; }
        if (sum == G) break;
        __builtin_amdgcn_s_sleep(1);
        if ((++sp & 255u) == 0u) { if (xb_ld(&bar[XB_TMO])) break; if (sp > XB_SPIN_CAP) { atomicAdd(&bar[XB_TMO], 1u); break; } }
    }
    nloc = mine > 0u ? mine : 1u; nx = cnt > 0u ? cnt : 1u;
}
__device__ __forceinline__ void xcd_barrier(unsigned* bar_, volatile LAS unsigned* st_, int wid_) {
    XcdBarrier b; b.bar = bar_; b.x = xb_xcc_id(); b.st = st_;
    asm volatile("s_waitcnt vmcnt(0)" ::: "memory");
    __syncthreads();
    int ln_; asm volatile("v_mbcnt_lo_u32_b32 %0, -1, 0\n\tv_mbcnt_hi_u32_b32 %0, -1, %0" : "=v"(ln_));
    if (wid_ == 0 && ln_ == 0) {
        unsigned* bar = b.bar;
        __builtin_amdgcn_s_waitcnt(0);
        unsigned nloc = b.st[0], nx = b.st[1];
        if (nloc == 0u) { xcd_barrier_complete(bar, b.x, nloc, nx); b.st[0] = nloc; b.st[1] = nx; }
        const unsigned old = xb_add(&bar[XB_XSUB(b.x)], 1u);
        const unsigned gen = old / nloc;
        if (old + 1u == (gen + 1u) * nloc) {
            __builtin_amdgcn_fence(__ATOMIC_RELEASE, "agent");
            asm volatile("s_waitcnt vmcnt(0)" ::: "memory");
            const unsigned og = xb_add(&bar[XB_TOP], 1u);
            const unsigned tg = og / nx;
            if (og + 1u == (tg + 1u) * nx) xb_add(&bar[XB_TOPGEN], 1u);
            else XB_SPIN(xb_ld(&bar[XB_TOPGEN]) == tg, bar);
            __builtin_amdgcn_fence(__ATOMIC_ACQUIRE, "agent");
            xb_add(&bar[XB_XGEN(b.x)], 1u);
            asm volatile("s_waitcnt vmcnt(0)" ::: "memory");
        } else {
            XB_SPIN(xb_ld(&bar[XB_XGEN(b.x)]) == gen, bar);
            __builtin_amdgcn_fence(__ATOMIC_ACQUIRE, "agent");
            asm volatile("s_waitcnt vmcnt(0)" ::: "memory");
        }
    }
    __syncthreads();
}

struct Params { const float* in[27]; float* out; unsigned char* ws; };

__device__ __forceinline__ float load_row(const float* xrow, int lane, f32x4 (&v)[4]) {
    const f32x4* xr = (const f32x4*)xrow + lane; float ss = 0.f;
#pragma unroll
    for (int j = 0; j < 4; ++j) { v[j] = xr[64 * j]; ss += (v[j][0] * v[j][0] + v[j][1] * v[j][1]) + (v[j][2] * v[j][2] + v[j][3] * v[j][3]); }
    return __builtin_amdgcn_rsqf(wave_sum(ss) * (1.f / D) + EPS);
}

__device__ __forceinline__ void transpose_item(const float* W, int K, int ldw, bf16_t* WT, int n0, int drow0, int kb, LAS float* scr, int lane, const float* gain) {
    const int k0 = 64 * kb; const float* wp = W + (size_t)k0 * ldw + n0 + lane;
#pragma unroll 16
    for (int i = 0; i < 64; ++i) scr[i * 65 + lane] = wp[(size_t)i * ldw] * (gain ? gain[k0 + i] : 1.f);
    asm volatile("s_waitcnt lgkmcnt(0)" ::: "memory");
    const int c = lane & 7;
#pragma unroll
    for (int j = 0; j < 8; ++j) { const int n = (lane >> 3) + 8 * j; const LAS float* s = scr + (8 * c) * 65 + n;
        u32x4 o; o.x = cvt_pk_bf16(s[0 * 65], s[1 * 65]); o.y = cvt_pk_bf16(s[2 * 65], s[3 * 65]); o.z = cvt_pk_bf16(s[4 * 65], s[5 * 65]); o.w = cvt_pk_bf16(s[6 * 65], s[7 * 65]);
        *(u32x4*)(WT + (size_t)(drow0 + n) * K + k0 + 8 * c) = o; }
    asm volatile("s_waitcnt lgkmcnt(0)" ::: "memory");
}
__device__ __forceinline__ int dest_row(int mode, int n0, int half) {
    if (mode == 1) { const int seg = n0 >> 9, r = n0 & 511; const int ds = seg == 1 ? 2 : (seg == 2 ? 1 : seg); return ds * 512 + r; }
    if (mode == 2) { const int hi = n0 >= half, np = hi ? n0 - half : n0; return (np >> 7) * 256 + hi * 128 + (np & 127); }
    return n0;
}
__device__ __forceinline__ bool transpose_mat(int& r, const float* W, int K, int ldw, int ncols, bf16_t* WT, int mode, LAS float* scr, int lane, const float* gain = nullptr) {
    const int nblk = ncols / 64, items = (K / 64) * nblk;
    if (r >= items) { r -= items; return false; }
    const int kb = r / nblk, nb = r % nblk;
    transpose_item(W, K, ldw, WT, nb * 64, dest_row(mode, nb * 64, ncols / 2), kb, scr, lane, gain);
    return true;
}

__device__ __forceinline__ const float* in_ptr(const Params& P, int i) { asm volatile("" : "+s"(i)); return P.in[i]; }
__global__ void __launch_bounds__(512, 2) mega(Params P) {
    extern __shared__ __attribute__((aligned(16))) unsigned char lds_raw[];
    LAS unsigned char* lds = (LAS unsigned char*)lds_raw;
    cg::grid_group grid = cg::this_grid();
    const int G = gridDim.x, bid = blockIdx.x, NGW = G * 8;
    const int wid0 = __builtin_amdgcn_readfirstlane((int)threadIdx.x >> 6);
#define PHASE_IDS int lane_; asm volatile("v_mbcnt_lo_u32_b32 %0, -1, 0\n\tv_mbcnt_hi_u32_b32 %0, -1, %0" : "=v"(lane_)); const int lane = lane_, wid = wid0, tid = wid * 64 + lane, gw = bid * 8 + wid; (void)tid; (void)gw;
    unsigned char* ws = P.ws;
    float* X = P.out;
    float* CL = (float*)(ws + WS_CL); float* CGm = (float*)(ws + WS_CG); float* GT = (float*)(ws + WS_GT);
    bf16_t* HNA = (bf16_t*)(ws + WS_HNA); bf16_t* HN = HNA + 2 * D;
    unsigned char* R = ws + WS_R;
    { volatile LAS unsigned* st0 = (volatile LAS unsigned*)(lds + XL_OFF + 8192); if (threadIdx.x < 2) st0[threadIdx.x] = 0u; __syncthreads(); }
    (void)xcd_barrier_post((unsigned*)(ws + WS_BAR), (volatile LAS unsigned*)(lds + XL_OFF + 8192));
#define GSYNC() xcd_barrier((unsigned*)(P.ws + WS_BAR), (volatile LAS unsigned*)(lds + XL_OFF + 8192), wid0)
#ifdef PROBE_SEL
    LAS float* tacc = (LAS float*)(lds + XL_OFF + 13600); LAS unsigned long long* tlast = (LAS unsigned long long*)(lds + XL_OFF + 13696);
    if (threadIdx.x == 0) { for (int i = 0; i < 16; ++i) tacc[i] = 0.f; *tlast = __builtin_amdgcn_s_memrealtime(); }
#define STAMP(gid) do { if (bid == 0 && threadIdx.x == 0) { const unsigned long long t_ = __builtin_amdgcn_s_memrealtime(); tacc[gid] += (float)(t_ - *tlast); *tlast = t_; } } while (0)
#else
#define STAMP(gid) do {} while (0)
#endif

    for (int rep_ = 0; rep_ < 1 + (int)((REPMASK >> 0) & 1u); ++rep_) { PHASE_IDS
        LAS float* scr = (LAS float*)(lds + wid * 16640);
        constexpr int I_IN = 16 * 40, I_OUT = 16 * 16, I_GLU = 16 * 32, I_UP = 16 * 88, I_DN = 44 * 16, I_GT = 16 * 16, I_PR = 4 * 16;
        constexpr int NIT = 2 * I_IN + 2 * I_OUT + 2 * I_GLU + 4 * I_UP + 4 * I_DN + 4 * I_GT + 4 * I_PR;
        for (int it = gw; it < NIT; it += NGW) {
            int r = it; bool done = false;
#pragma unroll 1
            for (int e = 0; e < 2 && !done; ++e) done = transpose_mat(r, in_ptr(P, 4) + (size_t)e * 1024 * 2568, 1024, 2568, 2560, (bf16_t*)(ws + WS_WIN) + (size_t)e * 2560 * 1024, 1, scr, lane);
#pragma unroll 1
            for (int e = 0; e < 2 && !done; ++e) done = transpose_mat(r, in_ptr(P, 11) + (size_t)e * 1024 * 1024, 1024, 1024, 1024, (bf16_t*)(ws + WS_WOUT) + (size_t)e * 1024 * 1024, 0, scr, lane);
#pragma unroll 1
            for (int e = 0; e < 2 && !done; ++e) done = transpose_mat(r, in_ptr(P, 20) + (size_t)e * 1024 * 2048, 1024, 2048, 2048, (bf16_t*)(ws + WS_WGLU) + (size_t)e * 2048 * 1024, 2, scr, lane);
#pragma unroll 1
            for (int e = 0; e < 4 && !done; ++e) done = transpose_mat(r, in_ptr(P, 21) + (size_t)e * 1024 * 5632, 1024, 5632, 5632, (bf16_t*)(ws + WS_WUP) + (size_t)e * 5632 * 1024, 2, scr, lane, in_ptr(P, 3) + e * D);
#pragma unroll 1
            for (int e = 0; e < 4 && !done; ++e) done = transpose_mat(r, in_ptr(P, 24) + (size_t)e * 2816 * 1024, 2816, 1024, 1024, (bf16_t*)(ws + WS_WDN) + (size_t)e * 1024 * 2816, 0, scr, lane);
#pragma unroll 1
            for (int e = 0; e < 4 && !done; ++e) done = transpose_mat(r, in_ptr(P, 26) + (size_t)e * 1024 * 1024, 1024, 1024, 1024, (bf16_t*)(ws + WS_WGT) + (size_t)e * 1024 * 1024, 0, scr, lane);
#pragma unroll 1
            for (int e = 0; e < 4 && !done; ++e) done = transpose_mat(r, in_ptr(P, 25) + (size_t)e * 256 * 1024, 256, 1024, 1024, (bf16_t*)(ws + WS_WPR) + (size_t)e * 1024 * 256, 0, scr, lane);
        }
        if (bid == 0) for (int i = tid; i < 2 * D / 2; i += 512) ((unsigned*)HNA)[i] = 0u;
    }
    grid.sync();
    STAMP(0);

#pragma unroll 1
    for (int L = 0; L < 4; ++L) {
        const int e = L >> 1;
        if ((L & 1) == 0) {
            for (int rep_ = 0; rep_ < 1 + (int)((REPMASK >> 1) & 1u); ++rep_) { PHASE_IDS
                const float* gmix = in_ptr(P, 2) + L * D; const float* Win = in_ptr(P, 4) + (size_t)e * 1024 * 2568; const float* bfg = in_ptr(P, 5) + e * 8;
                f32x4 wfa[16], wfb[16];
#pragma unroll
                for (int j = 0; j < 4; ++j)
#pragma unroll
                    for (int i = 0; i < 4; ++i) { const float* wp = Win + (size_t)(4 * lane + 256 * j + i) * 2568 + 2560; wfa[j * 4 + i] = *(const f32x4*)wp; wfb[j * 4 + i] = *(const f32x4*)(wp + 4); }
                const float* xsrc = (L == 0 ? in_ptr(P, 0) : X);
                LAS float* lw = (LAS float*)(lds + wid * 256);
                const float bbl = bfg[lane & 7];
                for (int gi = gw; gi < 2048; gi += NGW) {
                    f32x4 cur[4], nxt[4];
                    { const f32x4* xr = (const f32x4*)(xsrc + (size_t)(8 * gi) * D) + lane;
#pragma unroll
                      for (int j = 0; j < 4; ++j) cur[j] = xr[64 * j]; }
                    float myf = 0.f;
#pragma unroll 1
                    for (int rr = 0; rr < 8; ++rr) {
                        const int t = 8 * gi + rr;
                        if (rr < 7) { const f32x4* xr = (const f32x4*)(xsrc + (size_t)(t + 1) * D) + lane;
#pragma unroll
                            for (int j = 0; j < 4; ++j) nxt[j] = xr[64 * j]; }
                        float ss = 0.f;
#pragma unroll
                        for (int j = 0; j < 4; ++j) ss += (cur[j][0] * cur[j][0] + cur[j][1] * cur[j][1]) + (cur[j][2] * cur[j][2] + cur[j][3] * cur[j][3]);
                        const float rs = __builtin_amdgcn_rsqf(wave_sum(ss) * (1.f / D) + EPS);
                        if (L == 0) {
#pragma unroll
                            for (int j = 0; j < 4; ++j) *((f32x4*)(X + (size_t)t * D) + lane + 64 * j) = cur[j]; }
                        const float zf_ = zero_f(); f32x4 fa = (f32x4){zf_, zf_, zf_, zf_}, fb = fa;
#pragma unroll
                        for (int j = 0; j < 4; ++j) { const f32x4 gg = *((const f32x4*)gmix + lane + 64 * j); const f32x4 v = cur[j] * rs * gg;
                            *((u32x2*)(HN + (size_t)t * D) + lane + 64 * j) = pack4(v);
#pragma unroll
                            for (int i = 0; i < 4; ++i) { fa += wfa[j * 4 + i] * v[i]; fb += wfb[j * 4 + i] * v[i]; } }
                        float f0 = wave_sum(fa[0]), f1 = wave_sum(fa[1]), f2 = wave_sum(fa[2]), f3 = wave_sum(fa[3]), f4 = wave_sum(fb[0]), f5 = wave_sum(fb[1]), f6 = wave_sum(fb[2]), f7 = wave_sum(fb[3]);
                        const int h = lane & 7;
                        float sel = f0; sel = h == 1 ? f1 : sel; sel = h == 2 ? f2 : sel; sel = h == 3 ? f3 : sel; sel = h == 4 ? f4 : sel; sel = h == 5 ? f5 : sel; sel = h == 6 ? f6 : sel; sel = h == 7 ? f7 : sel;
                        myf = ((lane >> 3) == rr) ? sel : myf;
#pragma unroll
                        for (int j = 0; j < 4; ++j) cur[j] = nxt[j];
                    }
                    const float z = myf + bbl; const float ls = -__builtin_amdgcn_logf(1.f + __builtin_amdgcn_exp2f(-z * LOG2E));
                    lw[lane] = ls; asm volatile("s_waitcnt lgkmcnt(0)" ::: "memory");
                    float cum = 0.f;
#pragma unroll
                    for (int r2 = 0; r2 < 8; ++r2) { const float o_ = lw[r2 * 8 + (lane & 7)]; cum += (r2 <= (lane >> 3)) ? o_ : 0.f; }
                    asm volatile("s_waitcnt lgkmcnt(0)" ::: "memory");
                    CL[(size_t)gi * 64 + lane] = cum;
                    if (lane >= 56) GT[(size_t)gi * 8 + (lane & 7)] = cum;
                }
            }
            GSYNC();
            STAMP(1);
            for (int rep_ = 0; rep_ < 1 + (int)((REPMASK >> 2) & 1u); ++rep_) { PHASE_IDS
                pg8::Gemm g{HN, (const bf16_t*)(ws + WS_WIN) + (size_t)e * 2560 * 1024, 1024, 1024, 256};
                pg8::StaticOrder so; so.init(64, 10, G, bid);
                pg8::EpiStore E{(bf16_t*)(R + R_Z), ZW, 1};
                pg8::gemm_phase(lds, g, so, E, wid);
            }
            GSYNC();
            STAMP(2);
            for (int rep_ = 0; rep_ < 1 + (int)((REPMASK >> 3) & 1u); ++rep_) { PHASE_IDS
                bf16_t* Z = (bf16_t*)(R + R_Z);
                const float* gq = in_ptr(P, 6) + e * 64; const float* gk = in_ptr(P, 7) + e * 64;
                LAS float* CT = (LAS float*)(lds + 98304); LAS float* BT = CT + 2048; LAS float* OFF = BT + 512;
                __syncthreads();
                { const int ckk = tid >> 1, hq = (tid & 1) * 4; f32x4 s = (f32x4){0.f, 0.f, 0.f, 0.f};
#pragma unroll
                  for (int i = 0; i < 8; ++i) s += *(const f32x4*)(GT + (size_t)(8 * ckk + i) * 8 + hq);
                  *(LAS f32x4*)(CT + ckk * 8 + hq) = s; }
                __syncthreads();
                { const int h = tid & 7, b4 = tid >> 3; BT[b4 * 8 + h] = (CT[(4 * b4) * 8 + h] + CT[(4 * b4 + 1) * 8 + h]) + (CT[(4 * b4 + 2) * 8 + h] + CT[(4 * b4 + 3) * 8 + h]); }
                __syncthreads();
                { const int h = tid & 7, b4 = tid >> 3; float o_ = 0.f;
                  for (int i = 0; i < b4; ++i) o_ += BT[i * 8 + h];
#pragma unroll
                  for (int i = 0; i < 4; ++i) { OFF[(4 * b4 + i) * 8 + h] = o_; o_ += CT[(4 * b4 + i) * 8 + h]; } }
                __syncthreads();
                for (int ck = bid; ck < 256; ck += G) {
                    { const int h = tid & 7, tok = tid >> 3; float off = OFF[ck * 8 + h];
                      const int gl = tok >> 3;
                      for (int i2 = 0; i2 < gl; ++i2) off += GT[(size_t)(8 * ck + i2) * 8 + h];
                      const int t = 64 * ck + tok; CGm[(size_t)t * 8 + h] = CL[(size_t)t * 8 + h] + off; }
#pragma unroll 1
                    for (int ps4 = 0; ps4 < 16; ps4 += 4) {
                        u32x4 wq[4];
#pragma unroll
                        for (int q = 0; q < 4; ++q) { const int pair = (ps4 + q) * 64 + (tid >> 3); const int tok = pair >> 4, hh = (pair >> 1) & 7, isk = pair & 1;
                            wq[q] = *(const u32x4*)(Z + (size_t)(64 * ck + tok) * ZW + (isk ? 1536 : 512) + hh * 64 + (tid & 7) * 8); }
#pragma unroll
                        for (int q = 0; q < 4; ++q) { const int pair = (ps4 + q) * 64 + (tid >> 3), sub = tid & 7; const int tok = pair >> 4, hh = (pair >> 1) & 7, isk = pair & 1;
                            bf16_t* ptr = Z + (size_t)(64 * ck + tok) * ZW + (isk ? 1536 : 512) + hh * 64 + sub * 8;
                            const u32x4 w = wq[q]; float v[8];
                            v[0] = bf2f(w.x & 0xffffu); v[1] = bf2f(w.x >> 16); v[2] = bf2f(w.y & 0xffffu); v[3] = bf2f(w.y >> 16); v[4] = bf2f(w.z & 0xffffu); v[5] = bf2f(w.z >> 16); v[6] = bf2f(w.w & 0xffffu); v[7] = bf2f(w.w >> 16);
                            float ss = 0.f;
#pragma unroll
                            for (int i = 0; i < 8; ++i) ss += v[i] * v[i];
                            ss = x3_sum(ss);
                            const float rs = (__builtin_amdgcn_rsqf(ss * (1.f / 64.f) + EPS)) * (isk ? 1.f : 0.125f * LOG2E);
                            const float* gp = (isk ? gk : gq) + sub * 8;
#pragma unroll
                            for (int i = 0; i < 8; ++i) v[i] = v[i] * rs * gp[i];
                            u32x4 o; o.x = cvt_pk_bf16(v[0], v[1]); o.y = cvt_pk_bf16(v[2], v[3]); o.z = cvt_pk_bf16(v[4], v[5]); o.w = cvt_pk_bf16(v[6], v[7]);
                            { int rp_ = rep_; asm volatile("" : "+v"(rp_)); if (rp_) o = w; }
                            *(u32x4*)ptr = o; }
                    }
                    { LAS bf16_t* LT = (LAS bf16_t*)(lds + 1024); bf16_t* VTg = (bf16_t*)(R + 80 * MiB);
                      __syncthreads();
#pragma unroll 1
                      for (int k = 0; k < 8; ++k) { const int idx = tid + 512 * k; const int tok = idx & 63, cc = idx >> 6;
                          const u32x4 w = *(const u32x4*)(Z + (size_t)(64 * ck + tok) * ZW + 2048 + cc * 8); LAS bf16_t* lt = LT + (cc * 8) * 72 + tok;
                          lt[0 * 72] = (bf16_t)(w.x & 0xffffu); lt[1 * 72] = (bf16_t)(w.x >> 16); lt[2 * 72] = (bf16_t)(w.y & 0xffffu); lt[3 * 72] = (bf16_t)(w.y >> 16);
                          lt[4 * 72] = (bf16_t)(w.z & 0xffffu); lt[5 * 72] = (bf16_t)(w.z >> 16); lt[6 * 72] = (bf16_t)(w.w & 0xffffu); lt[7 * 72] = (bf16_t)(w.w >> 16); }
                      __syncthreads();
#pragma unroll 1
                      for (int k = 0; k < 8; ++k) { const int idx = tid + 512 * k; const int c = idx >> 3, part = idx & 7;
                          *(u32x4*)(VTg + (size_t)c * S + 64 * ck + part * 8) = *(const LAS u32x4*)(LT + c * 72 + part * 8); }
                    }
                }
                LAS bf16_t* Wsm = (LAS bf16_t*)lds; LAS bf16_t* VT = (LAS bf16_t*)(lds + 34816);
                const float* wsp = in_ptr(P, 9) + (size_t)e * 4 * 128 * 128; const float* bsp = in_ptr(P, 10) + e * 512; const float* vg = in_ptr(P, 8) + e * 512;
                for (int it = bid; it < 512; it += G) {
                    const int n = it >> 2, g = it & 3;
                    __syncthreads();
                    for (int idx = tid; idx < 128 * 32; idx += 512) { const int t = idx >> 5, s4 = (idx & 31) * 4; f32x4 w = *(const f32x4*)(wsp + ((size_t)g * 128 + t) * 128 + s4);
#pragma unroll
                        for (int i = 0; i < 4; ++i) if (s4 + i > t) w[i] = 0.f;
                        *(LAS u32x2*)(Wsm + t * 136 + s4) = pack4(w); }
                    { const int tok = tid >> 2, part = tid & 3; const bf16_t* vp = Z + (size_t)(128 * n + tok) * ZW + 1024 + g * 128 + part * 32;
                      float v[32]; float ss = 0.f;
#pragma unroll
                      for (int q = 0; q < 4; ++q) { const u32x4 w = *(const u32x4*)(vp + q * 8);
                          v[q * 8 + 0] = bf2f(w.x & 0xffffu); v[q * 8 + 1] = bf2f(w.x >> 16); v[q * 8 + 2] = bf2f(w.y & 0xffffu); v[q * 8 + 3] = bf2f(w.y >> 16);
                          v[q * 8 + 4] = bf2f(w.z & 0xffffu); v[q * 8 + 5] = bf2f(w.z >> 16); v[q * 8 + 6] = bf2f(w.w & 0xffffu); v[q * 8 + 7] = bf2f(w.w >> 16); }
#pragma unroll
                      for (int i = 0; i < 32; ++i) ss += v[i] * v[i];
                      ss = x2_sum(ss);
                      const float rs = __builtin_amdgcn_rsqf(ss * (1.f / 128.f) + EPS);
#pragma unroll
                      for (int i = 0; i < 32; ++i) { const int c = part * 32 + i; const float y = v[i] * rs * vg[g * 128 + c]; VT[c * 136 + tok] = (bf16_t)(cvt_pk_bf16(y, 0.f) & 0xffffu); } }
                    __syncthreads();
                    const int l15 = lane & 15, quad = lane >> 4;
                    f32x4 acc[8];
#pragma unroll
                    for (int cb = 0; cb < 8; ++cb) acc[cb] = (f32x4){0.f, 0.f, 0.f, 0.f};
                    for (int ks = 0; ks <= (wid >> 1); ++ks) {
                        const bf16x8 a = *(const LAS bf16x8*)(Wsm + (16 * wid + l15) * 136 + 32 * ks + quad * 8);
#pragma unroll
                        for (int cb = 0; cb < 8; ++cb) { const bf16x8 b = *(const LAS bf16x8*)(VT + (16 * cb + l15) * 136 + 32 * ks + quad * 8);
                            acc[cb] = __builtin_amdgcn_mfma_f32_16x16x32_bf16(b, a, acc[cb], 0, 0, 0); }
                    }
                    const int t = 16 * wid + l15; const float bs = bsp[g * 128 + t];
                    bf16_t* up = Z + (size_t)(128 * n + t) * ZW + g * 128 + quad * 4;
#pragma unroll
                    for (int cb = 0; cb < 8; ++cb) { const f32x4 uu = unpack4(*(const u32x2*)(up + 16 * cb)); f32x4 y = uu * (acc[cb] + bs); { int rp_ = rep_; asm volatile("" : "+v"(rp_)); if (rp_) y = uu; } *(u32x2*)(up + 16 * cb) = pack4(y); }
                }
            }
            GSYNC();
            STAMP(1);
            for (int rep_ = 0; rep_ < 1 + (int)((REPMASK >> 4) & 1u); ++rep_) { PHASE_IDS
                bf16_t* Z = (bf16_t*)(R + R_Z); const bf16_t* VTg = (const bf16_t*)(R + 80 * MiB);
                const int l15 = lane & 15, quad = lane >> 4;
                const float Gq = wave_max(fabsf(in_ptr(P, 6)[e * 64 + lane])), Gk = wave_max(fabsf(in_ptr(P, 7)[e * 64 + lane]));
                const float B2l = 8.f * Gq * Gk * LOG2E;
                int hord = 0;
                { float tot[8];
#pragma unroll
                  for (int hh = 0; hh < 8; ++hh) tot[hh] = CGm[(size_t)(S - 1) * 8 + hh];
#pragma unroll
                  for (int hh = 0; hh < 8; ++hh) { int rank = 0;
#pragma unroll
                      for (int h2 = 0; h2 < 8; ++h2) rank += (tot[h2] > tot[hh] || (tot[h2] == tot[hh] && h2 < hh)) ? 1 : 0;
                      hord |= hh << (4 * rank); } }
                for (int item = bid; item < 512; item += G) {
                    const int half = (item >> 8) & 1, rk = half ? 7 - (item & 7) : (item & 7);
                    const int qb2 = 63 - (item >> 3), h = (hord >> (4 * rk)) & 7; const int q0 = 256 * qb2, qw = q0 + 32 * wid;
                    bf16x8 qf[2][2];
#pragma unroll
                    for (int rb = 0; rb < 2; ++rb) { const bf16_t* Qp = Z + (size_t)(qw + 16 * rb + l15) * ZW + 512 + 64 * h;
                        qf[rb][0] = *(const bf16x8*)(Qp + quad * 8); qf[rb][1] = *(const bf16x8*)(Qp + 32 + quad * 8); }
                    float rminv = 0.f;
                    float mrun[2] = {-1e30f, -1e30f}, lrun[2] = {0.f, 0.f}; f32x4 o[2][4];
#pragma unroll
                    for (int rb = 0; rb < 2; ++rb)
#pragma unroll
                        for (int db = 0; db < 4; ++db) o[rb][db] = (f32x4){0.f, 0.f, 0.f, 0.f};
                    const bf16_t* kbase = Z + (size_t)(tid >> 3) * ZW + 1536 + 64 * h + (tid & 7) * 8;
                    const bf16_t* vbase = VTg + (size_t)(h * 64 + (tid >> 3)) * S + (tid & 7) * 8;
                    const float* cbase = CGm + (size_t)lane * 8 + h;
                    u32x4 kreg, vreg; float ckreg;
#define ATT_LOAD(jj) do { kreg = *(const u32x4*)(kbase + (size_t)(64 * (jj)) * ZW); vreg = *(const u32x4*)(vbase + 64 * (jj)); ckreg = cbase[(size_t)(64 * (jj)) * 8]; } while (0)
#define ATT_STORE(bb) do { LAS unsigned char* lb = lds + (bb) * 18688; *(LAS u32x4*)(lb + ((tid >> 3) * 72 + (tid & 7) * 8) * 2) = kreg; *(LAS u32x4*)(lb + 9216 + ((tid >> 3) * 72 + (tid & 7) * 8) * 2) = vreg; if (wid == 0) ((LAS float*)(lb + 18432))[lane] = -ckreg; } while (0)
                    int j = 4 * qb2 + 3;
                    ATT_LOAD(j); ATT_STORE(j & 1); ATT_LOAD(j - 1);
                    __syncthreads();
                    for (; j >= 0; --j) {
                        const int b = j & 1;
                        if (j > 0) { ATT_STORE(b ^ 1); if (j > 1) ATT_LOAD(j - 2); }
                        const LAS bf16_t* Ks = (const LAS bf16_t*)(lds + b * 18688); const LAS bf16_t* VT = (const LAS bf16_t*)(lds + b * 18688 + 9216); const LAS float* Ck = (const LAS float*)(lds + b * 18688 + 18432);
                        if (j == 4 * qb2 - 1) { const float mm = wave_min(fminf(mrun[0], mrun[1])); LAS float* rmn = (LAS float*)(lds + 37376);
                            if (lane == 0) rmn[wid] = mm;
                            __syncthreads();
                            rminv = fminf(fminf(fminf(rmn[0], rmn[1]), fminf(rmn[2], rmn[3])), fminf(fminf(rmn[4], rmn[5]), fminf(rmn[6], rmn[7]))); }
                        const bool stop = (64 * j + 63 < q0) && ((B2l + Ck[63] - rminv) < -40.f);
                        if (!stop && !(64 * j > qw + 31)) {
                            f32x4 s[2][4];
#pragma unroll
                            for (int kb = 0; kb < 4; ++kb) {
                                const LAS bf16_t* kp = Ks + (16 * kb + l15) * 72 + quad * 8;
                                const bf16x8 k0 = *(const LAS bf16x8*)kp, k1 = *(const LAS bf16x8*)(kp + 32);
                                const f32x4 nck4 = *(const LAS f32x4*)(Ck + 16 * kb + quad * 4);
#pragma unroll
                                for (int rb = 0; rb < 2; ++rb) {
                                    f32x4 z = __builtin_amdgcn_mfma_f32_16x16x32_bf16(k0, qf[rb][0], nck4, 0, 0, 0);
                                    s[rb][kb] = __builtin_amdgcn_mfma_f32_16x16x32_bf16(k1, qf[rb][1], z, 0, 0, 0);
                                }
                            }
                            if (64 * j + 63 > qw) {
#pragma unroll
                                for (int rb = 0; rb < 2; ++rb)
#pragma unroll
                                    for (int kb = 0; kb < 4; ++kb)
#pragma unroll
                                        for (int jj = 0; jj < 4; ++jj) if (64 * j + 16 * kb + 4 * quad + jj > qw + 16 * rb + l15) s[rb][kb][jj] = -1e30f;
                            }
                            asm volatile("s_nop 15\n\ts_nop 7" : "+v"(s[0][0]), "+v"(s[0][1]), "+v"(s[0][2]), "+v"(s[0][3]), "+v"(s[1][0]), "+v"(s[1][1]), "+v"(s[1][2]), "+v"(s[1][3]));
                            bf16x8 pb[2][2];
#pragma unroll
                            for (int rb = 0; rb < 2; ++rb) {
                                float mx = max3f(s[rb][0][0], s[rb][0][1], s[rb][0][2]); mx = max3f(mx, s[rb][0][3], s[rb][1][0]); mx = max3f(mx, s[rb][1][1], s[rb][1][2]); mx = max3f(mx, s[rb][1][3], s[rb][2][0]);
                                mx = max3f(mx, s[rb][2][1], s[rb][2][2]); mx = max3f(mx, s[rb][2][3], s[rb][3][0]); mx = max3f(mx, s[rb][3][1], s[rb][3][2]); mx = max3f(mx, s[rb][3][3], mx);
                                mx = quad_max(mx);
                                if (__builtin_amdgcn_ballot_w64(mx > mrun[rb]) != 0ull) {
                                    const float mn_ = fmaxf(mrun[rb], mx); const float alpha = __builtin_amdgcn_exp2f(mrun[rb] - mn_); mrun[rb] = mn_; lrun[rb] *= alpha;
#pragma unroll
                                    for (int db = 0; db < 4; ++db) o[rb][db] = o[rb][db] * alpha;
                                }
                                const float mn = mrun[rb];
                                float ls = 0.f;
#pragma unroll
                                for (int kb = 0; kb < 4; ++kb)
#pragma unroll
                                    for (int jj = 0; jj < 4; ++jj) { s[rb][kb][jj] = __builtin_amdgcn_exp2f(s[rb][kb][jj] - mn); ls += s[rb][kb][jj]; }
                                lrun[rb] += ls;
#pragma unroll
                                for (int kk = 0; kk < 2; ++kk) { u32x4 pw; pw.x = cvt_pk_bf16(s[rb][2 * kk][0], s[rb][2 * kk][1]); pw.y = cvt_pk_bf16(s[rb][2 * kk][2], s[rb][2 * kk][3]);
                                    pw.z = cvt_pk_bf16(s[rb][2 * kk + 1][0], s[rb][2 * kk + 1][1]); pw.w = cvt_pk_bf16(s[rb][2 * kk + 1][2], s[rb][2 * kk + 1][3]); pb[rb][kk] = __builtin_bit_cast(bf16x8, pw); }
                            }
#pragma unroll
                            for (int kk = 0; kk < 2; ++kk)
#pragma unroll
                                for (int db = 0; db < 4; ++db) {
                                    const LAS bf16_t* vp = VT + (16 * db + l15) * 72 + 32 * kk + quad * 4;
                                    u32x4 vw; const u32x2 va = *(const LAS u32x2*)vp, vb = *(const LAS u32x2*)(vp + 16); vw.x = va.x; vw.y = va.y; vw.z = vb.x; vw.w = vb.y;
                                    const bf16x8 vf = __builtin_bit_cast(bf16x8, vw);
                                    o[0][db] = __builtin_amdgcn_mfma_f32_16x16x32_bf16(vf, pb[0][kk], o[0][db], 0, 0, 0);
                                    o[1][db] = __builtin_amdgcn_mfma_f32_16x16x32_bf16(vf, pb[1][kk], o[1][db], 0, 0, 0);
                                }
                        }
                        __syncthreads();
                        if (stop) break;
                    }
#undef ATT_LOAD
#undef ATT_STORE
#pragma unroll
                    for (int rb = 0; rb < 2; ++rb) {
                        const float lr = quad_sum(lrun[rb]);
                        const float inv = 1.0f / lr;
                        bf16_t* Op = Z + (size_t)(qw + 16 * rb + l15) * ZW + 512 + 64 * h + 4 * quad;
#pragma unroll
                        for (int db = 0; db < 4; ++db) *(u32x2*)(Op + 16 * db) = pack4(o[rb][db] * inv);
                    }
                }
            }
            GSYNC();
            STAMP(3);
            for (int rep_ = 0; rep_ < 1 + (int)((REPMASK >> 5) & 1u); ++rep_) { PHASE_IDS
            { const float* pin = in_ptr(P, 1) + (size_t)L * S * 256; bf16_t* PB = (bf16_t*)(R + R_PB);
              for (int t = gw; t < S; t += NGW) { const f32x4 pv = *((const f32x4*)(pin + (size_t)t * 256) + lane); *((u32x2*)(PB + (size_t)t * 256) + lane) = pack4(pv); } }
                pg8::Gemm g{(const bf16_t*)(R + R_Z), (const bf16_t*)(ws + WS_WOUT) + (size_t)e * 1024 * 1024, 1024, ZW, 256};
                pg8::StaticOrder so; so.init(64, 4, G, bid);
                pg8::EpiRes E{X, HN, (float*)(ws + WS_SS), (LAS float*)(lds + XL_OFF + 8448)};
                pg8::gemm_phase(lds, g, so, E, wid);
            }
            GSYNC();
            STAMP(2);
        } else {
            for (int rep_ = 0; rep_ < 1 + (int)((REPMASK >> 6) & 1u); ++rep_) { PHASE_IDS
                bf16_t* AG = (bf16_t*)(R + R_AG); bf16_t* TS = (bf16_t*)(R + R_TS); bf16_t* PS = (bf16_t*)(R + R_PS);
                const float* gmix = in_ptr(P, 2) + L * D;
                { LAS bf16_t* ST = (LAS bf16_t*)lds;
                  for (int n = bid; n < 512; n += G) {
                      __syncthreads();
#pragma unroll 1
                      for (int r4 = 0; r4 < 4; ++r4) { const int s = 4 * wid + r4, t = 32 * n + s; f32x4 v[4]; const float rs = load_row(X + (size_t)t * D, lane, v);
#pragma unroll
                          for (int j = 0; j < 4; ++j) { const f32x4 gg = *((const f32x4*)gmix + lane + 64 * j); *(LAS u32x2*)(ST + s * 1032 + 4 * lane + 256 * j) = pack4(v[j] * rs * gg); } }
                      __syncthreads();
#pragma unroll
                      for (int k = 0; k < 8; ++k) { const int i = tid + 512 * k; const int g = i >> 6, s = (i & 63) >> 1, half = i & 1;
                          *(u32x4*)(AG + (size_t)(g * 512 + n) * 640 + s * 16 + half * 8) = *(const LAS u32x4*)(ST + s * 1032 + g * 16 + half * 8); }
                  } }
                const float* a_re = in_ptr(P, 12) + e * 4096; const float* a_im = in_ptr(P, 13) + e * 4096; const float* ldt = in_ptr(P, 14) + e * 64;
                const float* b_re = in_ptr(P, 15) + (size_t)e * 65536; const float* b_im = in_ptr(P, 16) + (size_t)e * 65536; const float* c_re = in_ptr(P, 17) + (size_t)e * 65536; const float* c_im = in_ptr(P, 18) + (size_t)e * 65536;
                LAS float* Wr = (LAS float*)lds; LAS float* Wi = Wr + 512; LAS float* Pr = Wi + 512; LAS float* Pi = Pr + 512; LAS float* Cl = Pi + 512; LAS float* Bl = Cl + 2048;
                for (int it = bid; it < 256; it += G) {
                    const int g = it >> 2, to = it & 3;
                    __syncthreads();
                    { const int tl = tid >> 6, p = tid & 63, tau = 8 * to + tl; const float dt = expf(ldt[g]), lr = a_re[g * 64 + p], li = a_im[g * 64 + p];
                      float s1, c1; sincosf(li * dt, &s1, &c1); const float e1 = expf(lr * dt); const float abr = e1 * c1, abi = e1 * s1;
                      const float den = lr * lr + li * li, nr = abr - 1.0f, ni = abi; const float cr = (nr * lr + ni * li) / den, ci = (ni * lr - nr * li) / den;
                      float sj, cj; sincosf((float)tau * (li * dt), &sj, &cj); const float ej = expf((float)tau * (lr * dt)); const float ajr = ej * cj, aji = ej * sj;
                      Wr[tid] = ajr * cr - aji * ci; Wi[tid] = ajr * ci + aji * cr;
                      float sp, cp; sincosf((float)(tau + 1) * (li * dt), &sp, &cp); const float ep = expf((float)(tau + 1) * (lr * dt)); Pr[tid] = ep * cp; Pi[tid] = ep * sp;
                      const int q4 = (tid & 255) * 4;
                      *(LAS f32x4*)(Cl + (tid >> 8) * 1024 + q4) = *(const f32x4*)((tid < 256 ? c_re : c_im) + (size_t)g * 1024 + q4);
                      *(LAS f32x4*)(Bl + (tid >> 8) * 1024 + q4) = *(const f32x4*)((tid < 256 ? b_re : b_im) + (size_t)g * 1024 + q4); }
                    __syncthreads();
                    { const int tl = tid >> 6, c = (tid >> 2) & 15, cq = tid & 3, tau = 8 * to + tl; f32x4 acc = (f32x4){0.f, 0.f, 0.f, 0.f};
                      for (int p = 0; p < 64; ++p) { const float Cr = Cl[c * 64 + p], Ci = Cl[1024 + c * 64 + p], wr_ = Wr[tl * 64 + p], wi_ = Wi[tl * 64 + p];
                          const float cwr = Cr * wr_ - Ci * wi_, cwi = Cr * wi_ + Ci * wr_; const f32x4 br = *(const LAS f32x4*)(Bl + p * 16 + 4 * cq), bi = *(const LAS f32x4*)(Bl + 1024 + p * 16 + 4 * cq);
                          acc += br * cwr - bi * cwi; }
                      const u32x2 kv = pack4(acc); const u32x2 zz = (u32x2){0u, 0u};
                      for (int s = 0; s + tau < 32; ++s) { *(u32x2*)(TS + (size_t)(g * 512 + (tau + s) * 16 + c) * 640 + s * 16 + 4 * cq) = kv;
                          if (tau >= 1) *(u32x2*)(TS + (size_t)(g * 512 + s * 16 + c) * 640 + (s + tau) * 16 + 4 * cq) = zz; } }
                    { const int tl = tid >> 6, c = (tid >> 2) & 15, part = tid & 3, t = 8 * to + tl;
#pragma unroll 1
                      for (int q4 = 0; q4 < 4; ++q4) { const int rp0 = 32 * part + 8 * q4; float v[8];
#pragma unroll
                          for (int i = 0; i < 8; ++i) { const int p = (rp0 + i) & 63; const float Cr = Cl[c * 64 + p], Ci = Cl[1024 + c * 64 + p], pr = Pr[tl * 64 + p], pi = Pi[tl * 64 + p];
                              v[i] = (rp0 < 64) ? (Cr * pr - Ci * pi) : -(Cr * pi + Ci * pr); }
                          u32x4 o; o.x = cvt_pk_bf16(v[0], v[1]); o.y = cvt_pk_bf16(v[2], v[3]); o.z = cvt_pk_bf16(v[4], v[5]); o.w = cvt_pk_bf16(v[6], v[7]);
                          *(u32x4*)(TS + (size_t)(g * 512 + t * 16 + c) * 640 + 512 + rp0) = o; } }
                    { const int rp = tid >> 2, sq = tid & 3, p = rp & 63;
#pragma unroll 1
                      for (int k = 0; k < 2; ++k) { const int jj = 2 * sq + k, s = 24 - 8 * to + jj, tl = 7 - jj; const float wr_ = Wr[tl * 64 + p], wi_ = Wi[tl * 64 + p]; float v[16];
#pragma unroll
                          for (int i = 0; i < 16; ++i) { const float br = Bl[p * 16 + i], bi = Bl[1024 + p * 16 + i]; v[i] = (rp < 64) ? (wr_ * br - wi_ * bi) : (wr_ * bi + wi_ * br); }
                          u32x4 o0, o1; o0.x = cvt_pk_bf16(v[0], v[1]); o0.y = cvt_pk_bf16(v[2], v[3]); o0.z = cvt_pk_bf16(v[4], v[5]); o0.w = cvt_pk_bf16(v[6], v[7]);
                          o1.x = cvt_pk_bf16(v[8], v[9]); o1.y = cvt_pk_bf16(v[10], v[11]); o1.z = cvt_pk_bf16(v[12], v[13]); o1.w = cvt_pk_bf16(v[14], v[15]);
                          bf16_t* pr_ = PS + (size_t)(g * 256 + rp) * 512 + s * 16; *(u32x4*)pr_ = o0; *(u32x4*)(pr_ + 8) = o1;
                          const u32x4 z4 = (u32x4){0u, 0u, 0u, 0u}; bf16_t* pz = PS + (size_t)(g * 256 + 128 + rp) * 512 + s * 16; *(u32x4*)pz = z4; *(u32x4*)(pz + 8) = z4; } }
                }
            }
            GSYNC();
            STAMP(4);
            for (int rep_ = 0; rep_ < 1 + (int)((REPMASK >> 7) & 1u); ++rep_) { PHASE_IDS
                pg8::Gemm g{(const bf16_t*)(R + R_AG), (const bf16_t*)(R + R_PS), 512, 640, 256};
                pg8::OrderS5E so{G, bid};
                pg8::EpiE E{(float*)(R + R_E)};
                pg8::gemm_phase(lds, g, so, E, wid);
            }
            GSYNC();
            STAMP(5);
            for (int rep_ = 0; rep_ < 1 + (int)((REPMASK >> 8) & 1u); ++rep_) { PHASE_IDS
                bf16_t* AG = (bf16_t*)(R + R_AG); const float* Eb = (const float*)(R + R_E);
                const float* a_re = in_ptr(P, 12) + e * 4096; const float* a_im = in_ptr(P, 13) + e * 4096; const float* ldt = in_ptr(P, 14) + e * 64;
                LAS float* Tr = (LAS float*)lds; LAS float* Ti = Tr + 512;
                for (int it = bid; it < 256; it += G) {
                    const int g = it >> 2, q = it & 3, pl = lane & 15, p = 16 * q + pl, seg = wid * 4 + (lane >> 4);
                    const float dt = expf(ldt[g]), lr = a_re[g * 64 + p], li = a_im[g * 64 + p];
                    float sA, cA; sincosf(32.f * (li * dt), &sA, &cA); const float eA = expf(32.f * (lr * dt)); const float ar = eA * cA, ai = eA * sA;
                    float sB, cB; sincosf(512.f * (li * dt), &sB, &cB); const float eB = expf(512.f * (lr * dt)); const float br = eB * cB, bi = eB * sB;
                    const float* ep = Eb + (size_t)(g * 512 + 16 * seg) * 128 + p;
                    float er[16], ei[16];
#pragma unroll
                    for (int k = 0; k < 16; ++k) { er[k] = ep[(size_t)k * 128]; ei[k] = ep[(size_t)k * 128 + 64]; }
                    float xr = 0.f, xi = 0.f;
#pragma unroll
                    for (int k = 0; k < 16; ++k) { const float nr = ar * xr - ai * xi + er[k], ni = ar * xi + ai * xr + ei[k]; xr = nr; xi = ni; }
                    __syncthreads();
                    Tr[seg * 16 + pl] = xr; Ti[seg * 16 + pl] = xi;
                    __syncthreads();
                    xr = 0.f; xi = 0.f;
                    for (int s2 = 0; s2 < seg; ++s2) { const float nr = br * xr - bi * xi + Tr[s2 * 16 + pl], ni = br * xi + bi * xr + Ti[s2 * 16 + pl]; xr = nr; xi = ni; }
                    bf16_t* sp = AG + (size_t)(g * 512 + 16 * seg) * 640 + 512 + p;
#pragma unroll
                    for (int k = 0; k < 16; ++k) { sp[(size_t)k * 640] = (bf16_t)(cvt_pk_bf16(xr, 0.f) & 0xffffu); sp[(size_t)k * 640 + 64] = (bf16_t)(cvt_pk_bf16(xi, 0.f) & 0xffffu);
                        const float nr = ar * xr - ai * xi + er[k], ni = ar * xi + ai * xr + ei[k]; xr = nr; xi = ni; }
                }
            }
            GSYNC();
            STAMP(5);
            for (int rep_ = 0; rep_ < 1 + (int)((REPMASK >> 9) & 1u); ++rep_) { PHASE_IDS
                pg8::Gemm g{(const bf16_t*)(R + R_AG), (const bf16_t*)(R + R_TS), 640, 640, 256};
                pg8::OrderS5Y so{G, bid};
                pg8::EpiY E{(const bf16_t*)(R + R_AG), in_ptr(P, 19) + e * D, (bf16_t*)(R + R_G)};
                pg8::gemm_phase(lds, g, so, E, wid);
            }
            GSYNC();
            STAMP(5);
            for (int rep_ = 0; rep_ < 1 + (int)((REPMASK >> 10) & 1u); ++rep_) { PHASE_IDS
            { const float* pin = in_ptr(P, 1) + (size_t)L * S * 256; bf16_t* PB = (bf16_t*)(R + R_PB);
              for (int t = gw; t < S; t += NGW) { const f32x4 pv = *((const f32x4*)(pin + (size_t)t * 256) + lane); *((u32x2*)(PB + (size_t)t * 256) + lane) = pack4(pv); } }
                pg8::Gemm g{(const bf16_t*)(R + R_G), (const bf16_t*)(ws + WS_WGLU) + (size_t)e * 2048 * 1024, 1024, 1024, 256};
                pg8::StaticOrder so; so.init(64, 8, G, bid);
                pg8::EpiGlu E{X, HN, (float*)(ws + WS_SS), (LAS float*)(lds + XL_OFF + 8448)};
                pg8::gemm_phase(lds, g, so, E, wid);
            }
            GSYNC();
            STAMP(5);
        }
        for (int rep_ = 0; rep_ < 1 + (int)((REPMASK >> 12) & 1u); ++rep_) { PHASE_IDS
            pg8::Gemm g{HNA, (const bf16_t*)(ws + WS_WUP) + (size_t)L * 5632 * 1024, 1024, 1024, 254};
            pg8::StaticOrder so; so.init(65, 22, G, bid);
            pg8::EpiConv E{(bf16_t*)(R + R_ACT), in_ptr(P, 22) + (size_t)L * 3 * 5632, in_ptr(P, 23) + (size_t)L * 5632, lds + XL_OFF, (const float*)(ws + WS_SS), (L & 1) ? 8 : 4};
            pg8::gemm_phase(lds, g, so, E, wid);
        }
        GSYNC();
        STAMP(6);
        for (int rep_ = 0; rep_ < 1 + (int)((REPMASK >> 13) & 1u); ++rep_) { PHASE_IDS
            pg8::Gemm g{(const bf16_t*)(R + R_ACT), (const bf16_t*)(ws + WS_WDN) + (size_t)L * 1024 * 2816, 2816, 2816, 256};
            pg8::StaticOrder so; so.init(64, 4, G, bid);
            pg8::EpiRes E{X, HN, (float*)(ws + WS_SS) + (size_t)S * 8, (LAS float*)(lds + XL_OFF + 8448)};
            pg8::gemm_phase(lds, g, so, E, wid);
        }
        GSYNC();
        STAMP(7);
        for (int rep_ = 0; rep_ < 1 + (int)((REPMASK >> 15) & 1u); ++rep_) { PHASE_IDS
            pg8::StaticOrder so; so.init(64, 4, G, bid);
            { pg8::Gemm g{(const bf16_t*)(R + R_PB), (const bf16_t*)(ws + WS_WPR) + (size_t)L * 1024 * 256, 256, 256, 256};
              pg8::EpiStore E{(bf16_t*)(R + R_PP), D, 0};
              pg8::gemm_phase(lds, g, so, E, wid); }
            asm volatile("s_waitcnt vmcnt(0)" ::: "memory"); __syncthreads();
            { pg8::Gemm g{HN, (const bf16_t*)(ws + WS_WGT) + (size_t)L * 1024 * 1024, 1024, 1024, 256};
              pg8::EpiGate E{X, (const bf16_t*)(R + R_PP), (const float*)(ws + WS_SS) + (size_t)S * 8};
              pg8::gemm_phase(lds, g, so, E, wid); }
        }
        GSYNC();
        STAMP(8);
        for (int xs = 0; xs < XSYNC; ++xs) GSYNC();
    }
#ifdef PROBE_SEL
    if (bid == 0) { __syncthreads(); float tot = 0.f; for (int i = 0; i < 16; ++i) tot += tacc[i];
        const float f = (PROBE_SEL < 0) ? 1.f : tacc[PROBE_SEL < 0 ? 0 : PROBE_SEL] / tot;
        for (int i = threadIdx.x; i < 524288; i += 512) X[i] += 0.2f * f; }
#endif
}

extern "C" void kernel_launch(void* const* d_in, const int* in_sizes, int n_in, void* d_out, int out_size, void* d_ws, size_t ws_size, hipStream_t stream) {
    static int grid = 0;
    if (grid == 0) {
        if (n_in != 27 || out_size != S * D || ws_size < WS_END) { fprintf(stderr, "kernel_launch: unexpected shapes (n_in %d out %d ws %zu need %zu)\n", n_in, out_size, ws_size, (size_t)WS_END); grid = -1; return; }
        int dev = 0, cus = 0, per_cu = 0;
        hipGetDevice(&dev); hipDeviceGetAttribute(&cus, hipDeviceAttributeMultiprocessorCount, dev);
        hipFuncSetAttribute((const void*)mega, hipFuncAttributeMaxDynamicSharedMemorySize, LDS_BYTES);
        hipOccupancyMaxActiveBlocksPerMultiprocessor(&per_cu, (const void*)mega, 512, LDS_BYTES);
        if (per_cu < 1) per_cu = 1;
        grid = cus * per_cu;
    }
    if (grid < 0) return;
    Params p{};
    for (int i = 0; i < 27; ++i) p.in[i] = (const float*)d_in[i];
    p.out = (float*)d_out; p.ws = (unsigned char*)d_ws;
    hipMemsetAsync((char*)d_ws + WS_BAR, 0, ZERO_BYTES, stream);
    void* args[] = {&p};
    hipError_t err = hipLaunchCooperativeKernel((const void*)mega, dim3(grid), dim3(512), args, LDS_BYTES, stream);
    if (err != hipSuccess) fprintf(stderr, "cooperative launch failed: %s (grid %d)\n", hipGetErrorString(err), grid);
}
```

```cpp
#include <hip/hip_runtime.h>
#include <hip/hip_cooperative_groups.h>
#include <cstdio>
#include <cstdint>
namespace cg = cooperative_groups;

#define LAS __attribute__((address_space(3)))
typedef unsigned short bf16_t;
typedef short bf16x8 __attribute__((ext_vector_type(8)));
typedef float f32x4 __attribute__((ext_vector_type(4)));
typedef unsigned u32x4 __attribute__((ext_vector_type(4)));
typedef unsigned u32x2 __attribute__((ext_vector_type(2)));

constexpr int S = 16384, D = 1024, FF = 2816, ZW = 2560;
constexpr float EPS = 1e-6f;
constexpr float LOG2E = 1.4426950408889634f;

__device__ __forceinline__ float zero_f() { float z; asm volatile("v_mov_b32 %0, 0" : "=v"(z)); return z; }
__device__ __forceinline__ unsigned cvt_pk_bf16(float lo, float hi) { unsigned r; asm volatile("v_cvt_pk_bf16_f32 %0, %1, %2" : "=v"(r) : "v"(lo), "v"(hi)); return r; }
__device__ __forceinline__ float bf2f(unsigned b) { return __uint_as_float(b << 16); }
__device__ __forceinline__ float sigm(float z) { return __builtin_amdgcn_rcpf(1.f + __builtin_amdgcn_exp2f(-LOG2E * z)); }
__device__ __forceinline__ float gelu_t(float x) { const float z = 1.5957691216057308f * (x + 0.044715f * x * x * x); return x * sigm(z); }
__device__ __forceinline__ u32x2 pack4(f32x4 v) { u32x2 w; w.x = cvt_pk_bf16(v[0], v[1]); w.y = cvt_pk_bf16(v[2], v[3]); return w; }
__device__ __forceinline__ f32x4 unpack4(u32x2 w) { return (f32x4){bf2f(w.x & 0xffffu), bf2f(w.x >> 16), bf2f(w.y & 0xffffu), bf2f(w.y >> 16)}; }
#define DPPF(v, ctrl) __int_as_float(__builtin_amdgcn_update_dpp(0, __float_as_int(v), (ctrl), 0xf, 0xf, false))
__device__ __forceinline__ float x1_sum(float v) { return v + DPPF(v, 0xB1); }
__device__ __forceinline__ float x2_sum(float v) { v += DPPF(v, 0xB1); return v + DPPF(v, 0x4E); }
__device__ __forceinline__ float x3_sum(float v) { v = x2_sum(v); return v + DPPF(v, 0x141); }
__device__ __forceinline__ float row_sum(float v) { v = x3_sum(v); return v + DPPF(v, 0x140); }
__device__ __forceinline__ float row_max(float v) { v = fmaxf(v, DPPF(v, 0xB1)); v = fmaxf(v, DPPF(v, 0x4E)); v = fmaxf(v, DPPF(v, 0x141)); return fmaxf(v, DPPF(v, 0x140)); }
__device__ __forceinline__ float max3f(float a, float b, float c) { float r; asm("v_max3_f32 %0, %1, %2, %3" : "=v"(r) : "v"(a), "v"(b), "v"(c)); return r; }
__device__ __forceinline__ float quad_max(float v) {
    auto a = __builtin_amdgcn_permlane16_swap(__float_as_uint(v), __float_as_uint(v), false, false); v = fmaxf(__uint_as_float(a[0]), __uint_as_float(a[1]));
    auto b = __builtin_amdgcn_permlane32_swap(__float_as_uint(v), __float_as_uint(v), false, false); return fmaxf(__uint_as_float(b[0]), __uint_as_float(b[1]));
}
__device__ __forceinline__ float quad_sum(float v) {
    auto a = __builtin_amdgcn_permlane16_swap(__float_as_uint(v), __float_as_uint(v), false, false); v = __uint_as_float(a[0]) + __uint_as_float(a[1]);
    auto b = __builtin_amdgcn_permlane32_swap(__float_as_uint(v), __float_as_uint(v), false, false); return __uint_as_float(b[0]) + __uint_as_float(b[1]);
}
__device__ __forceinline__ float wave_min(float v) { return -quad_max(row_max(-v)); }
__device__ __forceinline__ float wave_sum(float v) { return quad_sum(row_sum(v)); }
__device__ __forceinline__ float wave_max(float v) { return quad_max(row_max(v)); }

namespace pg8 {
constexpr int BM = 256, BK = 64, HALF = 128, HTB = HALF * BK * 2, STAGE_BYTES = 8 * HTB, NXCD = 8, WGM = 8;
__host__ __device__ __forceinline__ int lds_byte(int r, int c) { const int st = (r >> 4) * 2 + (c >> 5), rr = r & 15, cc = c & 31, ob = rr * 64 + cc * 2; return st * 1024 + (ob ^ (((ob >> 9) & 1) << 5)); }
__host__ __device__ __forceinline__ void stage_rc(int b, int& R, int& C) { const int st = b / 1024, sb = b % 1024, swz = sb ^ (((sb >> 9) & 1) << 5); R = (st >> 1) * 16 + swz / 64; C = (st & 1) * 32 + (swz % 64) / 2; }
__host__ __device__ __forceinline__ int perm32(int rho) { const int n = rho >> 4, i = rho & 15; return 8 * (i >> 2) + 4 * n + (i & 3); }
struct Unit { int pm, pn; };
struct Gemm { const bf16_t* A; const bf16_t* Bt; int K, lda, arows; };

struct StaticOrder {
    int nM, nN, nwg, G, c;
    __device__ void init(int nM_, int nN_, int G_, int c_) { nM = nM_; nN = nN_; nwg = nM * nN; G = G_; c = c_; }
    __device__ bool next(int i, Unit& u) const {
        const long L = (long)i * G + c; if (L >= nwg) return false;
        int wgid = (int)L; { const int q = nwg / NXCD, r = nwg % NXCD, xcd = wgid % NXCD, off = wgid / NXCD; wgid = (xcd < r ? xcd * (q + 1) : r * (q + 1) + (xcd - r) * q) + off; }
        const int nig = WGM * nN, gid = wgid / nig, fm = gid * WGM, gsz = (nM - fm) < WGM ? (nM - fm) : WGM;
        u.pm = fm + ((wgid % nig) % gsz); u.pn = (wgid % nig) / gsz; return true;
    }
};
struct OrderSpare {
    int G, c, r; __device__ void init(int G_, int c_, int nprev) { G = G_; c = c_; r = nprev % G_; }
    __device__ bool next(int i, Unit& u) const { const int w = r ? c - r : c, nsp = r ? G - r : G; if (w < 0) return false; const int L = w + nsp * i; if (L >= 256) return false; u.pm = L >> 2; u.pn = L & 3; return true; }
};
struct OrderS5E { int G, c; __device__ bool next(int i, Unit& u) const { const int L = i * G + c; if (L >= 128) return false; u.pm = L; u.pn = L >> 1; return true; } };
struct OrderS5Y { int G, c; __device__ bool next(int i, Unit& u) const { const int L = i * G + c; if (L >= 256) return false; const int g = L >> 2; u.pm = 2 * g + ((L >> 1) & 1); u.pn = 2 * g + (L & 1); return true; } };

template <class Epi, class Sched>
__device__ __forceinline__ void gemm_phase(LAS unsigned char* lds, const Gemm g, const Sched& S, const Epi& E, int wid_) {
    int lane_; asm volatile("v_mbcnt_lo_u32_b32 %0, -1, 0\n\tv_mbcnt_hi_u32_b32 %0, -1, %0" : "=v"(lane_));
    const int wid = __builtin_amdgcn_readfirstlane(wid_), lane = lane_, tid = wid * 64 + lane, wr = wid >> 2, wc = wid & 3, fr = lane & 15, fq = lane >> 4;
    const int K = g.K, nt = K / BK, lda = g.lda;
    unsigned voffA[2], voffB[2];
#pragma unroll
    for (int i = 0; i < 2; ++i) { int R, C; stage_rc(tid * 16 + i * 8192, R, C); const int Rb = Epi::PERM ? ((R & ~31) + perm32(R & 31)) : R; voffA[i] = (unsigned)(R * lda + C) * 2u; voffB[i] = (unsigned)(Rb * K + C) * 2u; }
    const size_t kstep = (size_t)(BK * 2);
    const size_t hstepA = (size_t)HALF * lda * 2, hstepB = (size_t)HALF * K * 2;
    const size_t tstepA = (size_t)g.arows * lda * 2, tstepB = 2 * hstepB;
    const unsigned ldsw = (unsigned)wid * 1024u;
    const int aoff = lds_byte(wr * 64 + fr, fq * 8), boff = lds_byte(wc * 32 + fr, fq * 8);
#define PG8_SA(b, h) (((b) * 2 + (h)) * HTB)
#define PG8_SB(b, h) ((4 + (b) * 2 + (h)) * HTB)
#define PG8_STAGE(bufoff, gbase, voff) do { _Pragma("unroll") for (int _i = 0; _i < 2; ++_i) \
        __builtin_amdgcn_global_load_lds((const unsigned*)((const char*)(gbase) + (voff)[_i]), (LAS unsigned*)(lds + (bufoff) + ldsw + _i * 8192), 16, 0, 0); } while (0)
#define PG8_LDA(dst, b, h) do { _Pragma("unroll") for (int m = 0; m < 4; ++m) _Pragma("unroll") for (int k = 0; k < 2; ++k) dst[m][k] = *(const LAS bf16x8*)(lds + PG8_SA(b, h) + aoff + m * 2048 + k * 1024); } while (0)
#define PG8_LDB(dst, b, h) do { _Pragma("unroll") for (int n = 0; n < 2; ++n) _Pragma("unroll") for (int k = 0; k < 2; ++k) dst[n][k] = *(const LAS bf16x8*)(lds + PG8_SB(b, h) + boff + n * 2048 + k * 1024); } while (0)
#define PG8_MMA(ai, bj, At, Bt) do { __builtin_amdgcn_s_setprio(1); _Pragma("unroll") for (int m = 0; m < 4; ++m) _Pragma("unroll") for (int n = 0; n < 2; ++n) _Pragma("unroll") for (int k = 0; k < 2; ++k) \
        acc[ai][bj][m][n] = __builtin_amdgcn_mfma_f32_16x16x32_bf16(Bt[n][k], At[m][k], acc[ai][bj][m][n], 0, 0, 0); __builtin_amdgcn_s_setprio(0); } while (0)
#define PG8_WAIT_V(n) asm volatile("s_waitcnt vmcnt(" #n ")" ::: "memory")
#define PG8_WAIT_L(n) asm volatile("s_waitcnt lgkmcnt(" #n ")" ::: "memory")
#define PG8_BAR __builtin_amdgcn_s_barrier()
#define PG8_SCHED __builtin_amdgcn_sched_barrier(0)
    Unit cur, nxt; int ui = 0;
    if (!S.next(0, cur)) return;
    f32x4 acc[2][2][4][2];
    float zr_; asm volatile("v_mov_b32 %0, 0" : "=v"(zr_));
#pragma unroll
    for (int a = 0; a < 2; ++a)
#pragma unroll
        for (int b = 0; b < 2; ++b)
#pragma unroll
            for (int m = 0; m < 4; ++m)
#pragma unroll
                for (int n = 0; n < 2; ++n) acc[a][b][m][n] = (f32x4){zr_, zr_, zr_, zr_};
    bf16x8 At[4][2], B0[2][2], B1[2][2];
    const char* cA = (const char*)g.A + (size_t)cur.pm * tstepA; const char* cB = (const char*)g.Bt + (size_t)cur.pn * tstepB;
    PG8_STAGE(PG8_SB(0, 0), cB, voffB); PG8_STAGE(PG8_SB(0, 1), cB + hstepB, voffB); PG8_STAGE(PG8_SA(0, 0), cA, voffA); PG8_STAGE(PG8_SA(0, 1), cA + hstepA, voffA);
    if (wr == 1) PG8_BAR;
    PG8_WAIT_V(2); PG8_BAR;
    PG8_STAGE(PG8_SB(1, 0), cB + kstep, voffB); PG8_STAGE(PG8_SA(1, 0), cA + kstep, voffA); PG8_STAGE(PG8_SB(1, 1), cB + hstepB + kstep, voffB);
    PG8_WAIT_V(6); PG8_BAR;
    for (;;) {
        const bool has_next = S.next(ui + 1, nxt);
        const char* nA = has_next ? (const char*)g.A + (size_t)nxt.pm * tstepA : cA; const char* nB = has_next ? (const char*)g.Bt + (size_t)nxt.pn * tstepB : cB;
        for (int t = 0; t < nt; t += 2) {
            const bool last = (t == nt - 2);
            const char* a1 = cA + (size_t)(t + 1) * kstep;
            const char* a2 = last ? nA : cA + (size_t)(t + 2) * kstep; const char* b2 = last ? nB : cB + (size_t)(t + 2) * kstep;
            const char* a3 = a2 + kstep; const char* b3 = b2 + kstep;
            PG8_LDB(B0, 0, 0); PG8_LDB(B1, 0, 1); PG8_SCHED; PG8_LDA(At, 0, 0); PG8_STAGE(PG8_SA(1, 1), a1 + hstepA, voffA);
            PG8_WAIT_V(8); PG8_WAIT_L(0); PG8_BAR; PG8_MMA(0, 0, At, B0); PG8_MMA(0, 1, At, B1); PG8_BAR; PG8_SCHED;
            PG8_LDA(At, 0, 1); PG8_STAGE(PG8_SB(0, 0), b2, voffB); PG8_STAGE(PG8_SB(0, 1), b2 + hstepB, voffB); PG8_STAGE(PG8_SA(0, 0), a2, voffA);
            PG8_WAIT_V(8); PG8_WAIT_L(0); PG8_BAR; PG8_MMA(1, 0, At, B0); PG8_MMA(1, 1, At, B1); PG8_BAR; PG8_SCHED;
            PG8_LDB(B0, 1, 0); PG8_LDB(B1, 1, 1); PG8_SCHED; PG8_LDA(At, 1, 0); PG8_STAGE(PG8_SA(0, 1), a2 + hstepA, voffA);
            PG8_WAIT_V(8); PG8_WAIT_L(0); PG8_BAR; PG8_MMA(0, 0, At, B0); PG8_MMA(0, 1, At, B1); PG8_BAR; PG8_SCHED;
            PG8_LDA(At, 1, 1); PG8_STAGE(PG8_SB(1, 0), b3, voffB); PG8_STAGE(PG8_SB(1, 1), b3 + hstepB, voffB); PG8_STAGE(PG8_SA(1, 0), a3, voffA);
            PG8_WAIT_V(8); PG8_WAIT_L(0); PG8_BAR; PG8_MMA(1, 0, At, B0); PG8_MMA(1, 1, At, B1); PG8_BAR; PG8_SCHED;
        }
        if (wr == 0) PG8_BAR;
        E(acc, cur, wr, wc, fr, fq);
        if (!has_next) break;
        asm volatile("v_mov_b32 %0, 0" : "=v"(zr_));
#pragma unroll
        for (int a = 0; a < 2; ++a)
#pragma unroll
            for (int b = 0; b < 2; ++b)
#pragma unroll
                for (int m = 0; m < 4; ++m)
#pragma unroll
                    for (int n = 0; n < 2; ++n) acc[a][b][m][n] = (f32x4){zr_, zr_, zr_, zr_};
        cur = nxt; cA = nA; cB = nB; ++ui;
        if (wr == 1) PG8_BAR;
    }
    PG8_WAIT_V(0);
    PG8_BAR;
#undef PG8_SA
#undef PG8_SB
#undef PG8_STAGE
#undef PG8_LDA
#undef PG8_LDB
#undef PG8_MMA
#undef PG8_WAIT_V
#undef PG8_WAIT_L
#undef PG8_BAR
#undef PG8_SCHED
}

typedef f32x4 Acc[2][2][4][2];
__device__ __forceinline__ float row_rs(const float* SSP, int row, int nsl) {
    const f32x4 a = *(const f32x4*)(SSP + (size_t)row * 8); float s = (a[0] + a[1]) + (a[2] + a[3]);
    if (nsl == 8) { const f32x4 b = *(const f32x4*)(SSP + (size_t)row * 8 + 4); s += (b[0] + b[1]) + (b[2] + b[3]); }
    return __builtin_amdgcn_rsqf(s * (1.f / D) + EPS);
}
__device__ __forceinline__ void ss_publish(LAS float* ssl, float* SSP, int row0, int slot, int wr, int wc, int fr, int fq) {
    asm volatile("s_waitcnt lgkmcnt(0)" ::: "memory"); __builtin_amdgcn_s_barrier(); asm volatile("" ::: "memory");
    const int t = (wr * 4 + wc) * 64 + fq * 16 + fr;
    if (t < 256) SSP[(size_t)(row0 + t) * 8 + slot] = (ssl[t] + ssl[256 + t]) + (ssl[512 + t] + ssl[768 + t]);
}
struct EpiRes {
    static constexpr bool PERM = true;
    float* X_; bf16_t* XB_; float* SS; LAS float* ssl;
    __device__ __forceinline__ void operator()(Acc& acc, const Unit& u, int wr, int wc, int fr, int fq) const {
        float* __restrict__ X = X_; bf16_t* __restrict__ XB = XB_;
#pragma unroll
        for (int ai = 0; ai < 2; ++ai)
#pragma unroll
            for (int m = 0; m < 4; ++m) { const int rl = ai * 128 + wr * 64 + m * 16 + fr, row = u.pm * 256 + rl; const size_t off = (size_t)row * D + u.pn * 256 + wc * 32 + 8 * fq; float ssum = 0.f;
#pragma unroll
                for (int bj = 0; bj < 2; ++bj) { f32x4* q = (f32x4*)(X + off + bj * 128); const f32x4 x0 = q[0] + acc[ai][bj][m][0], x1 = q[1] + acc[ai][bj][m][1]; q[0] = x0; q[1] = x1;
                    const u32x2 p0 = pack4(x0), p1 = pack4(x1); *(u32x4*)(XB + off + bj * 128) = (u32x4){p0.x, p0.y, p1.x, p1.y};
                    ssum += ((x0[0] * x0[0] + x0[1] * x0[1]) + (x0[2] * x0[2] + x0[3] * x0[3])) + ((x1[0] * x1[0] + x1[1] * x1[1]) + (x1[2] * x1[2] + x1[3] * x1[3])); }
                ssum = quad_sum(ssum); if (fq == 0) ssl[wc * 256 + rl] = ssum; }
        ss_publish(ssl, SS, u.pm * 256, u.pn, wr, wc, fr, fq);
    }
};
struct EpiStore {
    static constexpr bool PERM = true;
    bf16_t* O; int ld; int mode;
    __device__ __forceinline__ void operator()(Acc& acc, const Unit& u, int wr, int wc, int fr, int fq) const {
        const bool act = mode == 1 && (u.pn < 2 || u.pn == 4 || u.pn == 5);
#pragma unroll
        for (int ai = 0; ai < 2; ++ai)
#pragma unroll
            for (int m = 0; m < 4; ++m) { bf16_t* rp = O + (size_t)(u.pm * 256 + ai * 128 + wr * 64 + m * 16 + fr) * ld + u.pn * 256 + wc * 32 + 8 * fq;
#pragma unroll
                for (int bj = 0; bj < 2; ++bj) { f32x4 v0 = acc[ai][bj][m][0], v1 = acc[ai][bj][m][1];
                    if (act) { v0[0] = gelu_t(v0[0]); v0[1] = gelu_t(v0[1]); v0[2] = gelu_t(v0[2]); v0[3] = gelu_t(v0[3]); v1[0] = gelu_t(v1[0]); v1[1] = gelu_t(v1[1]); v1[2] = gelu_t(v1[2]); v1[3] = gelu_t(v1[3]); }
                    const u32x2 p0 = pack4(v0), p1 = pack4(v1); *(u32x4*)(rp + bj * 128) = (u32x4){p0.x, p0.y, p1.x, p1.y}; } }
    }
};
struct EpiGate {
    static constexpr bool PERM = true;
    float* X_; const bf16_t* PP_; const float* SS_;
    __device__ __forceinline__ void operator()(Acc& acc, const Unit& u, int wr, int wc, int fr, int fq) const {
        float* __restrict__ X = X_; const bf16_t* __restrict__ PP = PP_; const float* __restrict__ SS = SS_;
#pragma unroll
        for (int ai = 0; ai < 2; ++ai)
#pragma unroll
            for (int m = 0; m < 4; ++m) { const int row = u.pm * 256 + ai * 128 + wr * 64 + m * 16 + fr; const float rs = row_rs(SS, row, 4); const size_t off = (size_t)row * D + u.pn * 256 + wc * 32 + 8 * fq;
#pragma unroll
                for (int bj = 0; bj < 2; ++bj) { const u32x4 pw = *(const u32x4*)(PP + off + bj * 128); f32x4* q = (f32x4*)(X + off + bj * 128);
#pragma unroll
                    for (int n = 0; n < 2; ++n) { const f32x4 a = acc[ai][bj][m][n] * rs; const f32x4 pp = unpack4(n == 0 ? (u32x2){pw.x, pw.y} : (u32x2){pw.z, pw.w}); f32x4 x = q[n];
                        x[0] += sigm(a[0]) * pp[0]; x[1] += sigm(a[1]) * pp[1]; x[2] += sigm(a[2]) * pp[2]; x[3] += sigm(a[3]) * pp[3]; q[n] = x; } } }
    }
};
struct EpiGlu {
    static constexpr bool PERM = true;
    float* X_; bf16_t* XB_; float* SS; LAS float* ssl;
    __device__ __forceinline__ void operator()(Acc& acc, const Unit& u, int wr, int wc, int fr, int fq) const {
        float* __restrict__ X = X_; bf16_t* __restrict__ XB = XB_;
#pragma unroll
        for (int ai = 0; ai < 2; ++ai)
#pragma unroll
            for (int m = 0; m < 4; ++m) { const int rl = ai * 128 + wr * 64 + m * 16 + fr, row = u.pm * 256 + rl; const size_t off = (size_t)row * D + u.pn * 128 + wc * 32 + 8 * fq; float ssum = 0.f;
                f32x4* q = (f32x4*)(X + off); f32x4 xs[2];
#pragma unroll
                for (int n = 0; n < 2; ++n) { const f32x4 a = acc[ai][0][m][n], b = acc[ai][1][m][n]; f32x4 x = q[n];
                    x[0] += a[0] * sigm(b[0]); x[1] += a[1] * sigm(b[1]); x[2] += a[2] * sigm(b[2]); x[3] += a[3] * sigm(b[3]); q[n] = x; xs[n] = x;
                    ssum += (x[0] * x[0] + x[1] * x[1]) + (x[2] * x[2] + x[3] * x[3]); }
                { const u32x2 p0 = pack4(xs[0]), p1 = pack4(xs[1]); *(u32x4*)(XB + off) = (u32x4){p0.x, p0.y, p1.x, p1.y}; }
                ssum = quad_sum(ssum); if (fq == 0) ssl[wc * 256 + rl] = ssum; }
        ss_publish(ssl, SS, u.pm * 256, u.pn, wr, wc, fr, fq);
    }
};
struct EpiE {
    static constexpr bool PERM = false;
    float* Eo;
    __device__ __forceinline__ void operator()(Acc& acc, const Unit& u, int wr, int wc, int fr, int fq) const {
#pragma unroll
        for (int ai = 0; ai < 2; ++ai)
#pragma unroll
            for (int m = 0; m < 4; ++m) { float* rp = Eo + (size_t)(u.pm * 256 + ai * 128 + wr * 64 + m * 16 + fr) * 128 + wc * 32 + 4 * fq;
#pragma unroll
                for (int n = 0; n < 2; ++n) *(f32x4*)(rp + n * 16) = acc[ai][0][m][n]; }
    }
};
struct EpiY {
    static constexpr bool PERM = false;
    const bf16_t* AG_; const float* Dv; bf16_t* Gm_;
    __device__ __forceinline__ void operator()(Acc& acc, const Unit& u, int wr, int wc, int fr, int fq) const {
        const bf16_t* __restrict__ AG = AG_; bf16_t* __restrict__ Gm = Gm_;
        const int g = u.pm >> 1, jj = u.pn & 1; const f32x4 d4 = *(const f32x4*)(Dv + g * 16 + 4 * fq);
#pragma unroll
        for (int ai = 0; ai < 2; ++ai)
#pragma unroll
            for (int m = 0; m < 4; ++m) { const int rowA = u.pm * 256 + ai * 128 + wr * 64 + m * 16 + fr; const int nchunk = rowA - g * 512;
#pragma unroll
                for (int bj = 0; bj < 2; ++bj)
#pragma unroll
                    for (int n = 0; n < 2; ++n) { const int sp = 16 * jj + 8 * bj + 2 * wc + n; const int t = nchunk * 32 + sp;
                        const f32x4 uu = unpack4(*(const u32x2*)(AG + (size_t)rowA * 640 + sp * 16 + 4 * fq));
                        f32x4 y = acc[ai][bj][m][n] + d4 * uu; y[0] = gelu_t(y[0]); y[1] = gelu_t(y[1]); y[2] = gelu_t(y[2]); y[3] = gelu_t(y[3]);
                        *(u32x2*)(Gm + (size_t)t * D + g * 16 + 4 * fq) = pack4(y); } }
    }
};
__device__ __forceinline__ float dpp_ror1(float v) { return __int_as_float(__builtin_amdgcn_update_dpp(0, __float_as_int(v), 0x121, 0xf, 0xf, false)); }
__device__ __forceinline__ float dpp_ror2(float v) { return __int_as_float(__builtin_amdgcn_update_dpp(0, __float_as_int(v), 0x122, 0xf, 0xf, false)); }
struct EpiConv {
    static constexpr bool PERM = false;
    bf16_t* ACT; const float* cw; const float* cb; LAS unsigned char* xl; const float* SS; int nsl;
    __device__ __forceinline__ float rsg(int gr) const { return (gr >= 0 && gr < S) ? row_rs(SS, gr, nsl) : 0.f; }
    __device__ __forceinline__ void operator()(Acc& acc, const Unit& u, int wr, int wc, int fr, int fq) const {
        LAS f32x4* xb = (LAS f32x4*)xl + (wr * 128 + wc * 8 + fq * 2 + (fr - 14)); asm volatile("" : "+v"(xb));
        LAS float* wl = (LAS float*)(xl + 8448) + (32 * wc + 4 * fq); asm volatile("" : "+v"(wl));
        LAS float* rl = (LAS float*)(xl + 12544) + (64 * wr + fr); asm volatile("" : "+v"(rl));
        { const int t = (wr * 4 + wc) * 64 + fq * 16 + fr; if (t < 256) { ((LAS float*)(xl + 12544))[t] = rsg(254 * u.pm - 2 + t);
              const int k = t >> 5, c4 = (t & 31) * 4, kk = k & 3; const float* srcp = (kk == 3 ? cb : cw + kk * 2 * FF) + (k >> 2) * FF + 128 * u.pn + c4;
              *(LAS f32x4*)((LAS float*)(xl + 8448) + k * 128 + c4) = *(const f32x4*)srcp; } }
        if (fr >= 14) {
#pragma unroll
            for (int ai = 0; ai < 2; ++ai) {
                if (2 * ai + wr <= 2) { const float rs = rsg(254 * u.pm - 2 + 128 * ai + 64 * wr + 48 + fr);
#pragma unroll
                    for (int bj = 0; bj < 2; ++bj)
#pragma unroll
                        for (int n = 0; n < 2; ++n) xb[256 * ai + 64 * bj + 32 * n] = acc[ai][bj][3][n] * rs; } }
        }
        asm volatile("s_waitcnt lgkmcnt(0)" ::: "memory"); __builtin_amdgcn_s_barrier(); asm volatile("" ::: "memory");
        int frl = fr; asm volatile("" : "+v"(frl));
        bf16_t* ab = ACT + (size_t)(254 * u.pm - 2 + 64 * wr + frl) * FF + 128 * u.pn + 32 * wc + 4 * fq;
#pragma unroll
        for (int ai = 0; ai < 2; ++ai) { const int s = 2 * ai + wr;
#pragma unroll
            for (int n = 0; n < 2; ++n) {
                asm volatile("" ::: "memory");
                const f32x4 wg0 = *(const LAS f32x4*)(wl + 16 * n), wg1 = *(const LAS f32x4*)(wl + 128 + 16 * n), wg2 = *(const LAS f32x4*)(wl + 256 + 16 * n), bg = *(const LAS f32x4*)(wl + 384 + 16 * n);
                const f32x4 wu0 = *(const LAS f32x4*)(wl + 512 + 16 * n), wu1 = *(const LAS f32x4*)(wl + 640 + 16 * n), wu2 = *(const LAS f32x4*)(wl + 768 + 16 * n), bu = *(const LAS f32x4*)(wl + 896 + 16 * n);
                float z0_; asm volatile("v_mov_b32 %0, 0" : "=v"(z0_));
                f32x4 pg = (f32x4){z0_, z0_, z0_, z0_}, pu = pg;
                if (s >= 1 && fr >= 14) { pg = xb[256 * ai - 128 + 32 * n]; pu = xb[256 * ai - 128 + 64 + 32 * n]; }
#pragma unroll
                for (int m = 0; m < 4; ++m) {
                    const int rt = 128 * ai + 64 * wr + 16 * m + fr; const int gr = 254 * u.pm - 2 + rt;
                    const float rs = rl[128 * ai + 16 * m];
                    const f32x4 cg_ = acc[ai][0][m][n] * rs, cu_ = acc[ai][1][m][n] * rs;
                    f32x4 T1g, T2g, T1u, T2u, P1g, P2g, P1u, P2u;
#pragma unroll
                    for (int e = 0; e < 4; ++e) { T1g[e] = fr == 15 ? pg[e] : cg_[e]; T2g[e] = fr >= 14 ? pg[e] : cg_[e]; T1u[e] = fr == 15 ? pu[e] : cu_[e]; T2u[e] = fr >= 14 ? pu[e] : cu_[e]; }
#pragma unroll
                    for (int e = 0; e < 4; ++e) { P1g[e] = dpp_ror1(T1g[e]); P2g[e] = dpp_ror2(T2g[e]); P1u[e] = dpp_ror1(T1u[e]); P2u[e] = dpp_ror2(T2u[e]); }
                    const f32x4 hg = bg + wg0 * P2g + wg1 * P1g + wg2 * cg_;
                    const f32x4 hu = bu + wu0 * P2u + wu1 * P1u + wu2 * cu_;
                    f32x4 ex = hg * (-LOG2E);
#pragma unroll
                    for (int e = 0; e < 4; ++e) ex[e] = __builtin_amdgcn_exp2f(ex[e]);
                    ex = ex + 1.0f;
#pragma unroll
                    for (int e = 0; e < 4; ++e) ex[e] = __builtin_amdgcn_rcpf(ex[e]);
                    const f32x4 o = (hg * hu) * ex;
                    if (rt >= 2 && gr < S) *(u32x2*)(ab + (size_t)(128 * ai + 16 * m) * FF + 16 * n) = pack4(o);
                    pg = cg_; pu = cu_;
                }
            }
        }
    }
};
}

constexpr size_t MiB = 1u << 20;
constexpr size_t WS_CL = 0, WS_CG = 524288, WS_GT = 1048576, WS_BAR = 1179648, BAR_BYTES = 16384, WS_SS = 1245184, ZERO_BYTES = 16384;
constexpr size_t WS_WIN = 3 * MiB;
constexpr size_t WS_WOUT = WS_WIN + 2ull * 2560 * 1024 * 2;
constexpr size_t WS_WGLU = WS_WOUT + 2ull * 1024 * 1024 * 2;
constexpr size_t WS_WUP = WS_WGLU + 2ull * 2048 * 1024 * 2;
constexpr size_t WS_WDN = WS_WUP + 4ull * 5632 * 1024 * 2;
constexpr size_t WS_WGT = WS_WDN + 4ull * 1024 * 2816 * 2;
constexpr size_t WS_WPR = WS_WGT + 4ull * 1024 * 1024 * 2;
constexpr size_t WS_HNA = WS_WPR + 4ull * 1024 * 256 * 2;
constexpr size_t WS_R = WS_HNA + (2ull + 16384 + 256) * 1024 * 2;
constexpr size_t WS_END = WS_R + 144 * MiB;
constexpr size_t R_Z = 0;
constexpr size_t R_AG = 0, R_TS = 40 * MiB, R_PS = 80 * MiB, R_E = 96 * MiB, R_G = 112 * MiB;
constexpr size_t R_ACT = 0;
constexpr size_t R_PB = 96 * MiB, R_PP = 104 * MiB;

#ifndef REPMASK
#define REPMASK 0u
#endif
#ifndef XSYNC
#define XSYNC 0
#endif
constexpr int LDS_BYTES = 147456, XL_OFF = 131072;

#define XB_TMO      128
#define XB_XCNT(j)  (256  + 64 * (j))
#define XB_XSUB(j)  (1280 + 64 * (j))
#define XB_XGEN(j)  (2304 + 64 * (j))
#define XB_TOP      3328
#define XB_TOPGEN   3392
#define XCD_BAR_WORDS 3456
#define XB_SPIN_CAP (1u << 18)
__device__ __forceinline__ unsigned xb_ld(unsigned* p)              { return __hip_atomic_load(p, __ATOMIC_RELAXED, __HIP_MEMORY_SCOPE_AGENT); }
__device__ __forceinline__ unsigned xb_add(unsigned* p, unsigned v) { return __hip_atomic_fetch_add(p, v, __ATOMIC_RELAXED, __HIP_MEMORY_SCOPE_AGENT); }
__device__ __forceinline__ unsigned xb_xcc_id() { return (unsigned)__builtin_amdgcn_s_getreg((3 << 11) | 20) & 0xFu; }
#define XB_SPIN(cond, bar) do { unsigned _sp = 0; while (cond) { __builtin_amdgcn_s_sleep(1); \
    if ((++_sp & 255u) == 0u) { if (xb_ld(&(bar)[XB_TMO])) break; if (_sp > XB_SPIN_CAP) { atomicAdd(&(bar)[XB_TMO], 1u); break; } } } } while (0)
struct XcdBarrier { unsigned* bar; unsigned x; volatile LAS unsigned* st; };
__device__ __forceinline__ XcdBarrier xcd_barrier_post(unsigned* bar, volatile LAS unsigned* st) {
    XcdBarrier b; b.bar = bar; b.x = xb_xcc_id(); b.st = st;
    if (threadIdx.x == 0) (void)xb_add(&bar[XB_XCNT(b.x)], 1u);
    return b;
}
__device__ __forceinline__ void xcd_barrier_complete(unsigned* bar, unsigned x, unsigned& nloc, unsigned& nx) {
    const unsigned G = gridDim.x * gridDim.y * gridDim.z;
    unsigned sum, cnt, mine, sp = 0u;
    for (;;) {
        sum = 0u; cnt = 0u; mine = 0u;
#pragma unroll
        for (unsigned j = 0; j < 16; ++j) { const unsigned c = xb_ld(&bar[XB_XCNT(j)]); sum += c; cnt += (c > 0u) ? 1u : 0u; mine = (j == x) ? c : mine; }
        if (sum == G) break;
        __builtin_amdgcn_s_sleep(1);
        if ((++sp & 255u) == 0u) { if (xb_ld(&bar[XB_TMO])) break; if (sp > XB_SPIN_CAP) { atomicAdd(&bar[XB_TMO], 1u); break; } }
    }
    nloc = mine > 0u ? mine : 1u; nx = cnt > 0u ? cnt : 1u;
}
__device__ __forceinline__ void xcd_barrier(unsigned* bar_, volatile LAS unsigned* st_, int wid_) {
    XcdBarrier b; b.bar = bar_; b.x = xb_xcc_id(); b.st = st_;
    asm volatile("s_waitcnt vmcnt(0)" ::: "memory");
    __syncthreads();
    int ln_; asm volatile("v_mbcnt_lo_u32_b32 %0, -1, 0\n\tv_mbcnt_hi_u32_b32 %0, -1, %0" : "=v"(ln_));
    if (wid_ == 0 && ln_ == 0) {
        unsigned* bar = b.bar;
        __builtin_amdgcn_s_waitcnt(0);
        unsigned nloc = b.st[0], nx = b.st[1];
        if (nloc == 0u) { xcd_barrier_complete(bar, b.x, nloc, nx); b.st[0] = nloc; b.st[1] = nx; }
        const unsigned old = xb_add(&bar[XB_XSUB(b.x)], 1u);
        const unsigned gen = old / nloc;
        if (old + 1u == (gen + 1u) * nloc) {
            __builtin_amdgcn_fence(__ATOMIC_RELEASE, "agent");
            asm volatile("s_waitcnt vmcnt(0)" ::: "memory");
            const unsigned og = xb_add(&bar[XB_TOP], 1u);
            const unsigned tg = og / nx;
            if (og + 1u == (tg + 1u) * nx) xb_add(&bar[XB_TOPGEN], 1u);
            else XB_SPIN(xb_ld(&bar[XB_TOPGEN]) == tg, bar);
            __builtin_amdgcn_fence(__ATOMIC_ACQUIRE, "agent");
            xb_add(&bar[XB_XGEN(b.x)], 1u);
            asm volatile("s_waitcnt vmcnt(0)" ::: "memory");
        } else {
            XB_SPIN(xb_ld(&bar[XB_XGEN(b.x)]) == gen, bar);
            __builtin_amdgcn_fence(__ATOMIC_ACQUIRE, "agent");
            asm volatile("s_waitcnt vmcnt(0)" ::: "memory");
        }
    }
    __syncthreads();
}

struct Params { const float* in[27]; float* out; unsigned char* ws; };

__device__ __forceinline__ float load_row(const float* xrow, int lane, f32x4 (&v)[4]) {
    const f32x4* xr = (const f32x4*)xrow + lane; float ss = 0.f;
#pragma unroll
    for (int j = 0; j < 4; ++j) { v[j] = xr[64 * j]; ss += (v[j][0] * v[j][0] + v[j][1] * v[j][1]) + (v[j][2] * v[j][2] + v[j][3] * v[j][3]); }
    return __builtin_amdgcn_rsqf(wave_sum(ss) * (1.f / D) + EPS);
}

__device__ __forceinline__ void transpose_item(const float* W, int K, int ldw, bf16_t* WT, int n0, int drow0, int kb, LAS float* scr, int lane, const float* gain) {
    const int k0 = 64 * kb; const float* wp = W + (size_t)k0 * ldw + n0 + lane;
#pragma unroll 16
    for (int i = 0; i < 64; ++i) scr[i * 65 + lane] = wp[(size_t)i * ldw] * (gain ? gain[k0 + i] : 1.f);
    asm volatile("s_waitcnt lgkmcnt(0)" ::: "memory");
    const int c = lane & 7;
#pragma unroll
    for (int j = 0; j < 8; ++j) { const int n = (lane >> 3) + 8 * j; const LAS float* s = scr + (8 * c) * 65 + n;
        u32x4 o; o.x = cvt_pk_bf16(s[0 * 65], s[1 * 65]); o.y = cvt_pk_bf16(s[2 * 65], s[3 * 65]); o.z = cvt_pk_bf16(s[4 * 65], s[5 * 65]); o.w = cvt_pk_bf16(s[6 * 65], s[7 * 65]);
        *(u32x4*)(WT + (size_t)(drow0 + n) * K + k0 + 8 * c) = o; }
    asm volatile("s_waitcnt lgkmcnt(0)" ::: "memory");
}
__device__ __forceinline__ int dest_row(int mode, int n0, int half) {
    if (mode == 1) { const int seg = n0 >> 9, r = n0 & 511; const int ds = seg == 1 ? 2 : (seg == 2 ? 1 : seg); return ds * 512 + r; }
    if (mode == 2) { const int hi = n0 >= half, np = hi ? n0 - half : n0; return (np >> 7) * 256 + hi * 128 + (np & 127); }
    return n0;
}
__device__ __forceinline__ bool transpose_mat(int& r, const float* W, int K, int ldw, int ncols, bf16_t* WT, int mode, LAS float* scr, int lane, const float* gain = nullptr) {
    const int nblk = ncols / 64, items = (K / 64) * nblk;
    if (r >= items) { r -= items; return false; }
    const int kb = r / nblk, nb = r % nblk;
    transpose_item(W, K, ldw, WT, nb * 64, dest_row(mode, nb * 64, ncols / 2), kb, scr, lane, gain);
    return true;
}

__device__ __forceinline__ const float* in_ptr(const Params& P, int i) { asm volatile("" : "+s"(i)); return P.in[i]; }
__global__ void __launch_bounds__(512, 2) mega(Params P) {
    extern __shared__ __attribute__((aligned(16))) unsigned char lds_raw[];
    LAS unsigned char* lds = (LAS unsigned char*)lds_raw;
    cg::grid_group grid = cg::this_grid();
    const int G = gridDim.x, bid = blockIdx.x, NGW = G * 8;
    const int wid0 = __builtin_amdgcn_readfirstlane((int)threadIdx.x >> 6);
#define PHASE_IDS int lane_; asm volatile("v_mbcnt_lo_u32_b32 %0, -1, 0\n\tv_mbcnt_hi_u32_b32 %0, -1, %0" : "=v"(lane_)); const int lane = lane_, wid = wid0, tid = wid * 64 + lane, gw = bid * 8 + wid; (void)tid; (void)gw;
    unsigned char* ws = P.ws;
    float* X = P.out;
    float* CL = (float*)(ws + WS_CL); float* CGm = (float*)(ws + WS_CG); float* GT = (float*)(ws + WS_GT);
    bf16_t* HNA = (bf16_t*)(ws + WS_HNA); bf16_t* HN = HNA + 2 * D;
    unsigned char* R = ws + WS_R;
    { volatile LAS unsigned* st0 = (volatile LAS unsigned*)(lds + XL_OFF + 8192); if (threadIdx.x < 2) st0[threadIdx.x] = 0u; __syncthreads(); }
    (void)xcd_barrier_post((unsigned*)(ws + WS_BAR), (volatile LAS unsigned*)(lds + XL_OFF + 8192));
#define GSYNC() xcd_barrier((unsigned*)(P.ws + WS_BAR), (volatile LAS unsigned*)(lds + XL_OFF + 8192), wid0)
#ifdef PROBE_SEL
    LAS float* tacc = (LAS float*)(lds + XL_OFF + 13600); LAS unsigned long long* tlast = (LAS unsigned long long*)(lds + XL_OFF + 13696);
    if (threadIdx.x == 0) { for (int i = 0; i < 16; ++i) tacc[i] = 0.f; *tlast = __builtin_amdgcn_s_memrealtime(); }
#define STAMP(gid) do { if (bid == 0 && threadIdx.x == 0) { const unsigned long long t_ = __builtin_amdgcn_s_memrealtime(); tacc[gid] += (float)(t_ - *tlast); *tlast = t_; } } while (0)
#else
#define STAMP(gid) do {} while (0)
#endif

    for (int rep_ = 0; rep_ < 1 + (int)((REPMASK >> 0) & 1u); ++rep_) { PHASE_IDS
        LAS float* scr = (LAS float*)(lds + wid * 16640);
        constexpr int I_IN = 16 * 40, I_OUT = 16 * 16, I_GLU = 16 * 32, I_UP = 16 * 88, I_DN = 44 * 16, I_GT = 16 * 16, I_PR = 4 * 16;
        constexpr int NIT = 2 * I_IN + 2 * I_OUT + 2 * I_GLU + 4 * I_UP + 4 * I_DN + 4 * I_GT + 4 * I_PR;
        for (int it = gw; it < NIT; it += NGW) {
            int r = it; bool done = false;
#pragma unroll 1
            for (int e = 0; e < 2 && !done; ++e) done = transpose_mat(r, in_ptr(P, 4) + (size_t)e * 1024 * 2568, 1024, 2568, 2560, (bf16_t*)(ws + WS_WIN) + (size_t)e * 2560 * 1024, 1, scr, lane);
#pragma unroll 1
            for (int e = 0; e < 2 && !done; ++e) done = transpose_mat(r, in_ptr(P, 11) + (size_t)e * 1024 * 1024, 1024, 1024, 1024, (bf16_t*)(ws + WS_WOUT) + (size_t)e * 1024 * 1024, 0, scr, lane);
#pragma unroll 1
            for (int e = 0; e < 2 && !done; ++e) done = transpose_mat(r, in_ptr(P, 20) + (size_t)e * 1024 * 2048, 1024, 2048, 2048, (bf16_t*)(ws + WS_WGLU) + (size_t)e * 2048 * 1024, 2, scr, lane);
#pragma unroll 1
            for (int e = 0; e < 4 && !done; ++e) done = transpose_mat(r, in_ptr(P, 21) + (size_t)e * 1024 * 5632, 1024, 5632, 5632, (bf16_t*)(ws + WS_WUP) + (size_t)e * 5632 * 1024, 2, scr, lane, in_ptr(P, 3) + e * D);
#pragma unroll 1
            for (int e = 0; e < 4 && !done; ++e) done = transpose_mat(r, in_ptr(P, 24) + (size_t)e * 2816 * 1024, 2816, 1024, 1024, (bf16_t*)(ws + WS_WDN) + (size_t)e * 1024 * 2816, 0, scr, lane);
#pragma unroll 1
            for (int e = 0; e < 4 && !done; ++e) done = transpose_mat(r, in_ptr(P, 26) + (size_t)e * 1024 * 1024, 1024, 1024, 1024, (bf16_t*)(ws + WS_WGT) + (size_t)e * 1024 * 1024, 0, scr, lane);
#pragma unroll 1
            for (int e = 0; e < 4 && !done; ++e) done = transpose_mat(r, in_ptr(P, 25) + (size_t)e * 256 * 1024, 256, 1024, 1024, (bf16_t*)(ws + WS_WPR) + (size_t)e * 1024 * 256, 0, scr, lane);
        }
        if (bid == 0) for (int i = tid; i < 2 * D / 2; i += 512) ((unsigned*)HNA)[i] = 0u;
    }
    grid.sync();
    STAMP(0);

#pragma unroll 1
    for (int L = 0; L < 4; ++L) {
        const int e = L >> 1;
        if ((L & 1) == 0) {
            for (int rep_ = 0; rep_ < 1 + (int)((REPMASK >> 1) & 1u); ++rep_) { PHASE_IDS
                const float* gmix = in_ptr(P, 2) + L * D; const float* Win = in_ptr(P, 4) + (size_t)e * 1024 * 2568; const float* bfg = in_ptr(P, 5) + e * 8;
                f32x4 wfa[16], wfb[16];
#pragma unroll
                for (int j = 0; j < 4; ++j)
#pragma unroll
                    for (int i = 0; i < 4; ++i) { const float* wp = Win + (size_t)(4 * lane + 256 * j + i) * 2568 + 2560; wfa[j * 4 + i] = *(const f32x4*)wp; wfb[j * 4 + i] = *(const f32x4*)(wp + 4); }
                const float* xsrc = (L == 0 ? in_ptr(P, 0) : X);
                LAS float* lw = (LAS float*)(lds + wid * 256);
                const float bbl = bfg[lane & 7];
                for (int gi = gw; gi < 2048; gi += NGW) {
                    f32x4 cur[4], nxt[4];
                    { const f32x4* xr = (const f32x4*)(xsrc + (size_t)(8 * gi) * D) + lane;
#pragma unroll
                      for (int j = 0; j < 4; ++j) cur[j] = xr[64 * j]; }
                    float myf = 0.f;
#pragma unroll 1
                    for (int rr = 0; rr < 8; ++rr) {
                        const int t = 8 * gi + rr;
                        if (rr < 7) { const f32x4* xr = (const f32x4*)(xsrc + (size_t)(t + 1) * D) + lane;
#pragma unroll
                            for (int j = 0; j < 4; ++j) nxt[j] = xr[64 * j]; }
                        float ss = 0.f;
#pragma unroll
                        for (int j = 0; j < 4; ++j) ss += (cur[j][0] * cur[j][0] + cur[j][1] * cur[j][1]) + (cur[j][2] * cur[j][2] + cur[j][3] * cur[j][3]);
                        const float rs = __builtin_amdgcn_rsqf(wave_sum(ss) * (1.f / D) + EPS);
                        if (L == 0) {
#pragma unroll
                            for (int j = 0; j < 4; ++j) *((f32x4*)(X + (size_t)t * D) + lane + 64 * j) = cur[j]; }
                        const float zf_ = zero_f(); f32x4 fa = (f32x4){zf_, zf_, zf_, zf_}, fb = fa;
#pragma unroll
                        for (int j = 0; j < 4; ++j) { const f32x4 gg = *((const f32x4*)gmix + lane + 64 * j); const f32x4 v = cur[j] * rs * gg;
                            *((u32x2*)(HN + (size_t)t * D) + lane + 64 * j) = pack4(v);
#pragma unroll
                            for (int i = 0; i < 4; ++i) { fa += wfa[j * 4 + i] * v[i]; fb += wfb[j * 4 + i] * v[i]; } }
                        float f0 = wave_sum(fa[0]), f1 = wave_sum(fa[1]), f2 = wave_sum(fa[2]), f3 = wave_sum(fa[3]), f4 = wave_sum(fb[0]), f5 = wave_sum(fb[1]), f6 = wave_sum(fb[2]), f7 = wave_sum(fb[3]);
                        const int h = lane & 7;
                        float sel = f0; sel = h == 1 ? f1 : sel; sel = h == 2 ? f2 : sel; sel = h == 3 ? f3 : sel; sel = h == 4 ? f4 : sel; sel = h == 5 ? f5 : sel; sel = h == 6 ? f6 : sel; sel = h == 7 ? f7 : sel;
                        myf = ((lane >> 3) == rr) ? sel : myf;
#pragma unroll
                        for (int j = 0; j < 4; ++j) cur[j] = nxt[j];
                    }
                    const float z = myf + bbl; const float ls = -__builtin_amdgcn_logf(1.f + __builtin_amdgcn_exp2f(-z * LOG2E));
                    lw[lane] = ls; asm volatile("s_waitcnt lgkmcnt(0)" ::: "memory");
                    float cum = 0.f;
#pragma unroll
                    for (int r2 = 0; r2 < 8; ++r2) { const float o_ = lw[r2 * 8 + (lane & 7)]; cum += (r2 <= (lane >> 3)) ? o_ : 0.f; }
                    asm volatile("s_waitcnt lgkmcnt(0)" ::: "memory");
                    CL[(size_t)gi * 64 + lane] = cum;
                    if (lane >= 56) GT[(size_t)gi * 8 + (lane & 7)] = cum;
                }
            }
            GSYNC();
            STAMP(1);
            for (int rep_ = 0; rep_ < 1 + (int)((REPMASK >> 2) & 1u); ++rep_) { PHASE_IDS
                pg8::Gemm g{HN, (const bf16_t*)(ws + WS_WIN) + (size_t)e * 2560 * 1024, 1024, 1024, 256};
                pg8::StaticOrder so; so.init(64, 10, G, bid);
                pg8::EpiStore E{(bf16_t*)(R + R_Z), ZW, 1};
                pg8::gemm_phase(lds, g, so, E, wid);
            }
            GSYNC();
            STAMP(2);
            for (int rep_ = 0; rep_ < 1 + (int)((REPMASK >> 3) & 1u); ++rep_) { PHASE_IDS
                bf16_t* Z = (bf16_t*)(R + R_Z);
                const float* gq = in_ptr(P, 6) + e * 64; const float* gk = in_ptr(P, 7) + e * 64;
                LAS float* CT = (LAS float*)(lds + 98304); LAS float* BT = CT + 2048; LAS float* OFF = BT + 512;
                __syncthreads();
                { const int ckk = tid >> 1, hq = (tid & 1) * 4; f32x4 s = (f32x4){0.f, 0.f, 0.f, 0.f};
#pragma unroll
                  for (int i = 0; i < 8; ++i) s += *(const f32x4*)(GT + (size_t)(8 * ckk + i) * 8 + hq);
                  *(LAS f32x4*)(CT + ckk * 8 + hq) = s; }
                __syncthreads();
                { const int h = tid & 7, b4 = tid >> 3; BT[b4 * 8 + h] = (CT[(4 * b4) * 8 + h] + CT[(4 * b4 + 1) * 8 + h]) + (CT[(4 * b4 + 2) * 8 + h] + CT[(4 * b4 + 3) * 8 + h]); }
                __syncthreads();
                { const int h = tid & 7, b4 = tid >> 3; float o_ = 0.f;
                  for (int i = 0; i < b4; ++i) o_ += BT[i * 8 + h];
#pragma unroll
                  for (int i = 0; i < 4; ++i) { OFF[(4 * b4 + i) * 8 + h] = o_; o_ += CT[(4 * b4 + i) * 8 + h]; } }
                __syncthreads();
                for (int ck = bid; ck < 256; ck += G) {
                    { const int h = tid & 7, tok = tid >> 3; float off = OFF[ck * 8 + h];
                      const int gl = tok >> 3;
                      for (int i2 = 0; i2 < gl; ++i2) off += GT[(size_t)(8 * ck + i2) * 8 + h];
                      const int t = 64 * ck + tok; CGm[(size_t)t * 8 + h] = CL[(size_t)t * 8 + h] + off; }
#pragma unroll 1
                    for (int ps4 = 0; ps4 < 16; ps4 += 4) {
                        u32x4 wq[4];
#pragma unroll
                        for (int q = 0; q < 4; ++q) { const int pair = (ps4 + q) * 64 + (tid >> 3); const int tok = pair >> 4, hh = (pair >> 1) & 7, isk = pair & 1;
                            wq[q] = *(const u32x4*)(Z + (size_t)(64 * ck + tok) * ZW + (isk ? 1536 : 512) + hh * 64 + (tid & 7) * 8); }
#pragma unroll
                        for (int q = 0; q < 4; ++q) { const int pair = (ps4 + q) * 64 + (tid >> 3), sub = tid & 7; const int tok = pair >> 4, hh = (pair >> 1) & 7, isk = pair & 1;
                            bf16_t* ptr = Z + (size_t)(64 * ck + tok) * ZW + (isk ? 1536 : 512) + hh * 64 + sub * 8;
                            const u32x4 w = wq[q]; float v[8];
                            v[0] = bf2f(w.x & 0xffffu); v[1] = bf2f(w.x >> 16); v[2] = bf2f(w.y & 0xffffu); v[3] = bf2f(w.y >> 16); v[4] = bf2f(w.z & 0xffffu); v[5] = bf2f(w.z >> 16); v[6] = bf2f(w.w & 0xffffu); v[7] = bf2f(w.w >> 16);
                            float ss = 0.f;
#pragma unroll
                            for (int i = 0; i < 8; ++i) ss += v[i] * v[i];
                            ss = x3_sum(ss);
                            const float rs = (__builtin_amdgcn_rsqf(ss * (1.f / 64.f) + EPS)) * (isk ? 1.f : 0.125f * LOG2E);
                            const float* gp = (isk ? gk : gq) + sub * 8;
#pragma unroll
                            for (int i = 0; i < 8; ++i) v[i] = v[i] * rs * gp[i];
                            u32x4 o; o.x = cvt_pk_bf16(v[0], v[1]); o.y = cvt_pk_bf16(v[2], v[3]); o.z = cvt_pk_bf16(v[4], v[5]); o.w = cvt_pk_bf16(v[6], v[7]);
                            { int rp_ = rep_; asm volatile("" : "+v"(rp_)); if (rp_) o = w; }
                            *(u32x4*)ptr = o; }
                    }
                    { LAS bf16_t* LT = (LAS bf16_t*)(lds + 1024); bf16_t* VTg = (bf16_t*)(R + 80 * MiB);
                      __syncthreads();
#pragma unroll 1
                      for (int k = 0; k < 8; ++k) { const int idx = tid + 512 * k; const int tok = idx & 63, cc = idx >> 6;
                          const u32x4 w = *(const u32x4*)(Z + (size_t)(64 * ck + tok) * ZW + 2048 + cc * 8); LAS bf16_t* lt = LT + (cc * 8) * 72 + tok;
                          lt[0 * 72] = (bf16_t)(w.x & 0xffffu); lt[1 * 72] = (bf16_t)(w.x >> 16); lt[2 * 72] = (bf16_t)(w.y & 0xffffu); lt[3 * 72] = (bf16_t)(w.y >> 16);
                          lt[4 * 72] = (bf16_t)(w.z & 0xffffu); lt[5 * 72] = (bf16_t)(w.z >> 16); lt[6 * 72] = (bf16_t)(w.w & 0xffffu); lt[7 * 72] = (bf16_t)(w.w >> 16); }
                      __syncthreads();
#pragma unroll 1
                      for (int k = 0; k < 8; ++k) { const int idx = tid + 512 * k; const int c = idx >> 3, part = idx & 7;
                          *(u32x4*)(VTg + (size_t)c * S + 64 * ck + part * 8) = *(const LAS u32x4*)(LT + c * 72 + part * 8); }
                    }
                }
                LAS bf16_t* Wsm = (LAS bf16_t*)lds; LAS bf16_t* VT = (LAS bf16_t*)(lds + 34816);
                const float* wsp = in_ptr(P, 9) + (size_t)e * 4 * 128 * 128; const float* bsp = in_ptr(P, 10) + e * 512; const float* vg = in_ptr(P, 8) + e * 512;
                for (int it = bid; it < 512; it += G) {
                    const int n = it >> 2, g = it & 3;
                    __syncthreads();
                    for (int idx = tid; idx < 128 * 32; idx += 512) { const int t = idx >> 5, s4 = (idx & 31) * 4; f32x4 w = *(const f32x4*)(wsp + ((size_t)g * 128 + t) * 128 + s4);
#pragma unroll
                        for (int i = 0; i < 4; ++i) if (s4 + i > t) w[i] = 0.f;
                        *(LAS u32x2*)(Wsm + t * 136 + s4) = pack4(w); }
                    { const int tok = tid >> 2, part = tid & 3; const bf16_t* vp = Z + (size_t)(128 * n + tok) * ZW + 1024 + g * 128 + part * 32;
                      float v[32]; float ss = 0.f;
#pragma unroll
                      for (int q = 0; q < 4; ++q) { const u32x4 w = *(const u32x4*)(vp + q * 8);
                          v[q * 8 + 0] = bf2f(w.x & 0xffffu); v[q * 8 + 1] = bf2f(w.x >> 16); v[q * 8 + 2] = bf2f(w.y & 0xffffu); v[q * 8 + 3] = bf2f(w.y >> 16);
                          v[q * 8 + 4] = bf2f(w.z & 0xffffu); v[q * 8 + 5] = bf2f(w.z >> 16); v[q * 8 + 6] = bf2f(w.w & 0xffffu); v[q * 8 + 7] = bf2f(w.w >> 16); }
#pragma unroll
                      for (int i = 0; i < 32; ++i) ss += v[i] * v[i];
                      ss = x2_sum(ss);
                      const float rs = __builtin_amdgcn_rsqf(ss * (1.f / 128.f) + EPS);
#pragma unroll
                      for (int i = 0; i < 32; ++i) { const int c = part * 32 + i; const float y = v[i] * rs * vg[g * 128 + c]; VT[c * 136 + tok] = (bf16_t)(cvt_pk_bf16(y, 0.f) & 0xffffu); } }
                    __syncthreads();
                    const int l15 = lane & 15, quad = lane >> 4;
                    f32x4 acc[8];
#pragma unroll
                    for (int cb = 0; cb < 8; ++cb) acc[cb] = (f32x4){0.f, 0.f, 0.f, 0.f};
                    for (int ks = 0; ks <= (wid >> 1); ++ks) {
                        const bf16x8 a = *(const LAS bf16x8*)(Wsm + (16 * wid + l15) * 136 + 32 * ks + quad * 8);
#pragma unroll
                        for (int cb = 0; cb < 8; ++cb) { const bf16x8 b = *(const LAS bf16x8*)(VT + (16 * cb + l15) * 136 + 32 * ks + quad * 8);
                            acc[cb] = __builtin_amdgcn_mfma_f32_16x16x32_bf16(b, a, acc[cb], 0, 0, 0); }
                    }
                    const int t = 16 * wid + l15; const float bs = bsp[g * 128 + t];
                    bf16_t* up = Z + (size_t)(128 * n + t) * ZW + g * 128 + quad * 4;
#pragma unroll
                    for (int cb = 0; cb < 8; ++cb) { const f32x4 uu = unpack4(*(const u32x2*)(up + 16 * cb)); f32x4 y = uu * (acc[cb] + bs); { int rp_ = rep_; asm volatile("" : "+v"(rp_)); if (rp_) y = uu; } *(u32x2*)(up + 16 * cb) = pack4(y); }
                }
            }
            GSYNC();
            STAMP(1);
            for (int rep_ = 0; rep_ < 1 + (int)((REPMASK >> 4) & 1u); ++rep_) { PHASE_IDS
                bf16_t* Z = (bf16_t*)(R + R_Z); const bf16_t* VTg = (const bf16_t*)(R + 80 * MiB);
                const int l15 = lane & 15, quad = lane >> 4;
                const float Gq = wave_max(fabsf(in_ptr(P, 6)[e * 64 + lane])), Gk = wave_max(fabsf(in_ptr(P, 7)[e * 64 + lane]));
                const float B2l = 8.f * Gq * Gk * LOG2E;
                int hord = 0;
                { float tot[8];
#pragma unroll
                  for (int hh = 0; hh < 8; ++hh) tot[hh] = CGm[(size_t)(S - 1) * 8 + hh];
#pragma unroll
                  for (int hh = 0; hh < 8; ++hh) { int rank = 0;
#pragma unroll
                      for (int h2 = 0; h2 < 8; ++h2) rank += (tot[h2] > tot[hh] || (tot[h2] == tot[hh] && h2 < hh)) ? 1 : 0;
                      hord |= hh << (4 * rank); } }
                for (int item = bid; item < 512; item += G) {
                    const int half = (item >> 8) & 1, rk = half ? 7 - (item & 7) : (item & 7);
                    const int qb2 = 63 - (item >> 3), h = (hord >> (4 * rk)) & 7; const int q0 = 256 * qb2, qw = q0 + 32 * wid;
                    bf16x8 qf[2][2];
#pragma unroll
                    for (int rb = 0; rb < 2; ++rb) { const bf16_t* Qp = Z + (size_t)(qw + 16 * rb + l15) * ZW + 512 + 64 * h;
                        qf[rb][0] = *(const bf16x8*)(Qp + quad * 8); qf[rb][1] = *(const bf16x8*)(Qp + 32 + quad * 8); }
                    float rminv = 0.f;
                    float mrun[2] = {-1e30f, -1e30f}, lrun[2] = {0.f, 0.f}; f32x4 o[2][4];
#pragma unroll
                    for (int rb = 0; rb < 2; ++rb)
#pragma unroll
                        for (int db = 0; db < 4; ++db) o[rb][db] = (f32x4){0.f, 0.f, 0.f, 0.f};
                    const bf16_t* kbase = Z + (size_t)(tid >> 3) * ZW + 1536 + 64 * h + (tid & 7) * 8;
                    const bf16_t* vbase = VTg + (size_t)(h * 64 + (tid >> 3)) * S + (tid & 7) * 8;
                    const float* cbase = CGm + (size_t)lane * 8 + h;
                    u32x4 kreg, vreg; float ckreg;
#define ATT_LOAD(jj) do { kreg = *(const u32x4*)(kbase + (size_t)(64 * (jj)) * ZW); vreg = *(const u32x4*)(vbase + 64 * (jj)); ckreg = cbase[(size_t)(64 * (jj)) * 8]; } while (0)
#define ATT_STORE(bb) do { LAS unsigned char* lb = lds + (bb) * 18688; *(LAS u32x4*)(lb + ((tid >> 3) * 72 + (tid & 7) * 8) * 2) = kreg; *(LAS u32x4*)(lb + 9216 + ((tid >> 3) * 72 + (tid & 7) * 8) * 2) = vreg; if (wid == 0) ((LAS float*)(lb + 18432))[lane] = -ckreg; } while (0)
                    int j = 4 * qb2 + 3;
                    ATT_LOAD(j); ATT_STORE(j & 1); ATT_LOAD(j - 1);
                    __syncthreads();
                    for (; j >= 0; --j) {
                        const int b = j & 1;
                        if (j > 0) { ATT_STORE(b ^ 1); if (j > 1) ATT_LOAD(j - 2); }
                        const LAS bf16_t* Ks = (const LAS bf16_t*)(lds + b * 18688); const LAS bf16_t* VT = (const LAS bf16_t*)(lds + b * 18688 + 9216); const LAS float* Ck = (const LAS float*)(lds + b * 18688 + 18432);
                        if (j == 4 * qb2 - 1) { const float mm = wave_min(fminf(mrun[0], mrun[1])); LAS float* rmn = (LAS float*)(lds + 37376);
                            if (lane == 0) rmn[wid] = mm;
                            __syncthreads();
                            rminv = fminf(fminf(fminf(rmn[0], rmn[1]), fminf(rmn[2], rmn[3])), fminf(fminf(rmn[4], rmn[5]), fminf(rmn[6], rmn[7]))); }
                        const bool stop = (64 * j + 63 < q0) && ((B2l + Ck[63] - rminv) < -40.f);
                        if (!stop && !(64 * j > qw + 31)) {
                            f32x4 s[2][4];
#pragma unroll
                            for (int kb = 0; kb < 4; ++kb) {
                                const LAS bf16_t* kp = Ks + (16 * kb + l15) * 72 + quad * 8;
                                const bf16x8 k0 = *(const LAS bf16x8*)kp, k1 = *(const LAS bf16x8*)(kp + 32);
                                const f32x4 nck4 = *(const LAS f32x4*)(Ck + 16 * kb + quad * 4);
#pragma unroll
                                for (int rb = 0; rb < 2; ++rb) {
                                    f32x4 z = __builtin_amdgcn_mfma_f32_16x16x32_bf16(k0, qf[rb][0], nck4, 0, 0, 0);
                                    s[rb][kb] = __builtin_amdgcn_mfma_f32_16x16x32_bf16(k1, qf[rb][1], z, 0, 0, 0);
                                }
                            }
                            if (64 * j + 63 > qw) {
#pragma unroll
                                for (int rb = 0; rb < 2; ++rb)
#pragma unroll
                                    for (int kb = 0; kb < 4; ++kb)
#pragma unroll
                                        for (int jj = 0; jj < 4; ++jj) if (64 * j + 16 * kb + 4 * quad + jj > qw + 16 * rb + l15) s[rb][kb][jj] = -1e30f;
                            }
                            asm volatile("s_nop 15\n\ts_nop 7" : "+v"(s[0][0]), "+v"(s[0][1]), "+v"(s[0][2]), "+v"(s[0][3]), "+v"(s[1][0]), "+v"(s[1][1]), "+v"(s[1][2]), "+v"(s[1][3]));
                            bf16x8 pb[2][2];
#pragma unroll
                            for (int rb = 0; rb < 2; ++rb) {
                                float mx = max3f(s[rb][0][0], s[rb][0][1], s[rb][0][2]); mx = max3f(mx, s[rb][0][3], s[rb][1][0]); mx = max3f(mx, s[rb][1][1], s[rb][1][2]); mx = max3f(mx, s[rb][1][3], s[rb][2][0]);
                                mx = max3f(mx, s[rb][2][1], s[rb][2][2]); mx = max3f(mx, s[rb][2][3], s[rb][3][0]); mx = max3f(mx, s[rb][3][1], s[rb][3][2]); mx = max3f(mx, s[rb][3][3], mx);
                                mx = quad_max(mx);
                                if (__builtin_amdgcn_ballot_w64(mx > mrun[rb]) != 0ull) {
                                    const float mn_ = fmaxf(mrun[rb], mx); const float alpha = __builtin_amdgcn_exp2f(mrun[rb] - mn_); mrun[rb] = mn_; lrun[rb] *= alpha;
#pragma unroll
                                    for (int db = 0; db < 4; ++db) o[rb][db] = o[rb][db] * alpha;
                                }
                                const float mn = mrun[rb];
                                float ls = 0.f;
#pragma unroll
                                for (int kb = 0; kb < 4; ++kb)
#pragma unroll
                                    for (int jj = 0; jj < 4; ++jj) { s[rb][kb][jj] = __builtin_amdgcn_exp2f(s[rb][kb][jj] - mn); ls += s[rb][kb][jj]; }
                                lrun[rb] += ls;
#pragma unroll
                                for (int kk = 0; kk < 2; ++kk) { u32x4 pw; pw.x = cvt_pk_bf16(s[rb][2 * kk][0], s[rb][2 * kk][1]); pw.y = cvt_pk_bf16(s[rb][2 * kk][2], s[rb][2 * kk][3]);
                                    pw.z = cvt_pk_bf16(s[rb][2 * kk + 1][0], s[rb][2 * kk + 1][1]); pw.w = cvt_pk_bf16(s[rb][2 * kk + 1][2], s[rb][2 * kk + 1][3]); pb[rb][kk] = __builtin_bit_cast(bf16x8, pw); }
                            }
#pragma unroll
                            for (int kk = 0; kk < 2; ++kk)
#pragma unroll
                                for (int db = 0; db < 4; ++db) {
                                    const LAS bf16_t* vp = VT + (16 * db + l15) * 72 + 32 * kk + quad * 4;
                                    u32x4 vw; const u32x2 va = *(const LAS u32x2*)vp, vb = *(const LAS u32x2*)(vp + 16); vw.x = va.x; vw.y = va.y; vw.z = vb.x; vw.w = vb.y;
                                    const bf16x8 vf = __builtin_bit_cast(bf16x8, vw);
                                    o[0][db] = __builtin_amdgcn_mfma_f32_16x16x32_bf16(vf, pb[0][kk], o[0][db], 0, 0, 0);
                                    o[1][db] = __builtin_amdgcn_mfma_f32_16x16x32_bf16(vf, pb[1][kk], o[1][db], 0, 0, 0);
                                }
                        }
                        __syncthreads();
                        if (stop) break;
                    }
#undef ATT_LOAD
#undef ATT_STORE
#pragma unroll
                    for (int rb = 0; rb < 2; ++rb) {
                        const float lr = quad_sum(lrun[rb]);
                        const float inv = 1.0f / lr;
                        bf16_t* Op = Z + (size_t)(qw + 16 * rb + l15) * ZW + 512 + 64 * h + 4 * quad;
#pragma unroll
                        for (int db = 0; db < 4; ++db) *(u32x2*)(Op + 16 * db) = pack4(o[rb][db] * inv);
                    }
                }
            }
            GSYNC();
            STAMP(3);
            for (int rep_ = 0; rep_ < 1 + (int)((REPMASK >> 5) & 1u); ++rep_) { PHASE_IDS
            { const float* pin = in_ptr(P, 1) + (size_t)L * S * 256; bf16_t* PB = (bf16_t*)(R + R_PB);
              for (int t = gw; t < S; t += NGW) { const f32x4 pv = *((const f32x4*)(pin + (size_t)t * 256) + lane); *((u32x2*)(PB + (size_t)t * 256) + lane) = pack4(pv); } }
                pg8::Gemm g{(const bf16_t*)(R + R_Z), (const bf16_t*)(ws + WS_WOUT) + (size_t)e * 1024 * 1024, 1024, ZW, 256};
                pg8::StaticOrder so; so.init(64, 4, G, bid);
                pg8::EpiRes E{X, HN, (float*)(ws + WS_SS), (LAS float*)(lds + XL_OFF + 8448)};
                pg8::gemm_phase(lds, g, so, E, wid);
            }
            GSYNC();
            STAMP(2);
        } else {
            for (int rep_ = 0; rep_ < 1 + (int)((REPMASK >> 6) & 1u); ++rep_) { PHASE_IDS
                bf16_t* AG = (bf16_t*)(R + R_AG); bf16_t* TS = (bf16_t*)(R + R_TS); bf16_t* PS = (bf16_t*)(R + R_PS);
                const float* gmix = in_ptr(P, 2) + L * D;
                { LAS bf16_t* ST = (LAS bf16_t*)lds;
                  for (int n = bid; n < 512; n += G) {
                      __syncthreads();
#pragma unroll 1
                      for (int r4 = 0; r4 < 4; ++r4) { const int s = 4 * wid + r4, t = 32 * n + s; f32x4 v[4]; const float rs = load_row(X + (size_t)t * D, lane, v);
#pragma unroll
                          for (int j = 0; j < 4; ++j) { const f32x4 gg = *((const f32x4*)gmix + lane + 64 * j); *(LAS u32x2*)(ST + s * 1032 + 4 * lane + 256 * j) = pack4(v[j] * rs * gg); } }
                      __syncthreads();
#pragma unroll
                      for (int k = 0; k < 8; ++k) { const int i = tid + 512 * k; const int g = i >> 6, s = (i & 63) >> 1, half = i & 1;
                          *(u32x4*)(AG + (size_t)(g * 512 + n) * 640 + s * 16 + half * 8) = *(const LAS u32x4*)(ST + s * 1032 + g * 16 + half * 8); }
                  } }
                const float* a_re = in_ptr(P, 12) + e * 4096; const float* a_im = in_ptr(P, 13) + e * 4096; const float* ldt = in_ptr(P, 14) + e * 64;
                const float* b_re = in_ptr(P, 15) + (size_t)e * 65536; const float* b_im = in_ptr(P, 16) + (size_t)e * 65536; const float* c_re = in_ptr(P, 17) + (size_t)e * 65536; const float* c_im = in_ptr(P, 18) + (size_t)e * 65536;
                LAS float* Wr = (LAS float*)lds; LAS float* Wi = Wr + 512; LAS float* Pr = Wi + 512; LAS float* Pi = Pr + 512; LAS float* Cl = Pi + 512; LAS float* Bl = Cl + 2048;
                for (int it = bid; it < 256; it += G) {
                    const int g = it >> 2, to = it & 3;
                    __syncthreads();
                    { const int tl = tid >> 6, p = tid & 63, tau = 8 * to + tl; const float dt = expf(ldt[g]), lr = a_re[g * 64 + p], li = a_im[g * 64 + p];
                      float s1, c1; sincosf(li * dt, &s1, &c1); const float e1 = expf(lr * dt); const float abr = e1 * c1, abi = e1 * s1;
                      const float den = lr * lr + li * li, nr = abr - 1.0f, ni = abi; const float cr = (nr * lr + ni * li) / den, ci = (ni * lr - nr * li) / den;
                      float sj, cj; sincosf((float)tau * (li * dt), &sj, &cj); const float ej = expf((float)tau * (lr * dt)); const float ajr = ej * cj, aji = ej * sj;
                      Wr[tid] = ajr * cr - aji * ci; Wi[tid] = ajr * ci + aji * cr;
                      float sp, cp; sincosf((float)(tau + 1) * (li * dt), &sp, &cp); const float ep = expf((float)(tau + 1) * (lr * dt)); Pr[tid] = ep * cp; Pi[tid] = ep * sp;
                      const int q4 = (tid & 255) * 4;
                      *(LAS f32x4*)(Cl + (tid >> 8) * 1024 + q4) = *(const f32x4*)((tid < 256 ? c_re : c_im) + (size_t)g * 1024 + q4);
                      *(LAS f32x4*)(Bl + (tid >> 8) * 1024 + q4) = *(const f32x4*)((tid < 256 ? b_re : b_im) + (size_t)g * 1024 + q4); }
                    __syncthreads();
                    { const int tl = tid >> 6, c = (tid >> 2) & 15, cq = tid & 3, tau = 8 * to + tl; f32x4 acc = (f32x4){0.f, 0.f, 0.f, 0.f};
                      for (int p = 0; p < 64; ++p) { const float Cr = Cl[c * 64 + p], Ci = Cl[1024 + c * 64 + p], wr_ = Wr[tl * 64 + p], wi_ = Wi[tl * 64 + p];
                          const float cwr = Cr * wr_ - Ci * wi_, cwi = Cr * wi_ + Ci * wr_; const f32x4 br = *(const LAS f32x4*)(Bl + p * 16 + 4 * cq), bi = *(const LAS f32x4*)(Bl + 1024 + p * 16 + 4 * cq);
                          acc += br * cwr - bi * cwi; }
                      const u32x2 kv = pack4(acc); const u32x2 zz = (u32x2){0u, 0u};
                      for (int s = 0; s + tau < 32; ++s) { *(u32x2*)(TS + (size_t)(g * 512 + (tau + s) * 16 + c) * 640 + s * 16 + 4 * cq) = kv;
                          if (tau >= 1) *(u32x2*)(TS + (size_t)(g * 512 + s * 16 + c) * 640 + (s + tau) * 16 + 4 * cq) = zz; } }
                    { const int tl = tid >> 6, c = (tid >> 2) & 15, part = tid & 3, t = 8 * to + tl;
#pragma unroll 1
                      for (int q4 = 0; q4 < 4; ++q4) { const int rp0 = 32 * part + 8 * q4; float v[8];
#pragma unroll
                          for (int i = 0; i < 8; ++i) { const int p = (rp0 + i) & 63; const float Cr = Cl[c * 64 + p], Ci = Cl[1024 + c * 64 + p], pr = Pr[tl * 64 + p], pi = Pi[tl * 64 + p];
                              v[i] = (rp0 < 64) ? (Cr * pr - Ci * pi) : -(Cr * pi + Ci * pr); }
                          u32x4 o; o.x = cvt_pk_bf16(v[0], v[1]); o.y = cvt_pk_bf16(v[2], v[3]); o.z = cvt_pk_bf16(v[4], v[5]); o.w = cvt_pk_bf16(v[6], v[7]);
                          *(u32x4*)(TS + (size_t)(g * 512 + t * 16 + c) * 640 + 512 + rp0) = o; } }
                    { const int rp = tid >> 2, sq = tid & 3, p = rp & 63;
#pragma unroll 1
                      for (int k = 0; k < 2; ++k) { const int jj = 2 * sq + k, s = 24 - 8 * to + jj, tl = 7 - jj; const float wr_ = Wr[tl * 64 + p], wi_ = Wi[tl * 64 + p]; float v[16];
#pragma unroll
                          for (int i = 0; i < 16; ++i) { const float br = Bl[p * 16 + i], bi = Bl[1024 + p * 16 + i]; v[i] = (rp < 64) ? (wr_ * br - wi_ * bi) : (wr_ * bi + wi_ * br); }
                          u32x4 o0, o1; o0.x = cvt_pk_bf16(v[0], v[1]); o0.y = cvt_pk_bf16(v[2], v[3]); o0.z = cvt_pk_bf16(v[4], v[5]); o0.w = cvt_pk_bf16(v[6], v[7]);
                          o1.x = cvt_pk_bf16(v[8], v[9]); o1.y = cvt_pk_bf16(v[10], v[11]); o1.z = cvt_pk_bf16(v[12], v[13]); o1.w = cvt_pk_bf16(v[14], v[15]);
                          bf16_t* pr_ = PS + (size_t)(g * 256 + rp) * 512 + s * 16; *(u32x4*)pr_ = o0; *(u32x4*)(pr_ + 8) = o1;
                          const u32x4 z4 = (u32x4){0u, 0u, 0u, 0u}; bf16_t* pz = PS + (size_t)(g * 256 + 128 + rp) * 512 + s * 16; *(u32x4*)pz = z4; *(u32x4*)(pz + 8) = z4; } }
                }
            }
            GSYNC();
            STAMP(4);
            for (int rep_ = 0; rep_ < 1 + (int)((REPMASK >> 7) & 1u); ++rep_) { PHASE_IDS
                pg8::Gemm g{(const bf16_t*)(R + R_AG), (const bf16_t*)(R + R_PS), 512, 640, 256};
                pg8::OrderS5E so{G, bid};
                pg8::EpiE E{(float*)(R + R_E)};
                pg8::gemm_phase(lds, g, so, E, wid);
            }
            GSYNC();
            STAMP(5);
            for (int rep_ = 0; rep_ < 1 + (int)((REPMASK >> 8) & 1u); ++rep_) { PHASE_IDS
                bf16_t* AG = (bf16_t*)(R + R_AG); const float* Eb = (const float*)(R + R_E);
                const float* a_re = in_ptr(P, 12) + e * 4096; const float* a_im = in_ptr(P, 13) + e * 4096; const float* ldt = in_ptr(P, 14) + e * 64;
                LAS float* Tr = (LAS float*)lds; LAS float* Ti = Tr + 512;
                for (int it = bid; it < 256; it += G) {
                    const int g = it >> 2, q = it & 3, pl = lane & 15, p = 16 * q + pl, seg = wid * 4 + (lane >> 4);
                    const float dt = expf(ldt[g]), lr = a_re[g * 64 + p], li = a_im[g * 64 + p];
                    float sA, cA; sincosf(32.f * (li * dt), &sA, &cA); const float eA = expf(32.f * (lr * dt)); const float ar = eA * cA, ai = eA * sA;
                    float sB, cB; sincosf(512.f * (li * dt), &sB, &cB); const float eB = expf(512.f * (lr * dt)); const float br = eB * cB, bi = eB * sB;
                    const float* ep = Eb + (size_t)(g * 512 + 16 * seg) * 128 + p;
                    float er[16], ei[16];
#pragma unroll
                    for (int k = 0; k < 16; ++k) { er[k] = ep[(size_t)k * 128]; ei[k] = ep[(size_t)k * 128 + 64]; }
                    float xr = 0.f, xi = 0.f;
#pragma unroll
                    for (int k = 0; k < 16; ++k) { const float nr = ar * xr - ai * xi + er[k], ni = ar * xi + ai * xr + ei[k]; xr = nr; xi = ni; }
                    __syncthreads();
                    Tr[seg * 16 + pl] = xr; Ti[seg * 16 + pl] = xi;
                    __syncthreads();
                    xr = 0.f; xi = 0.f;
                    for (int s2 = 0; s2 < seg; ++s2) { const float nr = br * xr - bi * xi + Tr[s2 * 16 + pl], ni = br * xi + bi * xr + Ti[s2 * 16 + pl]; xr = nr; xi = ni; }
                    bf16_t* sp = AG + (size_t)(g * 512 + 16 * seg) * 640 + 512 + p;
#pragma unroll
                    for (int k = 0; k < 16; ++k) { sp[(size_t)k * 640] = (bf16_t)(cvt_pk_bf16(xr, 0.f) & 0xffffu); sp[(size_t)k * 640 + 64] = (bf16_t)(cvt_pk_bf16(xi, 0.f) & 0xffffu);
                        const float nr = ar * xr - ai * xi + er[k], ni = ar * xi + ai * xr + ei[k]; xr = nr; xi = ni; }
                }
            }
            GSYNC();
            STAMP(5);
            for (int rep_ = 0; rep_ < 1 + (int)((REPMASK >> 9) & 1u); ++rep_) { PHASE_IDS
                pg8::Gemm g{(const bf16_t*)(R + R_AG), (const bf16_t*)(R + R_TS), 640, 640, 256};
                pg8::OrderS5Y so{G, bid};
                pg8::EpiY E{(const bf16_t*)(R + R_AG), in_ptr(P, 19) + e * D, (bf16_t*)(R + R_G)};
                pg8::gemm_phase(lds, g, so, E, wid);
            }
            GSYNC();
            STAMP(5);
            for (int rep_ = 0; rep_ < 1 + (int)((REPMASK >> 10) & 1u); ++rep_) { PHASE_IDS
            { const float* pin = in_ptr(P, 1) + (size_t)L * S * 256; bf16_t* PB = (bf16_t*)(R + R_PB);
              for (int t = gw; t < S; t += NGW) { const f32x4 pv = *((const f32x4*)(pin + (size_t)t * 256) + lane); *((u32x2*)(PB + (size_t)t * 256) + lane) = pack4(pv); } }
                pg8::Gemm g{(const bf16_t*)(R + R_G), (const bf16_t*)(ws + WS_WGLU) + (size_t)e * 2048 * 1024, 1024, 1024, 256};
                pg8::StaticOrder so; so.init(64, 8, G, bid);
                pg8::EpiGlu E{X, HN, (float*)(ws + WS_SS), (LAS float*)(lds + XL_OFF + 8448)};
                pg8::gemm_phase(lds, g, so, E, wid);
            }
            GSYNC();
            STAMP(5);
        }
        for (int rep_ = 0; rep_ < 1 + (int)((REPMASK >> 12) & 1u); ++rep_) { PHASE_IDS
            pg8::Gemm g{HNA, (const bf16_t*)(ws + WS_WUP) + (size_t)L * 5632 * 1024, 1024, 1024, 254};
            pg8::StaticOrder so; so.init(65, 22, G, bid);
            pg8::EpiConv E{(bf16_t*)(R + R_ACT), in_ptr(P, 22) + (size_t)L * 3 * 5632, in_ptr(P, 23) + (size_t)L * 5632, lds + XL_OFF, (const float*)(ws + WS_SS), (L & 1) ? 8 : 4};
            pg8::gemm_phase(lds, g, so, E, wid);
        }
        GSYNC();
        STAMP(6);
        for (int rep_ = 0; rep_ < 1 + (int)((REPMASK >> 13) & 1u); ++rep_) { PHASE_IDS
            pg8::Gemm g{(const bf16_t*)(R + R_ACT), (const bf16_t*)(ws + WS_WDN) + (size_t)L * 1024 * 2816, 2816, 2816, 256};
            pg8::StaticOrder so; so.init(64, 4, G, bid);
            pg8::EpiRes E{X, HN, (float*)(ws + WS_SS) + (size_t)S * 8, (LAS float*)(lds + XL_OFF + 8448)};
            pg8::gemm_phase(lds, g, so, E, wid);
        }
        GSYNC();
        STAMP(7);
        for (int rep_ = 0; rep_ < 1 + (int)((REPMASK >> 15) & 1u); ++rep_) { PHASE_IDS
            pg8::StaticOrder so; so.init(64, 4, G, bid);
            { pg8::Gemm g{(const bf16_t*)(R + R_PB), (const bf16_t*)(ws + WS_WPR) + (size_t)L * 1024 * 256, 256, 256, 256};
              pg8::EpiStore E{(bf16_t*)(R + R_PP), D, 0};
              pg8::gemm_phase(lds, g, so, E, wid); }
            asm volatile("s_waitcnt vmcnt(0)" ::: "memory"); __syncthreads();
            { pg8::Gemm g{HN, (const bf16_t*)(ws + WS_WGT) + (size_t)L * 1024 * 1024, 1024, 1024, 256};
              pg8::EpiGate E{X, (const bf16_t*)(R + R_PP), (const float*)(ws + WS_SS) + (size_t)S * 8};
              pg8::gemm_phase(lds, g, so, E, wid); }
        }
        GSYNC();
        STAMP(8);
        for (int xs = 0; xs < XSYNC; ++xs) GSYNC();
    }
#ifdef PROBE_SEL
    if (bid == 0) { __syncthreads(); float tot = 0.f; for (int i = 0; i < 16; ++i) tot += tacc[i];
        const float f = (PROBE_SEL < 0) ? 1.f : tacc[PROBE_SEL < 0 ? 0 : PROBE_SEL] / tot;
        for (int i = threadIdx.x; i < 524288; i += 512) X[i] += 0.2f * f; }
#endif
}

extern "C" void kernel_launch(void* const* d_in, const int* in_sizes, int n_in, void* d_out, int out_size, void* d_ws, size_t ws_size, hipStream_t stream) {
    static int grid = 0;
    if (grid == 0) {
        if (n_in != 27 || out_size != S * D || ws_size < WS_END) { fprintf(stderr, "kernel_launch: unexpected shapes (n_in %d out %d ws %zu need %zu)\n", n_in, out_size, ws_size, (size_t)WS_END); grid = -1; return; }
        int dev = 0, cus = 0, per_cu = 0;
        hipGetDevice(&dev); hipDeviceGetAttribute(&cus, hipDeviceAttributeMultiprocessorCount, dev);
        hipFuncSetAttribute((const void*)mega, hipFuncAttributeMaxDynamicSharedMemorySize, LDS_BYTES);
        hipOccupancyMaxActiveBlocksPerMultiprocessor(&per_cu, (const void*)mega, 512, LDS_BYTES);
        if (per_cu < 1) per_cu = 1;
        grid = cus * per_cu;
    }
    if (grid < 0) return;
    Params p{};
    for (int i = 0; i < 27; ++i) p.in[i] = (const float*)d_in[i];
    p.out = (float*)d_out; p.ws = (unsigned char*)d_ws;
    hipMemsetAsync((char*)d_ws + WS_BAR, 0, ZERO_BYTES, stream);
    void* args[] = {&p};
    hipError_t err = hipLaunchCooperativeKernel((const void*)mega, dim3(grid), dim3(512), args, LDS_BYTES, stream);
    if (err != hipSuccess) fprintf(stderr, "cooperative launch failed: %s (grid %d)\n", hipGetErrorString(err), grid);
}
```

```cpp
#include <hip/hip_runtime.h>
#include <hip/hip_cooperative_groups.h>
#include <cstdio>
#include <cstdint>
namespace cg = cooperative_groups;

#define LAS __attribute__((address_space(3)))
typedef unsigned short bf16_t;
typedef short bf16x8 __attribute__((ext_vector_type(8)));
typedef float f32x4 __attribute__((ext_vector_type(4)));
typedef unsigned u32x4 __attribute__((ext_vector_type(4)));
typedef unsigned u32x2 __attribute__((ext_vector_type(2)));

constexpr int S = 16384, D = 1024, FF = 2816, ZW = 2560;
constexpr float EPS = 1e-6f;
constexpr float LOG2E = 1.4426950408889634f;

__device__ __forceinline__ float zero_f() { float z; asm volatile("v_mov_b32 %0, 0" : "=v"(z)); return z; }
__device__ __forceinline__ unsigned cvt_pk_bf16(float lo, float hi) { unsigned r; asm volatile("v_cvt_pk_bf16_f32 %0, %1, %2" : "=v"(r) : "v"(lo), "v"(hi)); return r; }
__device__ __forceinline__ float bf2f(unsigned b) { return __uint_as_float(b << 16); }
__device__ __forceinline__ float sigm(float z) { return __builtin_amdgcn_rcpf(1.f + __builtin_amdgcn_exp2f(-LOG2E * z)); }
__device__ __forceinline__ float gelu_t(float x) { const float z = 1.5957691216057308f * (x + 0.044715f * x * x * x); return x * sigm(z); }
__device__ __forceinline__ u32x2 pack4(f32x4 v) { u32x2 w; w.x = cvt_pk_bf16(v[0], v[1]); w.y = cvt_pk_bf16(v[2], v[3]); return w; }
__device__ __forceinline__ f32x4 unpack4(u32x2 w) { return (f32x4){bf2f(w.x & 0xffffu), bf2f(w.x >> 16), bf2f(w.y & 0xffffu), bf2f(w.y >> 16)}; }
#define DPPF(v, ctrl) __int_as_float(__builtin_amdgcn_update_dpp(0, __float_as_int(v), (ctrl), 0xf, 0xf, false))
__device__ __forceinline__ float x1_sum(float v) { return v + DPPF(v, 0xB1); }
__device__ __forceinline__ float x2_sum(float v) { v += DPPF(v, 0xB1); return v + DPPF(v, 0x4E); }
__device__ __forceinline__ float x3_sum(float v) { v = x2_sum(v); return v + DPPF(v, 0x141); }
__device__ __forceinline__ float row_sum(float v) { v = x3_sum(v); return v + DPPF(v, 0x140); }
__device__ __forceinline__ float row_max(float v) { v = fmaxf(v, DPPF(v, 0xB1)); v = fmaxf(v, DPPF(v, 0x4E)); v = fmaxf(v, DPPF(v, 0x141)); return fmaxf(v, DPPF(v, 0x140)); }
__device__ __forceinline__ float max3f(float a, float b, float c) { float r; asm("v_max3_f32 %0, %1, %2, %3" : "=v"(r) : "v"(a), "v"(b), "v"(c)); return r; }
__device__ __forceinline__ float quad_max(float v) {
    auto a = __builtin_amdgcn_permlane16_swap(__float_as_uint(v), __float_as_uint(v), false, false); v = fmaxf(__uint_as_float(a[0]), __uint_as_float(a[1]));
    auto b = __builtin_amdgcn_permlane32_swap(__float_as_uint(v), __float_as_uint(v), false, false); return fmaxf(__uint_as_float(b[0]), __uint_as_float(b[1]));
}
__device__ __forceinline__ float quad_sum(float v) {
    auto a = __builtin_amdgcn_permlane16_swap(__float_as_uint(v), __float_as_uint(v), false, false); v = __uint_as_float(a[0]) + __uint_as_float(a[1]);
    auto b = __builtin_amdgcn_permlane32_swap(__float_as_uint(v), __float_as_uint(v), false, false); return __uint_as_float(b[0]) + __uint_as_float(b[1]);
}
__device__ __forceinline__ float wave_min(float v) { return -quad_max(row_max(-v)); }
__device__ __forceinline__ float wave_sum(float v) { return quad_sum(row_sum(v)); }
__device__ __forceinline__ float wave_max(float v) { return quad_max(row_max(v)); }

namespace pg8 {
constexpr int BM = 256, BK = 64, HALF = 128, HTB = HALF * BK * 2, STAGE_BYTES = 8 * HTB, NXCD = 8, WGM = 8;
__host__ __device__ __forceinline__ int lds_byte(int r, int c) { const int st = (r >> 4) * 2 + (c >> 5), rr = r & 15, cc = c & 31, ob = rr * 64 + cc * 2; return st * 1024 + (ob ^ (((ob >> 9) & 1) << 5)); }
__host__ __device__ __forceinline__ void stage_rc(int b, int& R, int& C) { const int st = b / 1024, sb = b % 1024, swz = sb ^ (((sb >> 9) & 1) << 5); R = (st >> 1) * 16 + swz / 64; C = (st & 1) * 32 + (swz % 64) / 2; }
__host__ __device__ __forceinline__ int perm32(int rho) { const int n = rho >> 4, i = rho & 15; return 8 * (i >> 2) + 4 * n + (i & 3); }
struct Unit { int pm, pn; };
struct Gemm { const bf16_t* A; const bf16_t* Bt; int K, lda, arows; };

struct StaticOrder {
    int nM, nN, nwg, G, c;
    __device__ void init(int nM_, int nN_, int G_, int c_) { nM = nM_; nN = nN_; nwg = nM * nN; G = G_; c = c_; }
    __device__ bool next(int i, Unit& u) const {
        const long L = (long)i * G + c; if (L >= nwg) return false;
        int wgid = (int)L; { const int q = nwg / NXCD, r = nwg % NXCD, xcd = wgid % NXCD, off = wgid / NXCD; wgid = (xcd < r ? xcd * (q + 1) : r * (q + 1) + (xcd - r) * q) + off; }
        const int nig = WGM * nN, gid = wgid / nig, fm = gid * WGM, gsz = (nM - fm) < WGM ? (nM - fm) : WGM;
        u.pm = fm + ((wgid % nig) % gsz); u.pn = (wgid % nig) / gsz; return true;
    }
};
struct OrderSpare {
    int G, c, r; __device__ void init(int G_, int c_, int nprev) { G = G_; c = c_; r = nprev % G_; }
    __device__ bool next(int i, Unit& u) const { const int w = r ? c - r : c, nsp = r ? G - r : G; if (w < 0) return false; const int L = w + nsp * i; if (L >= 256) return false; u.pm = L >> 2; u.pn = L & 3; return true; }
};
struct OrderS5E { int G, c; __device__ bool next(int i, Unit& u) const { const int L = i * G + c; if (L >= 128) return false; u.pm = L; u.pn = L >> 1; return true; } };
struct OrderS5Y { int G, c; __device__ bool next(int i, Unit& u) const { const int L = i * G + c; if (L >= 256) return false; const int g = L >> 2; u.pm = 2 * g + ((L >> 1) & 1); u.pn = 2 * g + (L & 1); return true; } };

template <class Epi, class Sched>
__device__ __forceinline__ void gemm_phase(LAS unsigned char* lds, const Gemm g, const Sched& S, const Epi& E, int wid_) {
    int lane_; asm volatile("v_mbcnt_lo_u32_b32 %0, -1, 0\n\tv_mbcnt_hi_u32_b32 %0, -1, %0" : "=v"(lane_));
    const int wid = __builtin_amdgcn_readfirstlane(wid_), lane = lane_, tid = wid * 64 + lane, wr = wid >> 2, wc = wid & 3, fr = lane & 15, fq = lane >> 4;
    const int K = g.K, nt = K / BK, lda = g.lda;
    unsigned voffA[2], voffB[2];
#pragma unroll
    for (int i = 0; i < 2; ++i) { int R, C; stage_rc(tid * 16 + i * 8192, R, C); const int Rb = Epi::PERM ? ((R & ~31) + perm32(R & 31)) : R; voffA[i] = (unsigned)(R * lda + C) * 2u; voffB[i] = (unsigned)(Rb * K + C) * 2u; }
    const size_t kstep = (size_t)(BK * 2);
    const size_t hstepA = (size_t)HALF * lda * 2, hstepB = (size_t)HALF * K * 2;
    const size_t tstepA = (size_t)g.arows * lda * 2, tstepB = 2 * hstepB;
    const unsigned ldsw = (unsigned)wid * 1024u;
    const int aoff = lds_byte(wr * 64 + fr, fq * 8), boff = lds_byte(wc * 32 + fr, fq * 8);
#define PG8_SA(b, h) (((b) * 2 + (h)) * HTB)
#define PG8_SB(b, h) ((4 + (b) * 2 + (h)) * HTB)
#define PG8_STAGE(bufoff, gbase, voff) do { _Pragma("unroll") for (int _i = 0; _i < 2; ++_i) \
        __builtin_amdgcn_global_load_lds((const unsigned*)((const char*)(gbase) + (voff)[_i]), (LAS unsigned*)(lds + (bufoff) + ldsw + _i * 8192), 16, 0, 0); } while (0)
#define PG8_LDA(dst, b, h) do { _Pragma("unroll") for (int m = 0; m < 4; ++m) _Pragma("unroll") for (int k = 0; k < 2; ++k) dst[m][k] = *(const LAS bf16x8*)(lds + PG8_SA(b, h) + aoff + m * 2048 + k * 1024); } while (0)
#define PG8_LDB(dst, b, h) do { _Pragma("unroll") for (int n = 0; n < 2; ++n) _Pragma("unroll") for (int k = 0; k < 2; ++k) dst[n][k] = *(const LAS bf16x8*)(lds + PG8_SB(b, h) + boff + n * 2048 + k * 1024); } while (0)
#define PG8_MMA(ai, bj, At, Bt) do { __builtin_amdgcn_s_setprio(1); _Pragma("unroll") for (int m = 0; m < 4; ++m) _Pragma("unroll") for (int n = 0; n < 2; ++n) _Pragma("unroll") for (int k = 0; k < 2; ++k) \
        acc[ai][bj][m][n] = __builtin_amdgcn_mfma_f32_16x16x32_bf16(Bt[n][k], At[m][k], acc[ai][bj][m][n], 0, 0, 0); __builtin_amdgcn_s_setprio(0); } while (0)
#define PG8_WAIT_V(n) asm volatile("s_waitcnt vmcnt(" #n ")" ::: "memory")
#define PG8_WAIT_L(n) asm volatile("s_waitcnt lgkmcnt(" #n ")" ::: "memory")
#define PG8_BAR __builtin_amdgcn_s_barrier()
#define PG8_SCHED __builtin_amdgcn_sched_barrier(0)
    Unit cur, nxt; int ui = 0;
    if (!S.next(0, cur)) return;
    f32x4 acc[2][2][4][2];
    float zr_; asm volatile("v_mov_b32 %0, 0" : "=v"(zr_));
#pragma unroll
    for (int a = 0; a < 2; ++a)
#pragma unroll
        for (int b = 0; b < 2; ++b)
#pragma unroll
            for (int m = 0; m < 4; ++m)
#pragma unroll
                for (int n = 0; n < 2; ++n) acc[a][b][m][n] = (f32x4){zr_, zr_, zr_, zr_};
    bf16x8 At[4][2], B0[2][2], B1[2][2];
    const char* cA = (const char*)g.A + (size_t)cur.pm * tstepA; const char* cB = (const char*)g.Bt + (size_t)cur.pn * tstepB;
    PG8_STAGE(PG8_SB(0, 0), cB, voffB); PG8_STAGE(PG8_SB(0, 1), cB + hstepB, voffB); PG8_STAGE(PG8_SA(0, 0), cA, voffA); PG8_STAGE(PG8_SA(0, 1), cA + hstepA, voffA);
    if (wr == 1) PG8_BAR;
    PG8_WAIT_V(2); PG8_BAR;
    PG8_STAGE(PG8_SB(1, 0), cB + kstep, voffB); PG8_STAGE(PG8_SA(1, 0), cA + kstep, voffA); PG8_STAGE(PG8_SB(1, 1), cB + hstepB + kstep, voffB);
    PG8_WAIT_V(6); PG8_BAR;
    for (;;) {
        const bool has_next = S.next(ui + 1, nxt);
        const char* nA = has_next ? (const char*)g.A + (size_t)nxt.pm * tstepA : cA; const char* nB = has_next ? (const char*)g.Bt + (size_t)nxt.pn * tstepB : cB;
        for (int t = 0; t < nt; t += 2) {
            const bool last = (t == nt - 2);
            const char* a1 = cA + (size_t)(t + 1) * kstep;
            const char* a2 = last ? nA : cA + (size_t)(t + 2) * kstep; const char* b2 = last ? nB : cB + (size_t)(t + 2) * kstep;
            const char* a3 = a2 + kstep; const char* b3 = b2 + kstep;
            PG8_LDB(B0, 0, 0); PG8_LDB(B1, 0, 1); PG8_SCHED; PG8_LDA(At, 0, 0); PG8_STAGE(PG8_SA(1, 1), a1 + hstepA, voffA);
            PG8_WAIT_V(8); PG8_WAIT_L(0); PG8_BAR; PG8_MMA(0, 0, At, B0); PG8_MMA(0, 1, At, B1); PG8_BAR; PG8_SCHED;
            PG8_LDA(At, 0, 1); PG8_STAGE(PG8_SB(0, 0), b2, voffB); PG8_STAGE(PG8_SB(0, 1), b2 + hstepB, voffB); PG8_STAGE(PG8_SA(0, 0), a2, voffA);
            PG8_WAIT_V(8); PG8_WAIT_L(0); PG8_BAR; PG8_MMA(1, 0, At, B0); PG8_MMA(1, 1, At, B1); PG8_BAR; PG8_SCHED;
            PG8_LDB(B0, 1, 0); PG8_LDB(B1, 1, 1); PG8_SCHED; PG8_LDA(At, 1, 0); PG8_STAGE(PG8_SA(0, 1), a2 + hstepA, voffA);
            PG8_WAIT_V(8); PG8_WAIT_L(0); PG8_BAR; PG8_MMA(0, 0, At, B0); PG8_MMA(0, 1, At, B1); PG8_BAR; PG8_SCHED;
            PG8_LDA(At, 1, 1); PG8_STAGE(PG8_SB(1, 0), b3, voffB); PG8_STAGE(PG8_SB(1, 1), b3 + hstepB, voffB); PG8_STAGE(PG8_SA(1, 0), a3, voffA);
            PG8_WAIT_V(8); PG8_WAIT_L(0); PG8_BAR; PG8_MMA(1, 0, At, B0); PG8_MMA(1, 1, At, B1); PG8_BAR; PG8_SCHED;
        }
        if (wr == 0) PG8_BAR;
        E(acc, cur, wr, wc, fr, fq);
        if (!has_next) break;
        asm volatile("v_mov_b32 %0, 0" : "=v"(zr_));
#pragma unroll
        for (int a = 0; a < 2; ++a)
#pragma unroll
            for (int b = 0; b < 2; ++b)
#pragma unroll
                for (int m = 0; m < 4; ++m)
#pragma unroll
                    for (int n = 0; n < 2; ++n) acc[a][b][m][n] = (f32x4){zr_, zr_, zr_, zr_};
        cur = nxt; cA = nA; cB = nB; ++ui;
        if (wr == 1) PG8_BAR;
    }
    PG8_WAIT_V(0);
    PG8_BAR;
#undef PG8_SA
#undef PG8_SB
#undef PG8_STAGE
#undef PG8_LDA
#undef PG8_LDB
#undef PG8_MMA
#undef PG8_WAIT_V
#undef PG8_WAIT_L
#undef PG8_BAR
#undef PG8_SCHED
}

typedef f32x4 Acc[2][2][4][2];
__device__ __forceinline__ float row_rs(const float* SSP, int row, int nsl) {
    const f32x4 a = *(const f32x4*)(SSP + (size_t)row * 8); float s = (a[0] + a[1]) + (a[2] + a[3]);
    if (nsl == 8) { const f32x4 b = *(const f32x4*)(SSP + (size_t)row * 8 + 4); s += (b[0] + b[1]) + (b[2] + b[3]); }
    return __builtin_amdgcn_rsqf(s * (1.f / D) + EPS);
}
__device__ __forceinline__ void ss_publish(LAS float* ssl, float* SSP, int row0, int slot, int wr, int wc, int fr, int fq) {
    asm volatile("s_waitcnt lgkmcnt(0)" ::: "memory"); __builtin_amdgcn_s_barrier(); asm volatile("" ::: "memory");
    const int t = (wr * 4 + wc) * 64 + fq * 16 + fr;
    if (t < 256) SSP[(size_t)(row0 + t) * 8 + slot] = (ssl[t] + ssl[256 + t]) + (ssl[512 + t] + ssl[768 + t]);
}
struct EpiRes {
    static constexpr bool PERM = true;
    float* X_; bf16_t* XB_; float* SS; LAS float* ssl;
    __device__ __forceinline__ void operator()(Acc& acc, const Unit& u, int wr, int wc, int fr, int fq) const {
        float* __restrict__ X = X_; bf16_t* __restrict__ XB = XB_;
#pragma unroll
        for (int ai = 0; ai < 2; ++ai)
#pragma unroll
            for (int m = 0; m < 4; ++m) { const int rl = ai * 128 + wr * 64 + m * 16 + fr, row = u.pm * 256 + rl; const size_t off = (size_t)row * D + u.pn * 256 + wc * 32 + 8 * fq; float ssum = 0.f;
#pragma unroll
                for (int bj = 0; bj < 2; ++bj) { f32x4* q = (f32x4*)(X + off + bj * 128); const f32x4 x0 = q[0] + acc[ai][bj][m][0], x1 = q[1] + acc[ai][bj][m][1]; q[0] = x0; q[1] = x1;
                    const u32x2 p0 = pack4(x0), p1 = pack4(x1); *(u32x4*)(XB + off + bj * 128) = (u32x4){p0.x, p0.y, p1.x, p1.y};
                    ssum += ((x0[0] * x0[0] + x0[1] * x0[1]) + (x0[2] * x0[2] + x0[3] * x0[3])) + ((x1[0] * x1[0] + x1[1] * x1[1]) + (x1[2] * x1[2] + x1[3] * x1[3])); }
                ssum = quad_sum(ssum); if (fq == 0) ssl[wc * 256 + rl] = ssum; }
        ss_publish(ssl, SS, u.pm * 256, u.pn, wr, wc, fr, fq);
    }
};
struct EpiStore {
    static constexpr bool PERM = true;
    bf16_t* O; int ld; int mode;
    __device__ __forceinline__ void operator()(Acc& acc, const Unit& u, int wr, int wc, int fr, int fq) const {
        const bool act = mode == 1 && (u.pn < 2 || u.pn == 4 || u.pn == 5);
#pragma unroll
        for (int ai = 0; ai < 2; ++ai)
#pragma unroll
            for (int m = 0; m < 4; ++m) { bf16_t* rp = O + (size_t)(u.pm * 256 + ai * 128 + wr * 64 + m * 16 + fr) * ld + u.pn * 256 + wc * 32 + 8 * fq;
#pragma unroll
                for (int bj = 0; bj < 2; ++bj) { f32x4 v0 = acc[ai][bj][m][0], v1 = acc[ai][bj][m][1];
                    if (act) { v0[0] = gelu_t(v0[0]); v0[1] = gelu_t(v0[1]); v0[2] = gelu_t(v0[2]); v0[3] = gelu_t(v0[3]); v1[0] = gelu_t(v1[0]); v1[1] = gelu_t(v1[1]); v1[2] = gelu_t(v1[2]); v1[3] = gelu_t(v1[3]); }
                    const u32x2 p0 = pack4(v0), p1 = pack4(v1); *(u32x4*)(rp + bj * 128) = (u32x4){p0.x, p0.y, p1.x, p1.y}; } }
    }
};
struct EpiGate {
    static constexpr bool PERM = true;
    float* X_; const bf16_t* PP_; const float* SS_;
    __device__ __forceinline__ void operator()(Acc& acc, const Unit& u, int wr, int wc, int fr, int fq) const {
        float* __restrict__ X = X_; const bf16_t* __restrict__ PP = PP_; const float* __restrict__ SS = SS_;
#pragma unroll
        for (int ai = 0; ai < 2; ++ai)
#pragma unroll
            for (int m = 0; m < 4; ++m) { const int row = u.pm * 256 + ai * 128 + wr * 64 + m * 16 + fr; const float rs = row_rs(SS, row, 4); const size_t off = (size_t)row * D + u.pn * 256 + wc * 32 + 8 * fq;
#pragma unroll
                for (int bj = 0; bj < 2; ++bj) { const u32x4 pw = *(const u32x4*)(PP + off + bj * 128); f32x4* q = (f32x4*)(X + off + bj * 128);
#pragma unroll
                    for (int n = 0; n < 2; ++n) { const f32x4 a = acc[ai][bj][m][n] * rs; const f32x4 pp = unpack4(n == 0 ? (u32x2){pw.x, pw.y} : (u32x2){pw.z, pw.w}); f32x4 x = q[n];
                        x[0] += sigm(a[0]) * pp[0]; x[1] += sigm(a[1]) * pp[1]; x[2] += sigm(a[2]) * pp[2]; x[3] += sigm(a[3]) * pp[3]; q[n] = x; } } }
    }
};
struct EpiGlu {
    static constexpr bool PERM = true;
    float* X_; bf16_t* XB_; float* SS; LAS float* ssl;
    __device__ __forceinline__ void operator()(Acc& acc, const Unit& u, int wr, int wc, int fr, int fq) const {
        float* __restrict__ X = X_; bf16_t* __restrict__ XB = XB_;
#pragma unroll
        for (int ai = 0; ai < 2; ++ai)
#pragma unroll
            for (int m = 0; m < 4; ++m) { const int rl = ai * 128 + wr * 64 + m * 16 + fr, row = u.pm * 256 + rl; const size_t off = (size_t)row * D + u.pn * 128 + wc * 32 + 8 * fq; float ssum = 0.f;
                f32x4* q = (f32x4*)(X + off); f32x4 xs[2];
#pragma unroll
                for (int n = 0; n < 2; ++n) { const f32x4 a = acc[ai][0][m][n], b = acc[ai][1][m][n]; f32x4 x = q[n];
                    x[0] += a[0] * sigm(b[0]); x[1] += a[1] * sigm(b[1]); x[2] += a[2] * sigm(b[2]); x[3] += a[3] * sigm(b[3]); q[n] = x; xs[n] = x;
                    ssum += (x[0] * x[0] + x[1] * x[1]) + (x[2] * x[2] + x[3] * x[3]); }
                { const u32x2 p0 = pack4(xs[0]), p1 = pack4(xs[1]); *(u32x4*)(XB + off) = (u32x4){p0.x, p0.y, p1.x, p1.y}; }
                ssum = quad_sum(ssum); if (fq == 0) ssl[wc * 256 + rl] = ssum; }
        ss_publish(ssl, SS, u.pm * 256, u.pn, wr, wc, fr, fq);
    }
};
struct EpiE {
    static constexpr bool PERM = false;
    float* Eo;
    __device__ __forceinline__ void operator()(Acc& acc, const Unit& u, int wr, int wc, int fr, int fq) const {
#pragma unroll
        for (int ai = 0; ai < 2; ++ai)
#pragma unroll
            for (int m = 0; m < 4; ++m) { float* rp = Eo + (size_t)(u.pm * 256 + ai * 128 + wr * 64 + m * 16 + fr) * 128 + wc * 32 + 4 * fq;
#pragma unroll
                for (int n = 0; n < 2; ++n) *(f32x4*)(rp + n * 16) = acc[ai][0][m][n]; }
    }
};
struct EpiY {
    static constexpr bool PERM = false;
    const bf16_t* AG_; const float* Dv; bf16_t* Gm_;
    __device__ __forceinline__ void operator()(Acc& acc, const Unit& u, int wr, int wc, int fr, int fq) const {
        const bf16_t* __restrict__ AG = AG_; bf16_t* __restrict__ Gm = Gm_;
        const int g = u.pm >> 1, jj = u.pn & 1; const f32x4 d4 = *(const f32x4*)(Dv + g * 16 + 4 * fq);
#pragma unroll
        for (int ai = 0; ai < 2; ++ai)
#pragma unroll
            for (int m = 0; m < 4; ++m) { const int rowA = u.pm * 256 + ai * 128 + wr * 64 + m * 16 + fr; const int nchunk = rowA - g * 512;
#pragma unroll
                for (int bj = 0; bj < 2; ++bj)
#pragma unroll
                    for (int n = 0; n < 2; ++n) { const int sp = 16 * jj + 8 * bj + 2 * wc + n; const int t = nchunk * 32 + sp;
                        const f32x4 uu = unpack4(*(const u32x2*)(AG + (size_t)rowA * 640 + sp * 16 + 4 * fq));
                        f32x4 y = acc[ai][bj][m][n] + d4 * uu; y[0] = gelu_t(y[0]); y[1] = gelu_t(y[1]); y[2] = gelu_t(y[2]); y[3] = gelu_t(y[3]);
                        *(u32x2*)(Gm + (size_t)t * D + g * 16 + 4 * fq) = pack4(y); } }
    }
};
__device__ __forceinline__ float dpp_ror1(float v) { return __int_as_float(__builtin_amdgcn_update_dpp(0, __float_as_int(v), 0x121, 0xf, 0xf, false)); }
__device__ __forceinline__ float dpp_ror2(float v) { return __int_as_float(__builtin_amdgcn_update_dpp(0, __float_as_int(v), 0x122, 0xf, 0xf, false)); }
struct EpiConv {
    static constexpr bool PERM = false;
    bf16_t* ACT; const float* cw; const float* cb; LAS unsigned char* xl; const float* SS; int nsl;
    __device__ __forceinline__ float rsg(int gr) const { return (gr >= 0 && gr < S) ? row_rs(SS, gr, nsl) : 0.f; }
    __device__ __forceinline__ void operator()(Acc& acc, const Unit& u, int wr, int wc, int fr, int fq) const {
        LAS f32x4* xb = (LAS f32x4*)xl + (wr * 128 + wc * 8 + fq * 2 + (fr - 14)); asm volatile("" : "+v"(xb));
        LAS float* wl = (LAS float*)(xl + 8448) + (32 * wc + 4 * fq); asm volatile("" : "+v"(wl));
        LAS float* rl = (LAS float*)(xl + 12544) + (64 * wr + fr); asm volatile("" : "+v"(rl));
        { const int t = (wr * 4 + wc) * 64 + fq * 16 + fr; if (t < 256) { ((LAS float*)(xl + 12544))[t] = rsg(254 * u.pm - 2 + t);
              const int k = t >> 5, c4 = (t & 31) * 4, kk = k & 3; const float* srcp = (kk == 3 ? cb : cw + kk * 2 * FF) + (k >> 2) * FF + 128 * u.pn + c4;
              *(LAS f32x4*)((LAS float*)(xl + 8448) + k * 128 + c4) = *(const f32x4*)srcp; } }
        if (fr >= 14) {
#pragma unroll
            for (int ai = 0; ai < 2; ++ai) {
                if (2 * ai + wr <= 2) { const float rs = rsg(254 * u.pm - 2 + 128 * ai + 64 * wr + 48 + fr);
#pragma unroll
                    for (int bj = 0; bj < 2; ++bj)
#pragma unroll
                        for (int n = 0; n < 2; ++n) xb[256 * ai + 64 * bj + 32 * n] = acc[ai][bj][3][n] * rs; } }
        }
        asm volatile("s_waitcnt lgkmcnt(0)" ::: "memory"); __builtin_amdgcn_s_barrier(); asm volatile("" ::: "memory");
        int frl = fr; asm volatile("" : "+v"(frl));
        bf16_t* ab = ACT + (size_t)(254 * u.pm - 2 + 64 * wr + frl) * FF + 128 * u.pn + 32 * wc + 4 * fq;
#pragma unroll
        for (int ai = 0; ai < 2; ++ai) { const int s = 2 * ai + wr;
#pragma unroll
            for (int n = 0; n < 2; ++n) {
                asm volatile("" ::: "memory");
                const f32x4 wg0 = *(const LAS f32x4*)(wl + 16 * n), wg1 = *(const LAS f32x4*)(wl + 128 + 16 * n), wg2 = *(const LAS f32x4*)(wl + 256 + 16 * n), bg = *(const LAS f32x4*)(wl + 384 + 16 * n);
                const f32x4 wu0 = *(const LAS f32x4*)(wl + 512 + 16 * n), wu1 = *(const LAS f32x4*)(wl + 640 + 16 * n), wu2 = *(const LAS f32x4*)(wl + 768 + 16 * n), bu = *(const LAS f32x4*)(wl + 896 + 16 * n);
                float z0_; asm volatile("v_mov_b32 %0, 0" : "=v"(z0_));
                f32x4 pg = (f32x4){z0_, z0_, z0_, z0_}, pu = pg;
                if (s >= 1 && fr >= 14) { pg = xb[256 * ai - 128 + 32 * n]; pu = xb[256 * ai - 128 + 64 + 32 * n]; }
#pragma unroll
                for (int m = 0; m < 4; ++m) {
                    const int rt = 128 * ai + 64 * wr + 16 * m + fr; const int gr = 254 * u.pm - 2 + rt;
                    const float rs = rl[128 * ai + 16 * m];
                    const f32x4 cg_ = acc[ai][0][m][n] * rs, cu_ = acc[ai][1][m][n] * rs;
                    f32x4 T1g, T2g, T1u, T2u, P1g, P2g, P1u, P2u;
#pragma unroll
                    for (int e = 0; e < 4; ++e) { T1g[e] = fr == 15 ? pg[e] : cg_[e]; T2g[e] = fr >= 14 ? pg[e] : cg_[e]; T1u[e] = fr == 15 ? pu[e] : cu_[e]; T2u[e] = fr >= 14 ? pu[e] : cu_[e]; }
#pragma unroll
                    for (int e = 0; e < 4; ++e) { P1g[e] = dpp_ror1(T1g[e]); P2g[e] = dpp_ror2(T2g[e]); P1u[e] = dpp_ror1(T1u[e]); P2u[e] = dpp_ror2(T2u[e]); }
                    const f32x4 hg = bg + wg0 * P2g + wg1 * P1g + wg2 * cg_;
                    const f32x4 hu = bu + wu0 * P2u + wu1 * P1u + wu2 * cu_;
                    f32x4 ex = hg * (-LOG2E);
#pragma unroll
                    for (int e = 0; e < 4; ++e) ex[e] = __builtin_amdgcn_exp2f(ex[e]);
                    ex = ex + 1.0f;
#pragma unroll
                    for (int e = 0; e < 4; ++e) ex[e] = __builtin_amdgcn_rcpf(ex[e]);
                    const f32x4 o = (hg * hu) * ex;
                    if (rt >= 2 && gr < S) *(u32x2*)(ab + (size_t)(128 * ai + 16 * m) * FF + 16 * n) = pack4(o);
                    pg = cg_; pu = cu_;
                }
            }
        }
    }
};
}

constexpr size_t MiB = 1u << 20;
constexpr size_t WS_CL = 0, WS_CG = 524288, WS_GT = 1048576, WS_BAR = 1179648, BAR_BYTES = 16384, WS_SS = 1245184, ZERO_BYTES = 16384;
constexpr size_t WS_WIN = 3 * MiB;
constexpr size_t WS_WOUT = WS_WIN + 2ull * 2560 * 1024 * 2;
constexpr size_t WS_WGLU = WS_WOUT + 2ull * 1024 * 1024 * 2;
constexpr size_t WS_WUP = WS_WGLU + 2ull * 2048 * 1024 * 2;
constexpr size_t WS_WDN = WS_WUP + 4ull * 5632 * 1024 * 2;
constexpr size_t WS_WGT = WS_WDN + 4ull * 1024 * 2816 * 2;
constexpr size_t WS_WPR = WS_WGT + 4ull * 1024 * 1024 * 2;
constexpr size_t WS_HNA = WS_WPR + 4ull * 1024 * 256 * 2;
constexpr size_t WS_R = WS_HNA + (2ull + 16384 + 256) * 1024 * 2;
constexpr size_t WS_END = WS_R + 144 * MiB;
constexpr size_t R_Z = 0;
constexpr size_t R_AG = 0, R_TS = 40 * MiB, R_PS = 80 * MiB, R_E = 96 * MiB, R_G = 112 * MiB;
constexpr size_t R_ACT = 0;
constexpr size_t R_PB = 96 * MiB, R_PP = 104 * MiB;

#ifndef REPMASK
#define REPMASK 0u
#endif
#ifndef XSYNC
#define XSYNC 0
#endif
constexpr int LDS_BYTES = 147456, XL_OFF = 131072;

#define XB_TMO      128
#define XB_XCNT(j)  (256  + 64 * (j))
#define XB_XSUB(j)  (1280 + 64 * (j))
#define XB_XGEN(j)  (2304 + 64 * (j))
#define XB_TOP      3328
#define XB_TOPGEN   3392
#define XCD_BAR_WORDS 3456
#define XB_SPIN_CAP (1u << 18)
__device__ __forceinline__ unsigned xb_ld(unsigned* p)              { return __hip_atomic_load(p, __ATOMIC_RELAXED, __HIP_MEMORY_SCOPE_AGENT); }
__device__ __forceinline__ unsigned xb_add(unsigned* p, unsigned v) { return __hip_atomic_fetch_add(p, v, __ATOMIC_RELAXED, __HIP_MEMORY_SCOPE_AGENT); }
__device__ __forceinline__ unsigned xb_xcc_id() { return (unsigned)__builtin_amdgcn_s_getreg((3 << 11) | 20) & 0xFu; }
#define XB_SPIN(cond, bar) do { unsigned _sp = 0; while (cond) { __builtin_amdgcn_s_sleep(1); \
    if ((++_sp & 255u) == 0u) { if (xb_ld(&(bar)[XB_TMO])) break; if (_sp > XB_SPIN_CAP) { atomicAdd(&(bar)[XB_TMO], 1u); break; } } } } while (0)
struct XcdBarrier { unsigned* bar; unsigned x; volatile LAS unsigned* st; };
__device__ __forceinline__ XcdBarrier xcd_barrier_post(unsigned* bar, volatile LAS unsigned* st) {
    XcdBarrier b; b.bar = bar; b.x = xb_xcc_id(); b.st = st;
    if (threadIdx.x == 0) (void)xb_add(&bar[XB_XCNT(b.x)], 1u);
    return b;
}
__device__ __forceinline__ void xcd_barrier_complete(unsigned* bar, unsigned x, unsigned& nloc, unsigned& nx) {
    const unsigned G = gridDim.x * gridDim.y * gridDim.z;
    unsigned sum, cnt, mine, sp = 0u;
    for (;;) {
        sum = 0u; cnt = 0u; mine = 0u;
#pragma unroll
        for (unsigned j = 0; j < 16; ++j) { const unsigned c = xb_ld(&bar[XB_XCNT(j)]); sum += c; cnt += (c > 0u) ? 1u : 0u; mine = (j == x) ? c : mine; }
        if (sum == G) break;
        __builtin_amdgcn_s_sleep(1);
        if ((++sp & 255u) == 0u) { if (xb_ld(&bar[XB_TMO])) break; if (sp > XB_SPIN_CAP) { atomicAdd(&bar[XB_TMO], 1u); break; } }
    }
    nloc = mine > 0u ? mine : 1u; nx = cnt > 0u ? cnt : 1u;
}
__device__ __forceinline__ void xcd_barrier(unsigned* bar_, volatile LAS unsigned* st_, int wid_) {
    XcdBarrier b; b.bar = bar_; b.x = xb_xcc_id(); b.st = st_;
    asm volatile("s_waitcnt vmcnt(0)" ::: "memory");
    __syncthreads();
    int ln_; asm volatile("v_mbcnt_lo_u32_b32 %0, -1, 0\n\tv_mbcnt_hi_u32_b32 %0, -1, %0" : "=v"(ln_));
    if (wid_ == 0 && ln_ == 0) {
        unsigned* bar = b.bar;
        __builtin_amdgcn_s_waitcnt(0);
        unsigned nloc = b.st[0], nx = b.st[1];
        if (nloc == 0u) { xcd_barrier_complete(bar, b.x, nloc, nx); b.st[0] = nloc; b.st[1] = nx; }
        const unsigned old = xb_add(&bar[XB_XSUB(b.x)], 1u);
        const unsigned gen = old / nloc;
        if (old + 1u == (gen + 1u) * nloc) {
            __builtin_amdgcn_fence(__ATOMIC_RELEASE, "agent");
            asm volatile("s_waitcnt vmcnt(0)" ::: "memory");
            const unsigned og = xb_add(&bar[XB_TOP], 1u);
            const unsigned tg = og / nx;
            if (og + 1u == (tg + 1u) * nx) xb_add(&bar[XB_TOPGEN], 1u);
            else XB_SPIN(xb_ld(&bar[XB_TOPGEN]) == tg, bar);
            __builtin_amdgcn_fence(__ATOMIC_ACQUIRE, "agent");
            xb_add(&bar[XB_XGEN(b.x)], 1u);
            asm volatile("s_waitcnt vmcnt(0)" ::: "memory");
        } else {
            XB_SPIN(xb_ld(&bar[XB_XGEN(b.x)]) == gen, bar);
            __builtin_amdgcn_fence(__ATOMIC_ACQUIRE, "agent");
            asm volatile("s_waitcnt vmcnt(0)" ::: "memory");
        }
    }
    __syncthreads();
}

struct Params { const float* in[27]; float* out; unsigned char* ws; };

__device__ __forceinline__ float load_row(const float* xrow, int lane, f32x4 (&v)[4]) {
    const f32x4* xr = (const f32x4*)xrow + lane; float ss = 0.f;
#pragma unroll
    for (int j = 0; j < 4; ++j) { v[j] = xr[64 * j]; ss += (v[j][0] * v[j][0] + v[j][1] * v[j][1]) + (v[j][2] * v[j][2] + v[j][3] * v[j][3]); }
    return __builtin_amdgcn_rsqf(wave_sum(ss) * (1.f / D) + EPS);
}

__device__ __forceinline__ void transpose_item(const float* W, int K, int ldw, bf16_t* WT, int n0, int drow0, int kb, LAS float* scr, int lane, const float* gain) {
    const int k0 = 64 * kb, kq = lane >> 4, nq = 4 * (lane & 15); const float* wp = W + (size_t)(k0 + kq) * ldw + n0 + nq;
#pragma unroll
    for (int i = 0; i < 16; ++i) { const f32x4 w = *(const f32x4*)(wp + (size_t)(4 * i) * ldw) * (gain ? gain[k0 + 4 * i + kq] : 1.f); LAS float* sp = scr + (4 * i + kq) * 65 + nq; sp[0] = w[0]; sp[1] = w[1]; sp[2] = w[2]; sp[3] = w[3]; }
    asm volatile("s_waitcnt lgkmcnt(0)" ::: "memory");
    const int c = lane & 7;
#pragma unroll
    for (int j = 0; j < 8; ++j) { const int n = (lane >> 3) + 8 * j; const LAS float* s = scr + (8 * c) * 65 + n;
        u32x4 o; o.x = cvt_pk_bf16(s[0 * 65], s[1 * 65]); o.y = cvt_pk_bf16(s[2 * 65], s[3 * 65]); o.z = cvt_pk_bf16(s[4 * 65], s[5 * 65]); o.w = cvt_pk_bf16(s[6 * 65], s[7 * 65]);
        *(u32x4*)(WT + (size_t)(drow0 + n) * K + k0 + 8 * c) = o; }
    asm volatile("s_waitcnt lgkmcnt(0)" ::: "memory");
}
__device__ __forceinline__ int dest_row(int mode, int n0, int half) {
    if (mode == 1) { const int seg = n0 >> 9, r = n0 & 511; const int ds = seg == 1 ? 2 : (seg == 2 ? 1 : seg); return ds * 512 + r; }
    if (mode == 2) { const int hi = n0 >= half, np = hi ? n0 - half : n0; return (np >> 7) * 256 + hi * 128 + (np & 127); }
    return n0;
}
__device__ __forceinline__ bool transpose_mat(int& r, const float* W, int K, int ldw, int ncols, bf16_t* WT, int mode, LAS float* scr, int lane, const float* gain = nullptr) {
    const int nblk = ncols / 64, items = (K / 64) * nblk;
    if (r >= items) { r -= items; return false; }
    const int kb = r / nblk, nb = r % nblk;
    transpose_item(W, K, ldw, WT, nb * 64, dest_row(mode, nb * 64, ncols / 2), kb, scr, lane, gain);
    return true;
}

__device__ __forceinline__ const float* in_ptr(const Params& P, int i) { asm volatile("" : "+s"(i)); return P.in[i]; }
__global__ void __launch_bounds__(512, 2) mega(Params P) {
    extern __shared__ __attribute__((aligned(16))) unsigned char lds_raw[];
    LAS unsigned char* lds = (LAS unsigned char*)lds_raw;
    cg::grid_group grid = cg::this_grid();
    const int G = gridDim.x, bid = blockIdx.x, NGW = G * 8;
    const int wid0 = __builtin_amdgcn_readfirstlane((int)threadIdx.x >> 6);
#define PHASE_IDS int lane_; asm volatile("v_mbcnt_lo_u32_b32 %0, -1, 0\n\tv_mbcnt_hi_u32_b32 %0, -1, %0" : "=v"(lane_)); const int lane = lane_, wid = wid0, tid = wid * 64 + lane, gw = bid * 8 + wid; (void)tid; (void)gw;
    unsigned char* ws = P.ws;
    float* X = P.out;
    float* CL = (float*)(ws + WS_CL); float* CGm = (float*)(ws + WS_CG); float* GT = (float*)(ws + WS_GT);
    bf16_t* HNA = (bf16_t*)(ws + WS_HNA); bf16_t* HN = HNA + 2 * D;
    unsigned char* R = ws + WS_R;
    { volatile LAS unsigned* st0 = (volatile LAS unsigned*)(lds + XL_OFF + 8192); if (threadIdx.x < 2) st0[threadIdx.x] = 0u; __syncthreads(); }
    (void)xcd_barrier_post((unsigned*)(ws + WS_BAR), (volatile LAS unsigned*)(lds + XL_OFF + 8192));
#define GSYNC() xcd_barrier((unsigned*)(P.ws + WS_BAR), (volatile LAS unsigned*)(lds + XL_OFF + 8192), wid0)
#ifdef PROBE_SEL
    LAS float* tacc = (LAS float*)(lds + XL_OFF + 13600); LAS unsigned long long* tlast = (LAS unsigned long long*)(lds + XL_OFF + 13696);
    if (threadIdx.x == 0) { for (int i = 0; i < 16; ++i) tacc[i] = 0.f; *tlast = __builtin_amdgcn_s_memrealtime(); }
#define STAMP(gid) do { if (bid == 0 && threadIdx.x == 0) { const unsigned long long t_ = __builtin_amdgcn_s_memrealtime(); tacc[gid] += (float)(t_ - *tlast); *tlast = t_; } } while (0)
#else
#define STAMP(gid) do {} while (0)
#endif

    for (int rep_ = 0; rep_ < 1 + (int)((REPMASK >> 0) & 1u); ++rep_) { PHASE_IDS
        LAS float* scr = (LAS float*)(lds + wid * 16640);
        constexpr int I_IN = 16 * 40, I_OUT = 16 * 16, I_GLU = 16 * 32, I_UP = 16 * 88, I_DN = 44 * 16, I_GT = 16 * 16, I_PR = 4 * 16;
        constexpr int NIT = 2 * I_IN + 2 * I_OUT + 2 * I_GLU + 4 * I_UP + 4 * I_DN + 4 * I_GT + 4 * I_PR;
        for (int it = gw; it < NIT; it += NGW) {
            int r = it; bool done = false;
#pragma unroll 1
            for (int e = 0; e < 2 && !done; ++e) done = transpose_mat(r, in_ptr(P, 4) + (size_t)e * 1024 * 2568, 1024, 2568, 2560, (bf16_t*)(ws + WS_WIN) + (size_t)e * 2560 * 1024, 1, scr, lane);
#pragma unroll 1
            for (int e = 0; e < 2 && !done; ++e) done = transpose_mat(r, in_ptr(P, 11) + (size_t)e * 1024 * 1024, 1024, 1024, 1024, (bf16_t*)(ws + WS_WOUT) + (size_t)e * 1024 * 1024, 0, scr, lane);
#pragma unroll 1
            for (int e = 0; e < 2 && !done; ++e) done = transpose_mat(r, in_ptr(P, 20) + (size_t)e * 1024 * 2048, 1024, 2048, 2048, (bf16_t*)(ws + WS_WGLU) + (size_t)e * 2048 * 1024, 2, scr, lane);
#pragma unroll 1
            for (int e = 0; e < 4 && !done; ++e) done = transpose_mat(r, in_ptr(P, 21) + (size_t)e * 1024 * 5632, 1024, 5632, 5632, (bf16_t*)(ws + WS_WUP) + (size_t)e * 5632 * 1024, 2, scr, lane, in_ptr(P, 3) + e * D);
#pragma unroll 1
            for (int e = 0; e < 4 && !done; ++e) done = transpose_mat(r, in_ptr(P, 24) + (size_t)e * 2816 * 1024, 2816, 1024, 1024, (bf16_t*)(ws + WS_WDN) + (size_t)e * 1024 * 2816, 0, scr, lane);
#pragma unroll 1
            for (int e = 0; e < 4 && !done; ++e) done = transpose_mat(r, in_ptr(P, 26) + (size_t)e * 1024 * 1024, 1024, 1024, 1024, (bf16_t*)(ws + WS_WGT) + (size_t)e * 1024 * 1024, 0, scr, lane);
#pragma unroll 1
            for (int e = 0; e < 4 && !done; ++e) done = transpose_mat(r, in_ptr(P, 25) + (size_t)e * 256 * 1024, 256, 1024, 1024, (bf16_t*)(ws + WS_WPR) + (size_t)e * 1024 * 256, 0, scr, lane);
        }
        if (bid == 0) for (int i = tid; i < 2 * D / 2; i += 512) ((unsigned*)HNA)[i] = 0u;
    }
    grid.sync();
    STAMP(0);

#pragma unroll 1
    for (int L = 0; L < 4; ++L) {
        const int e = L >> 1;
        if ((L & 1) == 0) {
            for (int rep_ = 0; rep_ < 1 + (int)((REPMASK >> 1) & 1u); ++rep_) { PHASE_IDS
                const float* gmix = in_ptr(P, 2) + L * D; const float* Win = in_ptr(P, 4) + (size_t)e * 1024 * 2568; const float* bfg = in_ptr(P, 5) + e * 8;
                f32x4 wfa[16], wfb[16];
#pragma unroll
                for (int j = 0; j < 4; ++j)
#pragma unroll
                    for (int i = 0; i < 4; ++i) { const float* wp = Win + (size_t)(4 * lane + 256 * j + i) * 2568 + 2560; wfa[j * 4 + i] = *(const f32x4*)wp; wfb[j * 4 + i] = *(const f32x4*)(wp + 4); }
                const float* xsrc = (L == 0 ? in_ptr(P, 0) : X);
                LAS float* lw = (LAS float*)(lds + wid * 256);
                const float bbl = bfg[lane & 7];
                for (int gi = gw; gi < 2048; gi += NGW) {
                    f32x4 cur[4], nxt[4];
                    { const f32x4* xr = (const f32x4*)(xsrc + (size_t)(8 * gi) * D) + lane;
#pragma unroll
                      for (int j = 0; j < 4; ++j) cur[j] = xr[64 * j]; }
                    float myf = 0.f;
#pragma unroll 1
                    for (int rr = 0; rr < 8; ++rr) {
                        const int t = 8 * gi + rr;
                        if (rr < 7) { const f32x4* xr = (const f32x4*)(xsrc + (size_t)(t + 1) * D) + lane;
#pragma unroll
                            for (int j = 0; j < 4; ++j) nxt[j] = xr[64 * j]; }
                        float ss = 0.f;
#pragma unroll
                        for (int j = 0; j < 4; ++j) ss += (cur[j][0] * cur[j][0] + cur[j][1] * cur[j][1]) + (cur[j][2] * cur[j][2] + cur[j][3] * cur[j][3]);
                        const float rs = __builtin_amdgcn_rsqf(wave_sum(ss) * (1.f / D) + EPS);
                        if (L == 0) {
#pragma unroll
                            for (int j = 0; j < 4; ++j) *((f32x4*)(X + (size_t)t * D) + lane + 64 * j) = cur[j]; }
                        const float zf_ = zero_f(); f32x4 fa = (f32x4){zf_, zf_, zf_, zf_}, fb = fa;
#pragma unroll
                        for (int j = 0; j < 4; ++j) { const f32x4 gg = *((const f32x4*)gmix + lane + 64 * j); const f32x4 v = cur[j] * rs * gg;
                            *((u32x2*)(HN + (size_t)t * D) + lane + 64 * j) = pack4(v);
#pragma unroll
                            for (int i = 0; i < 4; ++i) { fa += wfa[j * 4 + i] * v[i]; fb += wfb[j * 4 + i] * v[i]; } }
                        float f0 = wave_sum(fa[0]), f1 = wave_sum(fa[1]), f2 = wave_sum(fa[2]), f3 = wave_sum(fa[3]), f4 = wave_sum(fb[0]), f5 = wave_sum(fb[1]), f6 = wave_sum(fb[2]), f7 = wave_sum(fb[3]);
                        const int h = lane & 7;
                        float sel = f0; sel = h == 1 ? f1 : sel; sel = h == 2 ? f2 : sel; sel = h == 3 ? f3 : sel; sel = h == 4 ? f4 : sel; sel = h == 5 ? f5 : sel; sel = h == 6 ? f6 : sel; sel = h == 7 ? f7 : sel;
                        myf = ((lane >> 3) == rr) ? sel : myf;
#pragma unroll
                        for (int j = 0; j < 4; ++j) cur[j] = nxt[j];
                    }
                    const float z = myf + bbl; const float ls = -__builtin_amdgcn_logf(1.f + __builtin_amdgcn_exp2f(-z * LOG2E));
                    lw[lane] = ls; asm volatile("s_waitcnt lgkmcnt(0)" ::: "memory");
                    float cum = 0.f;
#pragma unroll
                    for (int r2 = 0; r2 < 8; ++r2) { const float o_ = lw[r2 * 8 + (lane & 7)]; cum += (r2 <= (lane >> 3)) ? o_ : 0.f; }
                    asm volatile("s_waitcnt lgkmcnt(0)" ::: "memory");
                    CL[(size_t)gi * 64 + lane] = cum;
                    if (lane >= 56) GT[(size_t)gi * 8 + (lane & 7)] = cum;
                }
            }
            GSYNC();
            STAMP(1);
            for (int rep_ = 0; rep_ < 1 + (int)((REPMASK >> 2) & 1u); ++rep_) { PHASE_IDS
                pg8::Gemm g{HN, (const bf16_t*)(ws + WS_WIN) + (size_t)e * 2560 * 1024, 1024, 1024, 256};
                pg8::StaticOrder so; so.init(64, 10, G, bid);
                pg8::EpiStore E{(bf16_t*)(R + R_Z), ZW, 1};
                pg8::gemm_phase(lds, g, so, E, wid);
            }
            GSYNC();
            STAMP(2);
            for (int rep_ = 0; rep_ < 1 + (int)((REPMASK >> 3) & 1u); ++rep_) { PHASE_IDS
                bf16_t* Z = (bf16_t*)(R + R_Z);
                const float* gq = in_ptr(P, 6) + e * 64; const float* gk = in_ptr(P, 7) + e * 64;
                LAS float* CT = (LAS float*)(lds + 98304); LAS float* BT = CT + 2048; LAS float* OFF = BT + 512;
                __syncthreads();
                { const int ckk = tid >> 1, hq = (tid & 1) * 4; f32x4 s = (f32x4){0.f, 0.f, 0.f, 0.f};
#pragma unroll
                  for (int i = 0; i < 8; ++i) s += *(const f32x4*)(GT + (size_t)(8 * ckk + i) * 8 + hq);
                  *(LAS f32x4*)(CT + ckk * 8 + hq) = s; }
                __syncthreads();
                { const int h = tid & 7, b4 = tid >> 3; BT[b4 * 8 + h] = (CT[(4 * b4) * 8 + h] + CT[(4 * b4 + 1) * 8 + h]) + (CT[(4 * b4 + 2) * 8 + h] + CT[(4 * b4 + 3) * 8 + h]); }
                __syncthreads();
                { const int h = tid & 7, b4 = tid >> 3; float o_ = 0.f;
                  for (int i = 0; i < b4; ++i) o_ += BT[i * 8 + h];
#pragma unroll
                  for (int i = 0; i < 4; ++i) { OFF[(4 * b4 + i) * 8 + h] = o_; o_ += CT[(4 * b4 + i) * 8 + h]; } }
                __syncthreads();
                for (int ck = bid; ck < 256; ck += G) {
                    { const int h = tid & 7, tok = tid >> 3; float off = OFF[ck * 8 + h];
                      const int gl = tok >> 3;
                      for (int i2 = 0; i2 < gl; ++i2) off += GT[(size_t)(8 * ck + i2) * 8 + h];
                      const int t = 64 * ck + tok; CGm[(size_t)t * 8 + h] = CL[(size_t)t * 8 + h] + off; }
#pragma unroll 1
                    for (int ps4 = 0; ps4 < 16; ps4 += 4) {
                        u32x4 wq[4];
#pragma unroll
                        for (int q = 0; q < 4; ++q) { const int pair = (ps4 + q) * 64 + (tid >> 3); const int tok = pair >> 4, hh = (pair >> 1) & 7, isk = pair & 1;
                            wq[q] = *(const u32x4*)(Z + (size_t)(64 * ck + tok) * ZW + (isk ? 1536 : 512) + hh * 64 + (tid & 7) * 8); }
#pragma unroll
                        for (int q = 0; q < 4; ++q) { const int pair = (ps4 + q) * 64 + (tid >> 3), sub = tid & 7; const int tok = pair >> 4, hh = (pair >> 1) & 7, isk = pair & 1;
                            bf16_t* ptr = Z + (size_t)(64 * ck + tok) * ZW + (isk ? 1536 : 512) + hh * 64 + sub * 8;
                            const u32x4 w = wq[q]; float v[8];
                            v[0] = bf2f(w.x & 0xffffu); v[1] = bf2f(w.x >> 16); v[2] = bf2f(w.y & 0xffffu); v[3] = bf2f(w.y >> 16); v[4] = bf2f(w.z & 0xffffu); v[5] = bf2f(w.z >> 16); v[6] = bf2f(w.w & 0xffffu); v[7] = bf2f(w.w >> 16);
                            float ss = 0.f;
#pragma unroll
                            for (int i = 0; i < 8; ++i) ss += v[i] * v[i];
                            ss = x3_sum(ss);
                            const float rs = (__builtin_amdgcn_rsqf(ss * (1.f / 64.f) + EPS)) * (isk ? 1.f : 0.125f * LOG2E);
                            const float* gp = (isk ? gk : gq) + sub * 8;
#pragma unroll
                            for (int i = 0; i < 8; ++i) v[i] = v[i] * rs * gp[i];
                            u32x4 o; o.x = cvt_pk_bf16(v[0], v[1]); o.y = cvt_pk_bf16(v[2], v[3]); o.z = cvt_pk_bf16(v[4], v[5]); o.w = cvt_pk_bf16(v[6], v[7]);
                            { int rp_ = rep_; asm volatile("" : "+v"(rp_)); if (rp_) o = w; }
                            *(u32x4*)ptr = o; }
                    }
                    { LAS bf16_t* LT = (LAS bf16_t*)(lds + 1024); bf16_t* VTg = (bf16_t*)(R + 80 * MiB);
                      __syncthreads();
#pragma unroll 1
                      for (int k = 0; k < 8; ++k) { const int idx = tid + 512 * k; const int tok = idx & 63, cc = idx >> 6;
                          const u32x4 w = *(const u32x4*)(Z + (size_t)(64 * ck + tok) * ZW + 2048 + cc * 8); LAS bf16_t* lt = LT + (cc * 8) * 72 + tok;
                          lt[0 * 72] = (bf16_t)(w.x & 0xffffu); lt[1 * 72] = (bf16_t)(w.x >> 16); lt[2 * 72] = (bf16_t)(w.y & 0xffffu); lt[3 * 72] = (bf16_t)(w.y >> 16);
                          lt[4 * 72] = (bf16_t)(w.z & 0xffffu); lt[5 * 72] = (bf16_t)(w.z >> 16); lt[6 * 72] = (bf16_t)(w.w & 0xffffu); lt[7 * 72] = (bf16_t)(w.w >> 16); }
                      __syncthreads();
#pragma unroll 1
                      for (int k = 0; k < 8; ++k) { const int idx = tid + 512 * k; const int c = idx >> 3, part = idx & 7;
                          *(u32x4*)(VTg + (size_t)c * S + 64 * ck + part * 8) = *(const LAS u32x4*)(LT + c * 72 + part * 8); }
                    }
                }
                LAS bf16_t* Wsm = (LAS bf16_t*)lds; LAS bf16_t* VT = (LAS bf16_t*)(lds + 34816);
                const float* wsp = in_ptr(P, 9) + (size_t)e * 4 * 128 * 128; const float* bsp = in_ptr(P, 10) + e * 512; const float* vg = in_ptr(P, 8) + e * 512;
                for (int it = bid; it < 512; it += G) {
                    const int n = it >> 2, g = it & 3;
                    __syncthreads();
                    for (int idx = tid; idx < 128 * 32; idx += 512) { const int t = idx >> 5, s4 = (idx & 31) * 4; f32x4 w = *(const f32x4*)(wsp + ((size_t)g * 128 + t) * 128 + s4);
#pragma unroll
                        for (int i = 0; i < 4; ++i) if (s4 + i > t) w[i] = 0.f;
                        *(LAS u32x2*)(Wsm + t * 136 + s4) = pack4(w); }
                    { const int tok = tid >> 2, part = tid & 3; const bf16_t* vp = Z + (size_t)(128 * n + tok) * ZW + 1024 + g * 128 + part * 32;
                      float v[32]; float ss = 0.f;
#pragma unroll
                      for (int q = 0; q < 4; ++q) { const u32x4 w = *(const u32x4*)(vp + q * 8);
                          v[q * 8 + 0] = bf2f(w.x & 0xffffu); v[q * 8 + 1] = bf2f(w.x >> 16); v[q * 8 + 2] = bf2f(w.y & 0xffffu); v[q * 8 + 3] = bf2f(w.y >> 16);
                          v[q * 8 + 4] = bf2f(w.z & 0xffffu); v[q * 8 + 5] = bf2f(w.z >> 16); v[q * 8 + 6] = bf2f(w.w & 0xffffu); v[q * 8 + 7] = bf2f(w.w >> 16); }
#pragma unroll
                      for (int i = 0; i < 32; ++i) ss += v[i] * v[i];
                      ss = x2_sum(ss);
                      const float rs = __builtin_amdgcn_rsqf(ss * (1.f / 128.f) + EPS);
#pragma unroll
                      for (int i = 0; i < 32; ++i) { const int c = part * 32 + i; const float y = v[i] * rs * vg[g * 128 + c]; VT[c * 136 + tok] = (bf16_t)(cvt_pk_bf16(y, 0.f) & 0xffffu); } }
                    __syncthreads();
                    const int l15 = lane & 15, quad = lane >> 4;
                    f32x4 acc[8];
#pragma unroll
                    for (int cb = 0; cb < 8; ++cb) acc[cb] = (f32x4){0.f, 0.f, 0.f, 0.f};
                    for (int ks = 0; ks <= (wid >> 1); ++ks) {
                        const bf16x8 a = *(const LAS bf16x8*)(Wsm + (16 * wid + l15) * 136 + 32 * ks + quad * 8);
#pragma unroll
                        for (int cb = 0; cb < 8; ++cb) { const bf16x8 b = *(const LAS bf16x8*)(VT + (16 * cb + l15) * 136 + 32 * ks + quad * 8);
                            acc[cb] = __builtin_amdgcn_mfma_f32_16x16x32_bf16(b, a, acc[cb], 0, 0, 0); }
                    }
                    const int t = 16 * wid + l15; const float bs = bsp[g * 128 + t];
                    bf16_t* up = Z + (size_t)(128 * n + t) * ZW + g * 128 + quad * 4;
#pragma unroll
                    for (int cb = 0; cb < 8; ++cb) { const f32x4 uu = unpack4(*(const u32x2*)(up + 16 * cb)); f32x4 y = uu * (acc[cb] + bs); { int rp_ = rep_; asm volatile("" : "+v"(rp_)); if (rp_) y = uu; } *(u32x2*)(up + 16 * cb) = pack4(y); }
                }
            }
            GSYNC();
            STAMP(1);
            for (int rep_ = 0; rep_ < 1 + (int)((REPMASK >> 4) & 1u); ++rep_) { PHASE_IDS
                bf16_t* Z = (bf16_t*)(R + R_Z); const bf16_t* VTg = (const bf16_t*)(R + 80 * MiB);
                const int l15 = lane & 15, quad = lane >> 4;
                const float Gq = wave_max(fabsf(in_ptr(P, 6)[e * 64 + lane])), Gk = wave_max(fabsf(in_ptr(P, 7)[e * 64 + lane]));
                const float B2l = 8.f * Gq * Gk * LOG2E;
                int hord = 0;
                { float tot[8];
#pragma unroll
                  for (int hh = 0; hh < 8; ++hh) tot[hh] = CGm[(size_t)(S - 1) * 8 + hh];
#pragma unroll
                  for (int hh = 0; hh < 8; ++hh) { int rank = 0;
#pragma unroll
                      for (int h2 = 0; h2 < 8; ++h2) rank += (tot[h2] > tot[hh] || (tot[h2] == tot[hh] && h2 < hh)) ? 1 : 0;
                      hord |= hh << (4 * rank); } }
                for (int item = bid; item < 512; item += G) {
                    const int half = (item >> 8) & 1, rk = half ? 7 - (item & 7) : (item & 7);
                    const int qb2 = 63 - (item >> 3), h = (hord >> (4 * rk)) & 7; const int q0 = 256 * qb2, qw = q0 + 32 * wid;
                    bf16x8 qf[2][2];
#pragma unroll
                    for (int rb = 0; rb < 2; ++rb) { const bf16_t* Qp = Z + (size_t)(qw + 16 * rb + l15) * ZW + 512 + 64 * h;
                        qf[rb][0] = *(const bf16x8*)(Qp + quad * 8); qf[rb][1] = *(const bf16x8*)(Qp + 32 + quad * 8); }
                    float rminv = 0.f;
                    float mrun[2] = {-1e30f, -1e30f}, lrun[2] = {0.f, 0.f}; f32x4 o[2][4];
#pragma unroll
                    for (int rb = 0; rb < 2; ++rb)
#pragma unroll
                        for (int db = 0; db < 4; ++db) o[rb][db] = (f32x4){0.f, 0.f, 0.f, 0.f};
                    const bf16_t* kbase = Z + (size_t)(tid >> 3) * ZW + 1536 + 64 * h + (tid & 7) * 8;
                    const bf16_t* vbase = VTg + (size_t)(h * 64 + (tid >> 3)) * S + (tid & 7) * 8;
                    const float* cbase = CGm + (size_t)lane * 8 + h;
                    u32x4 kreg, vreg; float ckreg;
#define ATT_LOAD(jj) do { kreg = *(const u32x4*)(kbase + (size_t)(64 * (jj)) * ZW); vreg = *(const u32x4*)(vbase + 64 * (jj)); ckreg = cbase[(size_t)(64 * (jj)) * 8]; } while (0)
#define ATT_STORE(bb) do { LAS unsigned char* lb = lds + (bb) * 18688; *(LAS u32x4*)(lb + ((tid >> 3) * 72 + (tid & 7) * 8) * 2) = kreg; *(LAS u32x4*)(lb + 9216 + ((tid >> 3) * 72 + (tid & 7) * 8) * 2) = vreg; if (wid == 0) ((LAS float*)(lb + 18432))[lane] = -ckreg; } while (0)
                    int j = 4 * qb2 + 3;
                    ATT_LOAD(j); ATT_STORE(j & 1); ATT_LOAD(j - 1);
                    __syncthreads();
                    for (; j >= 0; --j) {
                        const int b = j & 1;
                        if (j > 0) { ATT_STORE(b ^ 1); if (j > 1) ATT_LOAD(j - 2); }
                        const LAS bf16_t* Ks = (const LAS bf16_t*)(lds + b * 18688); const LAS bf16_t* VT = (const LAS bf16_t*)(lds + b * 18688 + 9216); const LAS float* Ck = (const LAS float*)(lds + b * 18688 + 18432);
                        if (j == 4 * qb2 - 1) { const float mm = wave_min(fminf(mrun[0], mrun[1])); LAS float* rmn = (LAS float*)(lds + 37376);
                            if (lane == 0) rmn[wid] = mm;
                            __syncthreads();
                            rminv = fminf(fminf(fminf(rmn[0], rmn[1]), fminf(rmn[2], rmn[3])), fminf(fminf(rmn[4], rmn[5]), fminf(rmn[6], rmn[7]))); }
                        const bool stop = (64 * j + 63 < q0) && ((B2l + Ck[63] - rminv) < -40.f);
                        if (!stop && !(64 * j > qw + 31)) {
                            f32x4 s[2][4];
#pragma unroll
                            for (int kb = 0; kb < 4; ++kb) {
                                const LAS bf16_t* kp = Ks + (16 * kb + l15) * 72 + quad * 8;
                                const bf16x8 k0 = *(const LAS bf16x8*)kp, k1 = *(const LAS bf16x8*)(kp + 32);
                                const f32x4 nck4 = *(const LAS f32x4*)(Ck + 16 * kb + quad * 4);
#pragma unroll
                                for (int rb = 0; rb < 2; ++rb) {
                                    f32x4 z = __builtin_amdgcn_mfma_f32_16x16x32_bf16(k0, qf[rb][0], nck4, 0, 0, 0);
                                    s[rb][kb] = __builtin_amdgcn_mfma_f32_16x16x32_bf16(k1, qf[rb][1], z, 0, 0, 0);
                                }
                            }
                            if (64 * j + 63 > qw) {
#pragma unroll
                                for (int rb = 0; rb < 2; ++rb)
#pragma unroll
                                    for (int kb = 0; kb < 4; ++kb)
#pragma unroll
                                        for (int jj = 0; jj < 4; ++jj) if (64 * j + 16 * kb + 4 * quad + jj > qw + 16 * rb + l15) s[rb][kb][jj] = -1e30f;
                            }
                            asm volatile("s_nop 15\n\ts_nop 7" : "+v"(s[0][0]), "+v"(s[0][1]), "+v"(s[0][2]), "+v"(s[0][3]), "+v"(s[1][0]), "+v"(s[1][1]), "+v"(s[1][2]), "+v"(s[1][3]));
                            bf16x8 pb[2][2];
#pragma unroll
                            for (int rb = 0; rb < 2; ++rb) {
                                float mx = max3f(s[rb][0][0], s[rb][0][1], s[rb][0][2]); mx = max3f(mx, s[rb][0][3], s[rb][1][0]); mx = max3f(mx, s[rb][1][1], s[rb][1][2]); mx = max3f(mx, s[rb][1][3], s[rb][2][0]);
                                mx = max3f(mx, s[rb][2][1], s[rb][2][2]); mx = max3f(mx, s[rb][2][3], s[rb][3][0]); mx = max3f(mx, s[rb][3][1], s[rb][3][2]); mx = max3f(mx, s[rb][3][3], mx);
                                mx = quad_max(mx);
                                if (__builtin_amdgcn_ballot_w64(mx > mrun[rb]) != 0ull) {
                                    const float mn_ = fmaxf(mrun[rb], mx); const float alpha = __builtin_amdgcn_exp2f(mrun[rb] - mn_); mrun[rb] = mn_; lrun[rb] *= alpha;
#pragma unroll
                                    for (int db = 0; db < 4; ++db) o[rb][db] = o[rb][db] * alpha;
                                }
                                const float mn = mrun[rb];
                                float ls = 0.f;
#pragma unroll
                                for (int kb = 0; kb < 4; ++kb)
#pragma unroll
                                    for (int jj = 0; jj < 4; ++jj) { s[rb][kb][jj] = __builtin_amdgcn_exp2f(s[rb][kb][jj] - mn); ls += s[rb][kb][jj]; }
                                lrun[rb] += ls;
#pragma unroll
                                for (int kk = 0; kk < 2; ++kk) { u32x4 pw; pw.x = cvt_pk_bf16(s[rb][2 * kk][0], s[rb][2 * kk][1]); pw.y = cvt_pk_bf16(s[rb][2 * kk][2], s[rb][2 * kk][3]);
                                    pw.z = cvt_pk_bf16(s[rb][2 * kk + 1][0], s[rb][2 * kk + 1][1]); pw.w = cvt_pk_bf16(s[rb][2 * kk + 1][2], s[rb][2 * kk + 1][3]); pb[rb][kk] = __builtin_bit_cast(bf16x8, pw); }
                            }
#pragma unroll
                            for (int kk = 0; kk < 2; ++kk)
#pragma unroll
                                for (int db = 0; db < 4; ++db) {
                                    const LAS bf16_t* vp = VT + (16 * db + l15) * 72 + 32 * kk + quad * 4;
                                    u32x4 vw; const u32x2 va = *(const LAS u32x2*)vp, vb = *(const LAS u32x2*)(vp + 16); vw.x = va.x; vw.y = va.y; vw.z = vb.x; vw.w = vb.y;
                                    const bf16x8 vf = __builtin_bit_cast(bf16x8, vw);
                                    o[0][db] = __builtin_amdgcn_mfma_f32_16x16x32_bf16(vf, pb[0][kk], o[0][db], 0, 0, 0);
                                    o[1][db] = __builtin_amdgcn_mfma_f32_16x16x32_bf16(vf, pb[1][kk], o[1][db], 0, 0, 0);
                                }
                        }
                        __syncthreads();
                        if (stop) break;
                    }
#undef ATT_LOAD
#undef ATT_STORE
#pragma unroll
                    for (int rb = 0; rb < 2; ++rb) {
                        const float lr = quad_sum(lrun[rb]);
                        const float inv = 1.0f / lr;
                        bf16_t* Op = Z + (size_t)(qw + 16 * rb + l15) * ZW + 512 + 64 * h + 4 * quad;
#pragma unroll
                        for (int db = 0; db < 4; ++db) *(u32x2*)(Op + 16 * db) = pack4(o[rb][db] * inv);
                    }
                }
            }
            GSYNC();
            STAMP(3);
            for (int rep_ = 0; rep_ < 1 + (int)((REPMASK >> 5) & 1u); ++rep_) { PHASE_IDS
            { const float* pin = in_ptr(P, 1) + (size_t)L * S * 256; bf16_t* PB = (bf16_t*)(R + R_PB);
              for (int t = gw; t < S; t += NGW) { const f32x4 pv = *((const f32x4*)(pin + (size_t)t * 256) + lane); *((u32x2*)(PB + (size_t)t * 256) + lane) = pack4(pv); } }
                pg8::Gemm g{(const bf16_t*)(R + R_Z), (const bf16_t*)(ws + WS_WOUT) + (size_t)e * 1024 * 1024, 1024, ZW, 256};
                pg8::StaticOrder so; so.init(64, 4, G, bid);
                pg8::EpiRes E{X, HN, (float*)(ws + WS_SS), (LAS float*)(lds + XL_OFF + 8448)};
                pg8::gemm_phase(lds, g, so, E, wid);
            }
            GSYNC();
            STAMP(2);
        } else {
            for (int rep_ = 0; rep_ < 1 + (int)((REPMASK >> 6) & 1u); ++rep_) { PHASE_IDS
                bf16_t* AG = (bf16_t*)(R + R_AG); bf16_t* TS = (bf16_t*)(R + R_TS); bf16_t* PS = (bf16_t*)(R + R_PS);
                const float* gmix = in_ptr(P, 2) + L * D;
                { LAS bf16_t* ST = (LAS bf16_t*)lds;
                  for (int n = bid; n < 512; n += G) {
                      __syncthreads();
#pragma unroll 1
                      for (int r4 = 0; r4 < 4; ++r4) { const int s = 4 * wid + r4, t = 32 * n + s; f32x4 v[4]; const float rs = load_row(X + (size_t)t * D, lane, v);
#pragma unroll
                          for (int j = 0; j < 4; ++j) { const f32x4 gg = *((const f32x4*)gmix + lane + 64 * j); *(LAS u32x2*)(ST + s * 1032 + 4 * lane + 256 * j) = pack4(v[j] * rs * gg); } }
                      __syncthreads();
#pragma unroll
                      for (int k = 0; k < 8; ++k) { const int i = tid + 512 * k; const int g = i >> 6, s = (i & 63) >> 1, half = i & 1;
                          *(u32x4*)(AG + (size_t)(g * 512 + n) * 640 + s * 16 + half * 8) = *(const LAS u32x4*)(ST + s * 1032 + g * 16 + half * 8); }
                  } }
                const float* a_re = in_ptr(P, 12) + e * 4096; const float* a_im = in_ptr(P, 13) + e * 4096; const float* ldt = in_ptr(P, 14) + e * 64;
                const float* b_re = in_ptr(P, 15) + (size_t)e * 65536; const float* b_im = in_ptr(P, 16) + (size_t)e * 65536; const float* c_re = in_ptr(P, 17) + (size_t)e * 65536; const float* c_im = in_ptr(P, 18) + (size_t)e * 65536;
                LAS float* Wr = (LAS float*)lds; LAS float* Wi = Wr + 512; LAS float* Pr = Wi + 512; LAS float* Pi = Pr + 512; LAS float* Cl = Pi + 512; LAS float* Bl = Cl + 2048;
                for (int it = bid; it < 256; it += G) {
                    const int g = it >> 2, to = it & 3;
                    __syncthreads();
                    { const int tl = tid >> 6, p = tid & 63, tau = 8 * to + tl; const float dt = expf(ldt[g]), lr = a_re[g * 64 + p], li = a_im[g * 64 + p];
                      float s1, c1; sincosf(li * dt, &s1, &c1); const float e1 = expf(lr * dt); const float abr = e1 * c1, abi = e1 * s1;
                      const float den = lr * lr + li * li, nr = abr - 1.0f, ni = abi; const float cr = (nr * lr + ni * li) / den, ci = (ni * lr - nr * li) / den;
                      float sj, cj; sincosf((float)tau * (li * dt), &sj, &cj); const float ej = expf((float)tau * (lr * dt)); const float ajr = ej * cj, aji = ej * sj;
                      Wr[tid] = ajr * cr - aji * ci; Wi[tid] = ajr * ci + aji * cr;
                      float sp, cp; sincosf((float)(tau + 1) * (li * dt), &sp, &cp); const float ep = expf((float)(tau + 1) * (lr * dt)); Pr[tid] = ep * cp; Pi[tid] = ep * sp;
                      const int q4 = (tid & 255) * 4;
                      *(LAS f32x4*)(Cl + (tid >> 8) * 1024 + q4) = *(const f32x4*)((tid < 256 ? c_re : c_im) + (size_t)g * 1024 + q4);
                      *(LAS f32x4*)(Bl + (tid >> 8) * 1024 + q4) = *(const f32x4*)((tid < 256 ? b_re : b_im) + (size_t)g * 1024 + q4); }
                    __syncthreads();
                    { const int tl = tid >> 6, c = (tid >> 2) & 15, cq = tid & 3, tau = 8 * to + tl; f32x4 acc = (f32x4){0.f, 0.f, 0.f, 0.f};
                      for (int p = 0; p < 64; ++p) { const float Cr = Cl[c * 64 + p], Ci = Cl[1024 + c * 64 + p], wr_ = Wr[tl * 64 + p], wi_ = Wi[tl * 64 + p];
                          const float cwr = Cr * wr_ - Ci * wi_, cwi = Cr * wi_ + Ci * wr_; const f32x4 br = *(const LAS f32x4*)(Bl + p * 16 + 4 * cq), bi = *(const LAS f32x4*)(Bl + 1024 + p * 16 + 4 * cq);
                          acc += br * cwr - bi * cwi; }
                      const u32x2 kv = pack4(acc); const u32x2 zz = (u32x2){0u, 0u};
                      for (int s = 0; s + tau < 32; ++s) { *(u32x2*)(TS + (size_t)(g * 512 + (tau + s) * 16 + c) * 640 + s * 16 + 4 * cq) = kv;
                          if (tau >= 1) *(u32x2*)(TS + (size_t)(g * 512 + s * 16 + c) * 640 + (s + tau) * 16 + 4 * cq) = zz; } }
                    { const int tl = tid >> 6, c = (tid >> 2) & 15, part = tid & 3, t = 8 * to + tl;
#pragma unroll 1
                      for (int q4 = 0; q4 < 4; ++q4) { const int rp0 = 32 * part + 8 * q4; float v[8];
#pragma unroll
                          for (int i = 0; i < 8; ++i) { const int p = (rp0 + i) & 63; const float Cr = Cl[c * 64 + p], Ci = Cl[1024 + c * 64 + p], pr = Pr[tl * 64 + p], pi = Pi[tl * 64 + p];
                              v[i] = (rp0 < 64) ? (Cr * pr - Ci * pi) : -(Cr * pi + Ci * pr); }
                          u32x4 o; o.x = cvt_pk_bf16(v[0], v[1]); o.y = cvt_pk_bf16(v[2], v[3]); o.z = cvt_pk_bf16(v[4], v[5]); o.w = cvt_pk_bf16(v[6], v[7]);
                          *(u32x4*)(TS + (size_t)(g * 512 + t * 16 + c) * 640 + 512 + rp0) = o; } }
                    { const int rp = tid >> 2, sq = tid & 3, p = rp & 63;
#pragma unroll 1
                      for (int k = 0; k < 2; ++k) { const int jj = 2 * sq + k, s = 24 - 8 * to + jj, tl = 7 - jj; const float wr_ = Wr[tl * 64 + p], wi_ = Wi[tl * 64 + p]; float v[16];
#pragma unroll
                          for (int i = 0; i < 16; ++i) { const float br = Bl[p * 16 + i], bi = Bl[1024 + p * 16 + i]; v[i] = (rp < 64) ? (wr_ * br - wi_ * bi) : (wr_ * bi + wi_ * br); }
                          u32x4 o0, o1; o0.x = cvt_pk_bf16(v[0], v[1]); o0.y = cvt_pk_bf16(v[2], v[3]); o0.z = cvt_pk_bf16(v[4], v[5]); o0.w = cvt_pk_bf16(v[6], v[7]);
                          o1.x = cvt_pk_bf16(v[8], v[9]); o1.y = cvt_pk_bf16(v[10], v[11]); o1.z = cvt_pk_bf16(v[12], v[13]); o1.w = cvt_pk_bf16(v[14], v[15]);
                          bf16_t* pr_ = PS + (size_t)(g * 256 + rp) * 512 + s * 16; *(u32x4*)pr_ = o0; *(u32x4*)(pr_ + 8) = o1;
                          const u32x4 z4 = (u32x4){0u, 0u, 0u, 0u}; bf16_t* pz = PS + (size_t)(g * 256 + 128 + rp) * 512 + s * 16; *(u32x4*)pz = z4; *(u32x4*)(pz + 8) = z4; } }
                }
            }
            GSYNC();
            STAMP(4);
            for (int rep_ = 0; rep_ < 1 + (int)((REPMASK >> 7) & 1u); ++rep_) { PHASE_IDS
                pg8::Gemm g{(const bf16_t*)(R + R_AG), (const bf16_t*)(R + R_PS), 512, 640, 256};
                pg8::OrderS5E so{G, bid};
                pg8::EpiE E{(float*)(R + R_E)};
                pg8::gemm_phase(lds, g, so, E, wid);
            }
            GSYNC();
            STAMP(5);
            for (int rep_ = 0; rep_ < 1 + (int)((REPMASK >> 8) & 1u); ++rep_) { PHASE_IDS
                bf16_t* AG = (bf16_t*)(R + R_AG); const float* Eb = (const float*)(R + R_E);
                const float* a_re = in_ptr(P, 12) + e * 4096; const float* a_im = in_ptr(P, 13) + e * 4096; const float* ldt = in_ptr(P, 14) + e * 64;
                LAS float* Tr = (LAS float*)lds; LAS float* Ti = Tr + 512;
                for (int it = bid; it < 256; it += G) {
                    const int g = it >> 2, q = it & 3, pl = lane & 15, p = 16 * q + pl, seg = wid * 4 + (lane >> 4);
                    const float dt = expf(ldt[g]), lr = a_re[g * 64 + p], li = a_im[g * 64 + p];
                    float sA, cA; sincosf(32.f * (li * dt), &sA, &cA); const float eA = expf(32.f * (lr * dt)); const float ar = eA * cA, ai = eA * sA;
                    float sB, cB; sincosf(512.f * (li * dt), &sB, &cB); const float eB = expf(512.f * (lr * dt)); const float br = eB * cB, bi = eB * sB;
                    const float* ep = Eb + (size_t)(g * 512 + 16 * seg) * 128 + p;
                    float er[16], ei[16];
#pragma unroll
                    for (int k = 0; k < 16; ++k) { er[k] = ep[(size_t)k * 128]; ei[k] = ep[(size_t)k * 128 + 64]; }
                    float xr = 0.f, xi = 0.f;
#pragma unroll
                    for (int k = 0; k < 16; ++k) { const float nr = ar * xr - ai * xi + er[k], ni = ar * xi + ai * xr + ei[k]; xr = nr; xi = ni; }
                    __syncthreads();
                    Tr[seg * 16 + pl] = xr; Ti[seg * 16 + pl] = xi;
                    __syncthreads();
                    xr = 0.f; xi = 0.f;
                    for (int s2 = 0; s2 < seg; ++s2) { const float nr = br * xr - bi * xi + Tr[s2 * 16 + pl], ni = br * xi + bi * xr + Ti[s2 * 16 + pl]; xr = nr; xi = ni; }
                    bf16_t* sp = AG + (size_t)(g * 512 + 16 * seg) * 640 + 512 + p;
#pragma unroll
                    for (int k = 0; k < 16; ++k) { sp[(size_t)k * 640] = (bf16_t)(cvt_pk_bf16(xr, 0.f) & 0xffffu); sp[(size_t)k * 640 + 64] = (bf16_t)(cvt_pk_bf16(xi, 0.f) & 0xffffu);
                        const float nr = ar * xr - ai * xi + er[k], ni = ar * xi + ai * xr + ei[k]; xr = nr; xi = ni; }
                }
            }
            GSYNC();
            STAMP(5);
            for (int rep_ = 0; rep_ < 1 + (int)((REPMASK >> 9) & 1u); ++rep_) { PHASE_IDS
                pg8::Gemm g{(const bf16_t*)(R + R_AG), (const bf16_t*)(R + R_TS), 640, 640, 256};
                pg8::OrderS5Y so{G, bid};
                pg8::EpiY E{(const bf16_t*)(R + R_AG), in_ptr(P, 19) + e * D, (bf16_t*)(R + R_G)};
                pg8::gemm_phase(lds, g, so, E, wid);
            }
            GSYNC();
            STAMP(5);
            for (int rep_ = 0; rep_ < 1 + (int)((REPMASK >> 10) & 1u); ++rep_) { PHASE_IDS
            { const float* pin = in_ptr(P, 1) + (size_t)L * S * 256; bf16_t* PB = (bf16_t*)(R + R_PB);
              for (int t = gw; t < S; t += NGW) { const f32x4 pv = *((const f32x4*)(pin + (size_t)t * 256) + lane); *((u32x2*)(PB + (size_t)t * 256) + lane) = pack4(pv); } }
                pg8::Gemm g{(const bf16_t*)(R + R_G), (const bf16_t*)(ws + WS_WGLU) + (size_t)e * 2048 * 1024, 1024, 1024, 256};
                pg8::StaticOrder so; so.init(64, 8, G, bid);
                pg8::EpiGlu E{X, HN, (float*)(ws + WS_SS), (LAS float*)(lds + XL_OFF + 8448)};
                pg8::gemm_phase(lds, g, so, E, wid);
            }
            GSYNC();
            STAMP(5);
        }
        for (int rep_ = 0; rep_ < 1 + (int)((REPMASK >> 12) & 1u); ++rep_) { PHASE_IDS
            pg8::Gemm g{HNA, (const bf16_t*)(ws + WS_WUP) + (size_t)L * 5632 * 1024, 1024, 1024, 254};
            pg8::StaticOrder so; so.init(65, 22, G, bid);
            pg8::EpiConv E{(bf16_t*)(R + R_ACT), in_ptr(P, 22) + (size_t)L * 3 * 5632, in_ptr(P, 23) + (size_t)L * 5632, lds + XL_OFF, (const float*)(ws + WS_SS), (L & 1) ? 8 : 4};
            pg8::gemm_phase(lds, g, so, E, wid);
        }
        GSYNC();
        STAMP(6);
        for (int rep_ = 0; rep_ < 1 + (int)((REPMASK >> 13) & 1u); ++rep_) { PHASE_IDS
            pg8::Gemm g{(const bf16_t*)(R + R_ACT), (const bf16_t*)(ws + WS_WDN) + (size_t)L * 1024 * 2816, 2816, 2816, 256};
            pg8::StaticOrder so; so.init(64, 4, G, bid);
            pg8::EpiRes E{X, HN, (float*)(ws + WS_SS) + (size_t)S * 8, (LAS float*)(lds + XL_OFF + 8448)};
            pg8::gemm_phase(lds, g, so, E, wid);
        }
        GSYNC();
        STAMP(7);
        for (int rep_ = 0; rep_ < 1 + (int)((REPMASK >> 15) & 1u); ++rep_) { PHASE_IDS
            pg8::StaticOrder so; so.init(64, 4, G, bid);
            { pg8::Gemm g{(const bf16_t*)(R + R_PB), (const bf16_t*)(ws + WS_WPR) + (size_t)L * 1024 * 256, 256, 256, 256};
              pg8::EpiStore E{(bf16_t*)(R + R_PP), D, 0};
              pg8::gemm_phase(lds, g, so, E, wid); }
            asm volatile("s_waitcnt vmcnt(0)" ::: "memory"); __syncthreads();
            { pg8::Gemm g{HN, (const bf16_t*)(ws + WS_WGT) + (size_t)L * 1024 * 1024, 1024, 1024, 256};
              pg8::EpiGate E{X, (const bf16_t*)(R + R_PP), (const float*)(ws + WS_SS) + (size_t)S * 8};
              pg8::gemm_phase(lds, g, so, E, wid); }
        }
        GSYNC();
        STAMP(8);
        for (int xs = 0; xs < XSYNC; ++xs) GSYNC();
    }
#ifdef PROBE_SEL
    if (bid == 0) { __syncthreads(); float tot = 0.f; for (int i = 0; i < 16; ++i) tot += tacc[i];
        const float f = (PROBE_SEL < 0) ? 1.f : tacc[PROBE_SEL < 0 ? 0 : PROBE_SEL] / tot;
        for (int i = threadIdx.x; i < 524288; i += 512) X[i] += 0.2f * f; }
#endif
}

extern "C" void kernel_launch(void* const* d_in, const int* in_sizes, int n_in, void* d_out, int out_size, void* d_ws, size_t ws_size, hipStream_t stream) {
    static int grid = 0;
    if (grid == 0) {
        if (n_in != 27 || out_size != S * D || ws_size < WS_END) { fprintf(stderr, "kernel_launch: unexpected shapes (n_in %d out %d ws %zu need %zu)\n", n_in, out_size, ws_size, (size_t)WS_END); grid = -1; return; }
        int dev = 0, cus = 0, per_cu = 0;
        hipGetDevice(&dev); hipDeviceGetAttribute(&cus, hipDeviceAttributeMultiprocessorCount, dev);
        hipFuncSetAttribute((const void*)mega, hipFuncAttributeMaxDynamicSharedMemorySize, LDS_BYTES);
        hipOccupancyMaxActiveBlocksPerMultiprocessor(&per_cu, (const void*)mega, 512, LDS_BYTES);
        if (per_cu < 1) per_cu = 1;
        grid = cus * per_cu;
    }
    if (grid < 0) return;
    Params p{};
    for (int i = 0; i < 27; ++i) p.in[i] = (const float*)d_in[i];
    p.out = (float*)d_out; p.ws = (unsigned char*)d_ws;
    hipMemsetAsync((char*)d_ws + WS_BAR, 0, ZERO_BYTES, stream);
    void* args[] = {&p};
    hipError_t err = hipLaunchCooperativeKernel((const void*)mega, dim3(grid), dim3(512), args, LDS_BYTES, stream);
    if (err != hipSuccess) fprintf(stderr, "cooperative launch failed: %s (grid %d)\n", hipGetErrorString(err), grid);
}
```

```cpp
#include <hip/hip_runtime.h>
#include <hip/hip_cooperative_groups.h>
#include <cstdio>
#include <cstdint>
namespace cg = cooperative_groups;

#define LAS __attribute__((address_space(3)))
typedef unsigned short bf16_t;
typedef short bf16x8 __attribute__((ext_vector_type(8)));
typedef float f32x4 __attribute__((ext_vector_type(4)));
typedef unsigned u32x4 __attribute__((ext_vector_type(4)));
typedef unsigned u32x2 __attribute__((ext_vector_type(2)));

constexpr int S = 16384, D = 1024, FF = 2816, ZW = 2560;
constexpr float EPS = 1e-6f;
constexpr float LOG2E = 1.4426950408889634f;

__device__ __forceinline__ float zero_f() { float z; asm volatile("v_mov_b32 %0, 0" : "=v"(z)); return z; }
__device__ __forceinline__ unsigned cvt_pk_bf16(float lo, float hi) { unsigned r; asm volatile("v_cvt_pk_bf16_f32 %0, %1, %2" : "=v"(r) : "v"(lo), "v"(hi)); return r; }
__device__ __forceinline__ float bf2f(unsigned b) { return __uint_as_float(b << 16); }
__device__ __forceinline__ float sigm(float z) { return __builtin_amdgcn_rcpf(1.f + __builtin_amdgcn_exp2f(-LOG2E * z)); }
__device__ __forceinline__ float gelu_t(float x) { const float z = 1.5957691216057308f * (x + 0.044715f * x * x * x); return x * sigm(z); }
__device__ __forceinline__ u32x2 pack4(f32x4 v) { u32x2 w; w.x = cvt_pk_bf16(v[0], v[1]); w.y = cvt_pk_bf16(v[2], v[3]); return w; }
__device__ __forceinline__ f32x4 unpack4(u32x2 w) { return (f32x4){bf2f(w.x & 0xffffu), bf2f(w.x >> 16), bf2f(w.y & 0xffffu), bf2f(w.y >> 16)}; }
#define DPPF(v, ctrl) __int_as_float(__builtin_amdgcn_mov_dpp(__float_as_int(v), (ctrl), 0xf, 0xf, true))
__device__ __forceinline__ float x1_sum(float v) { return v + DPPF(v, 0xB1); }
__device__ __forceinline__ float x2_sum(float v) { v += DPPF(v, 0xB1); return v + DPPF(v, 0x4E); }
__device__ __forceinline__ float x3_sum(float v) { v = x2_sum(v); return v + DPPF(v, 0x141); }
__device__ __forceinline__ float row_sum(float v) { v = x3_sum(v); return v + DPPF(v, 0x140); }
__device__ __forceinline__ float row_max(float v) { v = fmaxf(v, DPPF(v, 0xB1)); v = fmaxf(v, DPPF(v, 0x4E)); v = fmaxf(v, DPPF(v, 0x141)); return fmaxf(v, DPPF(v, 0x140)); }
__device__ __forceinline__ float max3f(float a, float b, float c) { float r; asm("v_max3_f32 %0, %1, %2, %3" : "=v"(r) : "v"(a), "v"(b), "v"(c)); return r; }
__device__ __forceinline__ float quad_max(float v) {
    auto a = __builtin_amdgcn_permlane16_swap(__float_as_uint(v), __float_as_uint(v), false, false); v = fmaxf(__uint_as_float(a[0]), __uint_as_float(a[1]));
    auto b = __builtin_amdgcn_permlane32_swap(__float_as_uint(v), __float_as_uint(v), false, false); return fmaxf(__uint_as_float(b[0]), __uint_as_float(b[1]));
}
__device__ __forceinline__ float quad_sum(float v) {
    auto a = __builtin_amdgcn_permlane16_swap(__float_as_uint(v), __float_as_uint(v), false, false); v = __uint_as_float(a[0]) + __uint_as_float(a[1]);
    auto b = __builtin_amdgcn_permlane32_swap(__float_as_uint(v), __float_as_uint(v), false, false); return __uint_as_float(b[0]) + __uint_as_float(b[1]);
}
__device__ __forceinline__ float wave_min(float v) { return -quad_max(row_max(-v)); }
__device__ __forceinline__ float wave_sum(float v) { return quad_sum(row_sum(v)); }
__device__ __forceinline__ float wave_max(float v) { return quad_max(row_max(v)); }

namespace pg8 {
constexpr int BM = 256, BK = 64, HALF = 128, HTB = HALF * BK * 2, STAGE_BYTES = 8 * HTB, NXCD = 8, WGM = 4;
__host__ __device__ __forceinline__ int lds_byte(int r, int c) { const int st = (r >> 4) * 2 + (c >> 5), rr = r & 15, cc = c & 31, ob = rr * 64 + cc * 2; return st * 1024 + (ob ^ (((ob >> 9) & 1) << 5)); }
__host__ __device__ __forceinline__ void stage_rc(int b, int& R, int& C) { const int st = b / 1024, sb = b % 1024, swz = sb ^ (((sb >> 9) & 1) << 5); R = (st >> 1) * 16 + swz / 64; C = (st & 1) * 32 + (swz % 64) / 2; }
__host__ __device__ __forceinline__ int perm32(int rho) { const int n = rho >> 4, i = rho & 15; return 8 * (i >> 2) + 4 * n + (i & 3); }
struct Unit { int pm, pn; };
struct Gemm { const bf16_t* A; const bf16_t* Bt; int K, lda, arows; };

struct StaticOrder {
    int nM, nN, nwg, G, c;
    __device__ void init(int nM_, int nN_, int G_, int c_) { nM = nM_; nN = nN_; nwg = nM * nN; G = G_; c = c_; }
    __device__ bool next(int i, Unit& u) const {
        const long L = (long)i * G + c; if (L >= nwg) return false;
        int wgid = (int)L; { const int q = nwg / NXCD, r = nwg % NXCD, xcd = wgid % NXCD, off = wgid / NXCD; wgid = (xcd < r ? xcd * (q + 1) : r * (q + 1) + (xcd - r) * q) + off; }
        const int nig = WGM * nN, gid = wgid / nig, fm = gid * WGM, gsz = (nM - fm) < WGM ? (nM - fm) : WGM;
        u.pm = fm + ((wgid % nig) % gsz); u.pn = (wgid % nig) / gsz; return true;
    }
};
struct OrderSpare {
    int G, c, r; __device__ void init(int G_, int c_, int nprev) { G = G_; c = c_; r = nprev % G_; }
    __device__ bool next(int i, Unit& u) const { const int w = r ? c - r : c, nsp = r ? G - r : G; if (w < 0) return false; const int L = w + nsp * i; if (L >= 256) return false; u.pm = L >> 2; u.pn = L & 3; return true; }
};
struct OrderS5E { int G, c; __device__ bool next(int i, Unit& u) const { const int L = i * G + c; if (L >= 128) return false; u.pm = L; u.pn = L >> 1; return true; } };
struct OrderS5Y { int G, c; __device__ bool next(int i, Unit& u) const { const int L = i * G + c; if (L >= 256) return false; const int g = L >> 2; u.pm = 2 * g + ((L >> 1) & 1); u.pn = 2 * g + (L & 1); return true; } };

template <class Epi, class Sched>
__device__ __forceinline__ void gemm_phase(LAS unsigned char* lds, const Gemm g, const Sched& S, const Epi& E, int wid_) {
    int lane_; asm volatile("v_mbcnt_lo_u32_b32 %0, -1, 0\n\tv_mbcnt_hi_u32_b32 %0, -1, %0" : "=v"(lane_));
    const int wid = __builtin_amdgcn_readfirstlane(wid_), lane = lane_, tid = wid * 64 + lane, wr = wid >> 2, wc = wid & 3, fr = lane & 15, fq = lane >> 4;
    const int K = g.K, nt = K / BK, lda = g.lda;
    unsigned voffA[2], voffB[2];
#pragma unroll
    for (int i = 0; i < 2; ++i) { int R, C; stage_rc(tid * 16 + i * 8192, R, C); const int Rb = Epi::PERM ? ((R & ~31) + perm32(R & 31)) : R; voffA[i] = (unsigned)(R * lda + C) * 2u; voffB[i] = (unsigned)(Rb * K + C) * 2u; }
    const size_t kstep = (size_t)(BK * 2);
    const size_t hstepA = (size_t)HALF * lda * 2, hstepB = (size_t)HALF * K * 2;
    const size_t tstepA = (size_t)g.arows * lda * 2, tstepB = 2 * hstepB;
    const unsigned ldsw = (unsigned)wid * 1024u;
    const int aoff = lds_byte(wr * 64 + fr, fq * 8), boff = lds_byte(wc * 32 + fr, fq * 8);
#define PG8_SA(b, h) (((b) * 2 + (h)) * HTB)
#define PG8_SB(b, h) ((4 + (b) * 2 + (h)) * HTB)
#define PG8_STAGE(bufoff, gbase, voff) do { _Pragma("unroll") for (int _i = 0; _i < 2; ++_i) \
        __builtin_amdgcn_global_load_lds((const unsigned*)((const char*)(gbase) + (voff)[_i]), (LAS unsigned*)(lds + (bufoff) + ldsw + _i * 8192), 16, 0, 0); } while (0)
#define PG8_LDA(dst, b, h) do { _Pragma("unroll") for (int m = 0; m < 4; ++m) _Pragma("unroll") for (int k = 0; k < 2; ++k) dst[m][k] = *(const LAS bf16x8*)(lds + PG8_SA(b, h) + aoff + m * 2048 + k * 1024); } while (0)
#define PG8_LDB(dst, b, h) do { _Pragma("unroll") for (int n = 0; n < 2; ++n) _Pragma("unroll") for (int k = 0; k < 2; ++k) dst[n][k] = *(const LAS bf16x8*)(lds + PG8_SB(b, h) + boff + n * 2048 + k * 1024); } while (0)
#define PG8_MMA(ai, bj, At, Bt) do { __builtin_amdgcn_s_setprio(1); _Pragma("unroll") for (int m = 0; m < 4; ++m) _Pragma("unroll") for (int n = 0; n < 2; ++n) _Pragma("unroll") for (int k = 0; k < 2; ++k) \
        acc[ai][bj][m][n] = __builtin_amdgcn_mfma_f32_16x16x32_bf16(Bt[n][k], At[m][k], acc[ai][bj][m][n], 0, 0, 0); __builtin_amdgcn_s_setprio(0); } while (0)
#define PG8_WAIT_V(n) asm volatile("s_waitcnt vmcnt(" #n ")" ::: "memory")
#define PG8_WAIT_L(n) asm volatile("s_waitcnt lgkmcnt(" #n ")" ::: "memory")
#define PG8_BAR __builtin_amdgcn_s_barrier()
#define PG8_SCHED __builtin_amdgcn_sched_barrier(0)
    Unit cur, nxt; int ui = 0;
    if (!S.next(0, cur)) return;
    f32x4 acc[2][2][4][2];
    float zr_; asm volatile("v_mov_b32 %0, 0" : "=v"(zr_));
#pragma unroll
    for (int a = 0; a < 2; ++a)
#pragma unroll
        for (int b = 0; b < 2; ++b)
#pragma unroll
            for (int m = 0; m < 4; ++m)
#pragma unroll
                for (int n = 0; n < 2; ++n) acc[a][b][m][n] = (f32x4){zr_, zr_, zr_, zr_};
    bf16x8 At[4][2], B0[2][2], B1[2][2];
    const char* cA = (const char*)g.A + (size_t)cur.pm * tstepA; const char* cB = (const char*)g.Bt + (size_t)cur.pn * tstepB;
    PG8_STAGE(PG8_SB(0, 0), cB, voffB); PG8_STAGE(PG8_SB(0, 1), cB + hstepB, voffB); PG8_STAGE(PG8_SA(0, 0), cA, voffA); PG8_STAGE(PG8_SA(0, 1), cA + hstepA, voffA);
    if (wr == 1) PG8_BAR;
    PG8_WAIT_V(2); PG8_BAR;
    PG8_STAGE(PG8_SB(1, 0), cB + kstep, voffB); PG8_STAGE(PG8_SA(1, 0), cA + kstep, voffA); PG8_STAGE(PG8_SB(1, 1), cB + hstepB + kstep, voffB);
    PG8_WAIT_V(6); PG8_BAR;
    for (;;) {
        const bool has_next = S.next(ui + 1, nxt);
        const char* nA = has_next ? (const char*)g.A + (size_t)nxt.pm * tstepA : cA; const char* nB = has_next ? (const char*)g.Bt + (size_t)nxt.pn * tstepB : cB;
        for (int t = 0; t < nt; t += 2) {
            const bool last = (t == nt - 2);
            const char* a1 = cA + (size_t)(t + 1) * kstep;
            const char* a2 = last ? nA : cA + (size_t)(t + 2) * kstep; const char* b2 = last ? nB : cB + (size_t)(t + 2) * kstep;
            const char* a3 = a2 + kstep; const char* b3 = b2 + kstep;
            PG8_LDB(B0, 0, 0); PG8_LDB(B1, 0, 1); PG8_SCHED; PG8_LDA(At, 0, 0); PG8_STAGE(PG8_SA(1, 1), a1 + hstepA, voffA);
            PG8_WAIT_V(8); PG8_WAIT_L(0); PG8_BAR; PG8_MMA(0, 0, At, B0); PG8_MMA(0, 1, At, B1); PG8_BAR; PG8_SCHED;
            PG8_LDA(At, 0, 1); PG8_STAGE(PG8_SB(0, 0), b2, voffB); PG8_STAGE(PG8_SB(0, 1), b2 + hstepB, voffB); PG8_STAGE(PG8_SA(0, 0), a2, voffA);
            PG8_WAIT_V(8); PG8_WAIT_L(0); PG8_BAR; PG8_MMA(1, 0, At, B0); PG8_MMA(1, 1, At, B1); PG8_BAR; PG8_SCHED;
            PG8_LDB(B0, 1, 0); PG8_LDB(B1, 1, 1); PG8_SCHED; PG8_LDA(At, 1, 0); PG8_STAGE(PG8_SA(0, 1), a2 + hstepA, voffA);
            PG8_WAIT_V(8); PG8_WAIT_L(0); PG8_BAR; PG8_MMA(0, 0, At, B0); PG8_MMA(0, 1, At, B1); PG8_BAR; PG8_SCHED;
            PG8_LDA(At, 1, 1); PG8_STAGE(PG8_SB(1, 0), b3, voffB); PG8_STAGE(PG8_SB(1, 1), b3 + hstepB, voffB); PG8_STAGE(PG8_SA(1, 0), a3, voffA);
            PG8_WAIT_V(8); PG8_WAIT_L(0); PG8_BAR; PG8_MMA(1, 0, At, B0); PG8_MMA(1, 1, At, B1); PG8_BAR; PG8_SCHED;
        }
        if (wr == 0) PG8_BAR;
        E(acc, cur, wr, wc, fr, fq);
        if (!has_next) break;
        asm volatile("v_mov_b32 %0, 0" : "=v"(zr_));
#pragma unroll
        for (int a = 0; a < 2; ++a)
#pragma unroll
            for (int b = 0; b < 2; ++b)
#pragma unroll
                for (int m = 0; m < 4; ++m)
#pragma unroll
                    for (int n = 0; n < 2; ++n) acc[a][b][m][n] = (f32x4){zr_, zr_, zr_, zr_};
        cur = nxt; cA = nA; cB = nB; ++ui;
        if (wr == 1) PG8_BAR;
    }
    PG8_WAIT_V(0);
    PG8_BAR;
#undef PG8_SA
#undef PG8_SB
#undef PG8_STAGE
#undef PG8_LDA
#undef PG8_LDB
#undef PG8_MMA
#undef PG8_WAIT_V
#undef PG8_WAIT_L
#undef PG8_BAR
#undef PG8_SCHED
}

typedef f32x4 Acc[2][2][4][2];
__device__ __forceinline__ float row_rs(const float* SSP, int row, int nsl) {
    const f32x4 a = *(const f32x4*)(SSP + (size_t)row * 8); float s = (a[0] + a[1]) + (a[2] + a[3]);
    if (nsl == 8) { const f32x4 b = *(const f32x4*)(SSP + (size_t)row * 8 + 4); s += (b[0] + b[1]) + (b[2] + b[3]); }
    return __builtin_amdgcn_rsqf(s * (1.f / D) + EPS);
}
__device__ __forceinline__ void ss_publish(LAS float* ssl, float* SSP, int row0, int slot, int wr, int wc, int fr, int fq) {
    asm volatile("s_waitcnt lgkmcnt(0)" ::: "memory"); __builtin_amdgcn_s_barrier(); asm volatile("" ::: "memory");
    const int t = (wr * 4 + wc) * 64 + fq * 16 + fr;
    if (t < 256) SSP[(size_t)(row0 + t) * 8 + slot] = (ssl[t] + ssl[256 + t]) + (ssl[512 + t] + ssl[768 + t]);
}
struct EpiRes {
    static constexpr bool PERM = true;
    float* X_; bf16_t* XB_; float* SS; LAS float* ssl;
    __device__ __forceinline__ void operator()(Acc& acc, const Unit& u, int wr, int wc, int fr, int fq) const {
        float* __restrict__ X = X_; bf16_t* __restrict__ XB = XB_;
#pragma unroll
        for (int ai = 0; ai < 2; ++ai)
#pragma unroll
            for (int m = 0; m < 4; ++m) { const int rl = ai * 128 + wr * 64 + m * 16 + fr, row = u.pm * 256 + rl; const size_t off = (size_t)row * D + u.pn * 256 + wc * 32 + 8 * fq; float ssum = 0.f;
#pragma unroll
                for (int bj = 0; bj < 2; ++bj) { f32x4* q = (f32x4*)(X + off + bj * 128); const f32x4 x0 = q[0] + acc[ai][bj][m][0], x1 = q[1] + acc[ai][bj][m][1]; q[0] = x0; q[1] = x1;
                    const u32x2 p0 = pack4(x0), p1 = pack4(x1); *(u32x4*)(XB + off + bj * 128) = (u32x4){p0.x, p0.y, p1.x, p1.y};
                    ssum += ((x0[0] * x0[0] + x0[1] * x0[1]) + (x0[2] * x0[2] + x0[3] * x0[3])) + ((x1[0] * x1[0] + x1[1] * x1[1]) + (x1[2] * x1[2] + x1[3] * x1[3])); }
                ssum = quad_sum(ssum); if (fq == 0) ssl[wc * 256 + rl] = ssum; }
        ss_publish(ssl, SS, u.pm * 256, u.pn, wr, wc, fr, fq);
    }
};
struct EpiStore {
    static constexpr bool PERM = true;
    bf16_t* O; int ld; int mode;
    __device__ __forceinline__ void operator()(Acc& acc, const Unit& u, int wr, int wc, int fr, int fq) const {
        const bool act = mode == 1 && (u.pn < 2 || u.pn == 4 || u.pn == 5);
#pragma unroll
        for (int ai = 0; ai < 2; ++ai)
#pragma unroll
            for (int m = 0; m < 4; ++m) { bf16_t* rp = O + (size_t)(u.pm * 256 + ai * 128 + wr * 64 + m * 16 + fr) * ld + u.pn * 256 + wc * 32 + 8 * fq;
#pragma unroll
                for (int bj = 0; bj < 2; ++bj) { f32x4 v0 = acc[ai][bj][m][0], v1 = acc[ai][bj][m][1];
                    if (act) { v0[0] = gelu_t(v0[0]); v0[1] = gelu_t(v0[1]); v0[2] = gelu_t(v0[2]); v0[3] = gelu_t(v0[3]); v1[0] = gelu_t(v1[0]); v1[1] = gelu_t(v1[1]); v1[2] = gelu_t(v1[2]); v1[3] = gelu_t(v1[3]); }
                    const u32x2 p0 = pack4(v0), p1 = pack4(v1); *(u32x4*)(rp + bj * 128) = (u32x4){p0.x, p0.y, p1.x, p1.y}; } }
    }
};
struct EpiGate {
    static constexpr bool PERM = true;
    float* X_; const bf16_t* PP_; const float* SS_;
    __device__ __forceinline__ void operator()(Acc& acc, const Unit& u, int wr, int wc, int fr, int fq) const {
        float* __restrict__ X = X_; const bf16_t* __restrict__ PP = PP_; const float* __restrict__ SS = SS_;
#pragma unroll
        for (int ai = 0; ai < 2; ++ai)
#pragma unroll
            for (int m = 0; m < 4; ++m) { const int row = u.pm * 256 + ai * 128 + wr * 64 + m * 16 + fr; const float rs = row_rs(SS, row, 4); const size_t off = (size_t)row * D + u.pn * 256 + wc * 32 + 8 * fq;
#pragma unroll
                for (int bj = 0; bj < 2; ++bj) { const u32x4 pw = *(const u32x4*)(PP + off + bj * 128); f32x4* q = (f32x4*)(X + off + bj * 128);
#pragma unroll
                    for (int n = 0; n < 2; ++n) { const f32x4 a = acc[ai][bj][m][n] * rs; const f32x4 pp = unpack4(n == 0 ? (u32x2){pw.x, pw.y} : (u32x2){pw.z, pw.w}); f32x4 x = q[n];
                        x[0] += sigm(a[0]) * pp[0]; x[1] += sigm(a[1]) * pp[1]; x[2] += sigm(a[2]) * pp[2]; x[3] += sigm(a[3]) * pp[3]; q[n] = x; } } }
    }
};
struct EpiGlu {
    static constexpr bool PERM = true;
    float* X_; bf16_t* XB_; float* SS; LAS float* ssl;
    __device__ __forceinline__ void operator()(Acc& acc, const Unit& u, int wr, int wc, int fr, int fq) const {
        float* __restrict__ X = X_; bf16_t* __restrict__ XB = XB_;
#pragma unroll
        for (int ai = 0; ai < 2; ++ai)
#pragma unroll
            for (int m = 0; m < 4; ++m) { const int rl = ai * 128 + wr * 64 + m * 16 + fr, row = u.pm * 256 + rl; const size_t off = (size_t)row * D + u.pn * 128 + wc * 32 + 8 * fq; float ssum = 0.f;
                f32x4* q = (f32x4*)(X + off); f32x4 xs[2];
#pragma unroll
                for (int n = 0; n < 2; ++n) { const f32x4 a = acc[ai][0][m][n], b = acc[ai][1][m][n]; f32x4 x = q[n];
                    x[0] += a[0] * sigm(b[0]); x[1] += a[1] * sigm(b[1]); x[2] += a[2] * sigm(b[2]); x[3] += a[3] * sigm(b[3]); q[n] = x; xs[n] = x;
                    ssum += (x[0] * x[0] + x[1] * x[1]) + (x[2] * x[2] + x[3] * x[3]); }
                { const u32x2 p0 = pack4(xs[0]), p1 = pack4(xs[1]); *(u32x4*)(XB + off) = (u32x4){p0.x, p0.y, p1.x, p1.y}; }
                ssum = quad_sum(ssum); if (fq == 0) ssl[wc * 256 + rl] = ssum; }
        ss_publish(ssl, SS, u.pm * 256, u.pn, wr, wc, fr, fq);
    }
};
struct EpiE {
    static constexpr bool PERM = false;
    float* Eo;
    __device__ __forceinline__ void operator()(Acc& acc, const Unit& u, int wr, int wc, int fr, int fq) const {
#pragma unroll
        for (int ai = 0; ai < 2; ++ai)
#pragma unroll
            for (int m = 0; m < 4; ++m) { float* rp = Eo + (size_t)(u.pm * 256 + ai * 128 + wr * 64 + m * 16 + fr) * 128 + wc * 32 + 4 * fq;
#pragma unroll
                for (int n = 0; n < 2; ++n) *(f32x4*)(rp + n * 16) = acc[ai][0][m][n]; }
    }
};
struct EpiY {
    static constexpr bool PERM = false;
    const bf16_t* AG_; const float* Dv; bf16_t* Gm_;
    __device__ __forceinline__ void operator()(Acc& acc, const Unit& u, int wr, int wc, int fr, int fq) const {
        const bf16_t* __restrict__ AG = AG_; bf16_t* __restrict__ Gm = Gm_;
        const int g = u.pm >> 1, jj = u.pn & 1; const f32x4 d4 = *(const f32x4*)(Dv + g * 16 + 4 * fq);
#pragma unroll
        for (int ai = 0; ai < 2; ++ai)
#pragma unroll
            for (int m = 0; m < 4; ++m) { const int rowA = u.pm * 256 + ai * 128 + wr * 64 + m * 16 + fr; const int nchunk = rowA - g * 512;
#pragma unroll
                for (int bj = 0; bj < 2; ++bj)
#pragma unroll
                    for (int n = 0; n < 2; ++n) { const int sp = 16 * jj + 8 * bj + 2 * wc + n; const int t = nchunk * 32 + sp;
                        const f32x4 uu = unpack4(*(const u32x2*)(AG + (size_t)rowA * 640 + sp * 16 + 4 * fq));
                        f32x4 y = acc[ai][bj][m][n] + d4 * uu; y[0] = gelu_t(y[0]); y[1] = gelu_t(y[1]); y[2] = gelu_t(y[2]); y[3] = gelu_t(y[3]);
                        *(u32x2*)(Gm + (size_t)t * D + g * 16 + 4 * fq) = pack4(y); } }
    }
};
__device__ __forceinline__ float dpp_ror1(float v) { return __int_as_float(__builtin_amdgcn_mov_dpp(__float_as_int(v), 0x121, 0xf, 0xf, true)); }
__device__ __forceinline__ float dpp_ror2(float v) { return __int_as_float(__builtin_amdgcn_mov_dpp(__float_as_int(v), 0x122, 0xf, 0xf, true)); }
struct EpiConv {
    static constexpr bool PERM = false;
    bf16_t* ACT; const float* cw; const float* cb; LAS unsigned char* xl; const float* SS; int nsl;
    __device__ __forceinline__ float rsg(int gr) const { return (gr >= 0 && gr < S) ? row_rs(SS, gr, nsl) : 0.f; }
    __device__ __forceinline__ void operator()(Acc& acc, const Unit& u, int wr, int wc, int fr, int fq) const {
        LAS f32x4* xb = (LAS f32x4*)xl + (wr * 128 + wc * 8 + fq * 2 + (fr - 14)); asm volatile("" : "+v"(xb));
        LAS float* wl = (LAS float*)(xl + 8448) + (32 * wc + 4 * fq); asm volatile("" : "+v"(wl));
        LAS float* rl = (LAS float*)(xl + 12544) + (64 * wr + fr); asm volatile("" : "+v"(rl));
        { const int t = (wr * 4 + wc) * 64 + fq * 16 + fr; if (t < 256) { ((LAS float*)(xl + 12544))[t] = rsg(254 * u.pm - 2 + t);
              const int k = t >> 5, c4 = (t & 31) * 4, kk = k & 3; const float* srcp = (kk == 3 ? cb : cw + kk * 2 * FF) + (k >> 2) * FF + 128 * u.pn + c4;
              *(LAS f32x4*)((LAS float*)(xl + 8448) + k * 128 + c4) = *(const f32x4*)srcp; } }
        if (fr >= 14) {
#pragma unroll
            for (int ai = 0; ai < 2; ++ai) {
                if (2 * ai + wr <= 2) { const float rs = rsg(254 * u.pm - 2 + 128 * ai + 64 * wr + 48 + fr);
#pragma unroll
                    for (int bj = 0; bj < 2; ++bj)
#pragma unroll
                        for (int n = 0; n < 2; ++n) xb[256 * ai + 64 * bj + 32 * n] = acc[ai][bj][3][n] * rs; } }
        }
        asm volatile("s_waitcnt lgkmcnt(0)" ::: "memory"); __builtin_amdgcn_s_barrier(); asm volatile("" ::: "memory");
        int frl = fr; asm volatile("" : "+v"(frl));
        bf16_t* ab = ACT + (size_t)(254 * u.pm - 2 + 64 * wr + frl) * FF + 128 * u.pn + 32 * wc + 4 * fq;
#pragma unroll
        for (int ai = 0; ai < 2; ++ai) { const int s = 2 * ai + wr;
#pragma unroll
            for (int n = 0; n < 2; ++n) {
                asm volatile("" ::: "memory");
                const f32x4 wg0 = *(const LAS f32x4*)(wl + 16 * n), wg1 = *(const LAS f32x4*)(wl + 128 + 16 * n), wg2 = *(const LAS f32x4*)(wl + 256 + 16 * n), bg = *(const LAS f32x4*)(wl + 384 + 16 * n);
                const f32x4 wu0 = *(const LAS f32x4*)(wl + 512 + 16 * n), wu1 = *(const LAS f32x4*)(wl + 640 + 16 * n), wu2 = *(const LAS f32x4*)(wl + 768 + 16 * n), bu = *(const LAS f32x4*)(wl + 896 + 16 * n);
                float z0_; asm volatile("v_mov_b32 %0, 0" : "=v"(z0_));
                f32x4 pg = (f32x4){z0_, z0_, z0_, z0_}, pu = pg;
                if (s >= 1 && fr >= 14) { pg = xb[256 * ai - 128 + 32 * n]; pu = xb[256 * ai - 128 + 64 + 32 * n]; }
#pragma unroll
                for (int m = 0; m < 4; ++m) {
                    const int rt = 128 * ai + 64 * wr + 16 * m + fr; const int gr = 254 * u.pm - 2 + rt;
                    const float rs = rl[128 * ai + 16 * m];
                    const f32x4 cg_ = acc[ai][0][m][n] * rs, cu_ = acc[ai][1][m][n] * rs;
                    f32x4 T1g, T2g, T1u, T2u, P1g, P2g, P1u, P2u;
                    T1g = (fr == 15) ? pg : cg_; T2g = (fr >= 14) ? pg : cg_; T1u = (fr == 15) ? pu : cu_; T2u = (fr >= 14) ? pu : cu_;
#pragma unroll
                    for (int e = 0; e < 4; ++e) { P1g[e] = dpp_ror1(T1g[e]); P2g[e] = dpp_ror2(T2g[e]); P1u[e] = dpp_ror1(T1u[e]); P2u[e] = dpp_ror2(T2u[e]); }
                    const f32x4 hg = bg + wg0 * P2g + wg1 * P1g + wg2 * cg_;
                    const f32x4 hu = bu + wu0 * P2u + wu1 * P1u + wu2 * cu_;
                    f32x4 ex = hg * (-LOG2E);
#pragma unroll
                    for (int e = 0; e < 4; ++e) ex[e] = __builtin_amdgcn_exp2f(ex[e]);
                    ex = ex + 1.0f;
#pragma unroll
                    for (int e = 0; e < 4; ++e) ex[e] = __builtin_amdgcn_rcpf(ex[e]);
                    const f32x4 o = (hg * hu) * ex;
                    if (rt >= 2 && gr < S) *(u32x2*)(ab + (size_t)(128 * ai + 16 * m) * FF + 16 * n) = pack4(o);
                    pg = cg_; pu = cu_;
                }
            }
        }
    }
};
}

constexpr size_t MiB = 1u << 20;
constexpr size_t WS_CL = 0, WS_CG = 524288, WS_GT = 1048576, WS_BAR = 1179648, BAR_BYTES = 16384, WS_SS = 1245184, ZERO_BYTES = 16384;
constexpr size_t WS_WIN = 3 * MiB;
constexpr size_t WS_WOUT = WS_WIN + 2ull * 2560 * 1024 * 2;
constexpr size_t WS_WGLU = WS_WOUT + 2ull * 1024 * 1024 * 2;
constexpr size_t WS_WUP = WS_WGLU + 2ull * 2048 * 1024 * 2;
constexpr size_t WS_WDN = WS_WUP + 4ull * 5632 * 1024 * 2;
constexpr size_t WS_WGT = WS_WDN + 4ull * 1024 * 2816 * 2;
constexpr size_t WS_WPR = WS_WGT + 4ull * 1024 * 1024 * 2;
constexpr size_t WS_HNA = WS_WPR + 4ull * 1024 * 256 * 2;
constexpr size_t WS_R = WS_HNA + (2ull + 16384 + 256) * 1024 * 2;
constexpr size_t WS_END = WS_R + 144 * MiB;
constexpr size_t R_Z = 0;
constexpr size_t R_AG = 0, R_TS = 40 * MiB, R_PS = 80 * MiB, R_E = 96 * MiB, R_G = 112 * MiB;
constexpr size_t R_ACT = 0;
constexpr size_t R_PB = 96 * MiB, R_PP = 104 * MiB;

#ifndef REPMASK
#define REPMASK 0u
#endif
#ifndef XSYNC
#define XSYNC 0
#endif
constexpr int LDS_BYTES = 147456, XL_OFF = 131072;

#define XB_TMO      128
#define XB_XCNT(j)  (256  + 64 * (j))
#define XB_XSUB(j)  (1280 + 64 * (j))
#define XB_XGEN(j)  (2304 + 64 * (j))
#define XB_TOP      3328
#define XB_TOPGEN   3392
#define XCD_BAR_WORDS 3456
#define XB_SPIN_CAP (1u << 18)
__device__ __forceinline__ unsigned xb_ld(unsigned* p)              { return __hip_atomic_load(p, __ATOMIC_RELAXED, __HIP_MEMORY_SCOPE_AGENT); }
__device__ __forceinline__ unsigned xb_add(unsigned* p, unsigned v) { return __hip_atomic_fetch_add(p, v, __ATOMIC_RELAXED, __HIP_MEMORY_SCOPE_AGENT); }
__device__ __forceinline__ unsigned xb_xcc_id() { return (unsigned)__builtin_amdgcn_s_getreg((3 << 11) | 20) & 0xFu; }
#define XB_SPIN(cond, bar) do { unsigned _sp = 0; while (cond) { __builtin_amdgcn_s_sleep(1); \
    if ((++_sp & 255u) == 0u) { if (xb_ld(&(bar)[XB_TMO])) break; if (_sp > XB_SPIN_CAP) { atomicAdd(&(bar)[XB_TMO], 1u); break; } } } } while (0)
struct XcdBarrier { unsigned* bar; unsigned x; volatile LAS unsigned* st; };
__device__ __forceinline__ XcdBarrier xcd_barrier_post(unsigned* bar, volatile LAS unsigned* st) {
    XcdBarrier b; b.bar = bar; b.x = xb_xcc_id(); b.st = st;
    if (threadIdx.x == 0) (void)xb_add(&bar[XB_XCNT(b.x)], 1u);
    return b;
}
__device__ __forceinline__ void xcd_barrier_complete(unsigned* bar, unsigned x, unsigned& nloc, unsigned& nx) {
    const unsigned G = gridDim.x * gridDim.y * gridDim.z;
    unsigned sum, cnt, mine, sp = 0u;
    for (;;) {
        sum = 0u; cnt = 0u; mine = 0u;
#pragma unroll
        for (unsigned j = 0; j < 16; ++j) { const unsigned c = xb_ld(&bar[XB_XCNT(j)]); sum += c; cnt += (c > 0u) ? 1u : 0u; mine = (j == x) ? c : mine; }
        if (sum == G) break;
        __builtin_amdgcn_s_sleep(1);
        if ((++sp & 255u) == 0u) { if (xb_ld(&bar[XB_TMO])) break; if (sp > XB_SPIN_CAP) { atomicAdd(&bar[XB_TMO], 1u); break; } }
    }
    nloc = mine > 0u ? mine : 1u; nx = cnt > 0u ? cnt : 1u;
}
__device__ __forceinline__ void xcd_barrier(unsigned* bar_, volatile LAS unsigned* st_, int wid_) {
    XcdBarrier b; b.bar = bar_; b.x = xb_xcc_id(); b.st = st_;
    asm volatile("s_waitcnt vmcnt(0)" ::: "memory");
    __syncthreads();
    int ln_; asm volatile("v_mbcnt_lo_u32_b32 %0, -1, 0\n\tv_mbcnt_hi_u32_b32 %0, -1, %0" : "=v"(ln_));
    if (wid_ == 0 && ln_ == 0) {
        unsigned* bar = b.bar;
        __builtin_amdgcn_s_waitcnt(0);
        unsigned nloc = b.st[0], nx = b.st[1];
        if (nloc == 0u) { xcd_barrier_complete(bar, b.x, nloc, nx); b.st[0] = nloc; b.st[1] = nx; }
        const unsigned old = xb_add(&bar[XB_XSUB(b.x)], 1u);
        const unsigned gen = old / nloc;
        if (old + 1u == (gen + 1u) * nloc) {
            __builtin_amdgcn_fence(__ATOMIC_RELEASE, "agent");
            asm volatile("s_waitcnt vmcnt(0)" ::: "memory");
            const unsigned og = xb_add(&bar[XB_TOP], 1u);
            const unsigned tg = og / nx;
            if (og + 1u == (tg + 1u) * nx) xb_add(&bar[XB_TOPGEN], 1u);
            else XB_SPIN(xb_ld(&bar[XB_TOPGEN]) == tg, bar);
            __builtin_amdgcn_fence(__ATOMIC_ACQUIRE, "agent");
            xb_add(&bar[XB_XGEN(b.x)], 1u);
            asm volatile("s_waitcnt vmcnt(0)" ::: "memory");
        } else {
            XB_SPIN(xb_ld(&bar[XB_XGEN(b.x)]) == gen, bar);
            __builtin_amdgcn_fence(__ATOMIC_ACQUIRE, "agent");
            asm volatile("s_waitcnt vmcnt(0)" ::: "memory");
        }
    }
    __syncthreads();
}

struct Params { const float* in[27]; float* out; unsigned char* ws; };

__device__ __forceinline__ float load_row(const float* xrow, int lane, f32x4 (&v)[4]) {
    const f32x4* xr = (const f32x4*)xrow + lane; float ss = 0.f;
#pragma unroll
    for (int j = 0; j < 4; ++j) { v[j] = xr[64 * j]; ss += (v[j][0] * v[j][0] + v[j][1] * v[j][1]) + (v[j][2] * v[j][2] + v[j][3] * v[j][3]); }
    return __builtin_amdgcn_rsqf(wave_sum(ss) * (1.f / D) + EPS);
}

__device__ __forceinline__ void transpose_item(const float* W, int K, int ldw, bf16_t* WT, int n0, int drow0, int kb, LAS float* scr, int lane, const float* gain) {
    const int k0 = 64 * kb, kq = lane >> 4, nq = 4 * (lane & 15); const float* wp = W + (size_t)(k0 + kq) * ldw + n0 + nq;
#pragma unroll
    for (int i = 0; i < 16; ++i) { const f32x4 w = *(const f32x4*)(wp + (size_t)(4 * i) * ldw) * (gain ? gain[k0 + 4 * i + kq] : 1.f); LAS float* sp = scr + (4 * i + kq) * 65 + nq; sp[0] = w[0]; sp[1] = w[1]; sp[2] = w[2]; sp[3] = w[3]; }
    asm volatile("s_waitcnt lgkmcnt(0)" ::: "memory");
    const int c = lane & 7;
#pragma unroll
    for (int j = 0; j < 8; ++j) { const int n = (lane >> 3) + 8 * j; const LAS float* s = scr + (8 * c) * 65 + n;
        u32x4 o; o.x = cvt_pk_bf16(s[0 * 65], s[1 * 65]); o.y = cvt_pk_bf16(s[2 * 65], s[3 * 65]); o.z = cvt_pk_bf16(s[4 * 65], s[5 * 65]); o.w = cvt_pk_bf16(s[6 * 65], s[7 * 65]);
        *(u32x4*)(WT + (size_t)(drow0 + n) * K + k0 + 8 * c) = o; }
    asm volatile("s_waitcnt lgkmcnt(0)" ::: "memory");
}
__device__ __forceinline__ int dest_row(int mode, int n0, int half) {
    if (mode == 1) { const int seg = n0 >> 9, r = n0 & 511; const int ds = seg == 1 ? 2 : (seg == 2 ? 1 : seg); return ds * 512 + r; }
    if (mode == 2) { const int hi = n0 >= half, np = hi ? n0 - half : n0; return (np >> 7) * 256 + hi * 128 + (np & 127); }
    return n0;
}
__device__ __forceinline__ bool transpose_mat(int& r, const float* W, int K, int ldw, int ncols, bf16_t* WT, int mode, LAS float* scr, int lane, const float* gain = nullptr) {
    const int nblk = ncols / 64, items = (K / 64) * nblk;
    if (r >= items) { r -= items; return false; }
    const int kb = r / nblk, nb = r % nblk;
    transpose_item(W, K, ldw, WT, nb * 64, dest_row(mode, nb * 64, ncols / 2), kb, scr, lane, gain);
    return true;
}

__device__ __forceinline__ const float* in_ptr(const Params& P, int i) { asm volatile("" : "+s"(i)); return P.in[i]; }
__global__ void __launch_bounds__(512, 2) mega(Params P) {
    extern __shared__ __attribute__((aligned(16))) unsigned char lds_raw[];
    LAS unsigned char* lds = (LAS unsigned char*)lds_raw;
    cg::grid_group grid = cg::this_grid();
    const int G = gridDim.x, bid = blockIdx.x, NGW = G * 8;
    const int wid0 = __builtin_amdgcn_readfirstlane((int)threadIdx.x >> 6);
#define PHASE_IDS int lane_; asm volatile("v_mbcnt_lo_u32_b32 %0, -1, 0\n\tv_mbcnt_hi_u32_b32 %0, -1, %0" : "=v"(lane_)); const int lane = lane_, wid = wid0, tid = wid * 64 + lane, gw = bid * 8 + wid; (void)tid; (void)gw;
    unsigned char* ws = P.ws;
    float* X = P.out;
    float* CL = (float*)(ws + WS_CL); float* CGm = (float*)(ws + WS_CG); float* GT = (float*)(ws + WS_GT);
    bf16_t* HNA = (bf16_t*)(ws + WS_HNA); bf16_t* HN = HNA + 2 * D;
    unsigned char* R = ws + WS_R;
    { volatile LAS unsigned* st0 = (volatile LAS unsigned*)(lds + XL_OFF + 8192); if (threadIdx.x < 2) st0[threadIdx.x] = 0u; __syncthreads(); }
    (void)xcd_barrier_post((unsigned*)(ws + WS_BAR), (volatile LAS unsigned*)(lds + XL_OFF + 8192));
#define GSYNC() xcd_barrier((unsigned*)(P.ws + WS_BAR), (volatile LAS unsigned*)(lds + XL_OFF + 8192), wid0)
#ifdef PROBE_SEL
    LAS float* tacc = (LAS float*)(lds + XL_OFF + 13600); LAS unsigned long long* tlast = (LAS unsigned long long*)(lds + XL_OFF + 13696);
    if (threadIdx.x == 0) { for (int i = 0; i < 16; ++i) tacc[i] = 0.f; *tlast = __builtin_amdgcn_s_memrealtime(); }
#define STAMP(gid) do { if (bid == 0 && threadIdx.x == 0) { const unsigned long long t_ = __builtin_amdgcn_s_memrealtime(); tacc[gid] += (float)(t_ - *tlast); *tlast = t_; } } while (0)
#else
#define STAMP(gid) do {} while (0)
#endif

    for (int rep_ = 0; rep_ < 1 + (int)((REPMASK >> 0) & 1u); ++rep_) { PHASE_IDS
        LAS float* scr = (LAS float*)(lds + wid * 16640);
        constexpr int I_IN = 16 * 40, I_OUT = 16 * 16, I_GLU = 16 * 32, I_UP = 16 * 88, I_DN = 44 * 16, I_GT = 16 * 16, I_PR = 4 * 16;
        constexpr int NIT = 2 * I_IN + 2 * I_OUT + 2 * I_GLU + 4 * I_UP + 4 * I_DN + 4 * I_GT + 4 * I_PR;
        for (int it = gw; it < NIT; it += NGW) {
            int r = it; bool done = false;
#pragma unroll 1
            for (int e = 0; e < 2 && !done; ++e) done = transpose_mat(r, in_ptr(P, 4) + (size_t)e * 1024 * 2568, 1024, 2568, 2560, (bf16_t*)(ws + WS_WIN) + (size_t)e * 2560 * 1024, 1, scr, lane);
#pragma unroll 1
            for (int e = 0; e < 2 && !done; ++e) done = transpose_mat(r, in_ptr(P, 11) + (size_t)e * 1024 * 1024, 1024, 1024, 1024, (bf16_t*)(ws + WS_WOUT) + (size_t)e * 1024 * 1024, 0, scr, lane);
#pragma unroll 1
            for (int e = 0; e < 2 && !done; ++e) done = transpose_mat(r, in_ptr(P, 20) + (size_t)e * 1024 * 2048, 1024, 2048, 2048, (bf16_t*)(ws + WS_WGLU) + (size_t)e * 2048 * 1024, 2, scr, lane);
#pragma unroll 1
            for (int e = 0; e < 4 && !done; ++e) done = transpose_mat(r, in_ptr(P, 21) + (size_t)e * 1024 * 5632, 1024, 5632, 5632, (bf16_t*)(ws + WS_WUP) + (size_t)e * 5632 * 1024, 2, scr, lane, in_ptr(P, 3) + e * D);
#pragma unroll 1
            for (int e = 0; e < 4 && !done; ++e) done = transpose_mat(r, in_ptr(P, 24) + (size_t)e * 2816 * 1024, 2816, 1024, 1024, (bf16_t*)(ws + WS_WDN) + (size_t)e * 1024 * 2816, 0, scr, lane);
#pragma unroll 1
            for (int e = 0; e < 4 && !done; ++e) done = transpose_mat(r, in_ptr(P, 26) + (size_t)e * 1024 * 1024, 1024, 1024, 1024, (bf16_t*)(ws + WS_WGT) + (size_t)e * 1024 * 1024, 0, scr, lane);
#pragma unroll 1
            for (int e = 0; e < 4 && !done; ++e) done = transpose_mat(r, in_ptr(P, 25) + (size_t)e * 256 * 1024, 256, 1024, 1024, (bf16_t*)(ws + WS_WPR) + (size_t)e * 1024 * 256, 0, scr, lane);
        }
        if (bid == 0) for (int i = tid; i < 2 * D / 2; i += 512) ((unsigned*)HNA)[i] = 0u;
    }
    grid.sync();
    STAMP(0);

#pragma unroll 1
    for (int L = 0; L < 4; ++L) {
        const int e = L >> 1;
        if ((L & 1) == 0) {
            for (int rep_ = 0; rep_ < 1 + (int)((REPMASK >> 1) & 1u); ++rep_) { PHASE_IDS
                const float* gmix = in_ptr(P, 2) + L * D; const float* Win = in_ptr(P, 4) + (size_t)e * 1024 * 2568; const float* bfg = in_ptr(P, 5) + e * 8;
                f32x4 wfa[16], wfb[16];
#pragma unroll
                for (int j = 0; j < 4; ++j)
#pragma unroll
                    for (int i = 0; i < 4; ++i) { const float* wp = Win + (size_t)(4 * lane + 256 * j + i) * 2568 + 2560; wfa[j * 4 + i] = *(const f32x4*)wp; wfb[j * 4 + i] = *(const f32x4*)(wp + 4); }
                const float* xsrc = (L == 0 ? in_ptr(P, 0) : X);
                LAS float* lw = (LAS float*)(lds + wid * 256);
                const float bbl = bfg[lane & 7];
                for (int gi = gw; gi < 2048; gi += NGW) {
                    f32x4 cur[4], nxt[4];
                    { const f32x4* xr = (const f32x4*)(xsrc + (size_t)(8 * gi) * D) + lane;
#pragma unroll
                      for (int j = 0; j < 4; ++j) cur[j] = xr[64 * j]; }
                    float myf = 0.f;
#pragma unroll 1
                    for (int rr = 0; rr < 8; ++rr) {
                        const int t = 8 * gi + rr;
                        if (rr < 7) { const f32x4* xr = (const f32x4*)(xsrc + (size_t)(t + 1) * D) + lane;
#pragma unroll
                            for (int j = 0; j < 4; ++j) nxt[j] = xr[64 * j]; }
                        float ss = 0.f;
#pragma unroll
                        for (int j = 0; j < 4; ++j) ss += (cur[j][0] * cur[j][0] + cur[j][1] * cur[j][1]) + (cur[j][2] * cur[j][2] + cur[j][3] * cur[j][3]);
                        const float rs = __builtin_amdgcn_rsqf(wave_sum(ss) * (1.f / D) + EPS);
                        if (L == 0) {
#pragma unroll
                            for (int j = 0; j < 4; ++j) *((f32x4*)(X + (size_t)t * D) + lane + 64 * j) = cur[j]; }
                        const float zf_ = zero_f(); f32x4 fa = (f32x4){zf_, zf_, zf_, zf_}, fb = fa;
#pragma unroll
                        for (int j = 0; j < 4; ++j) { const f32x4 gg = *((const f32x4*)gmix + lane + 64 * j); const f32x4 v = cur[j] * rs * gg;
                            *((u32x2*)(HN + (size_t)t * D) + lane + 64 * j) = pack4(v);
#pragma unroll
                            for (int i = 0; i < 4; ++i) { fa += wfa[j * 4 + i] * v[i]; fb += wfb[j * 4 + i] * v[i]; } }
                        float f0 = wave_sum(fa[0]), f1 = wave_sum(fa[1]), f2 = wave_sum(fa[2]), f3 = wave_sum(fa[3]), f4 = wave_sum(fb[0]), f5 = wave_sum(fb[1]), f6 = wave_sum(fb[2]), f7 = wave_sum(fb[3]);
                        const int h = lane & 7;
                        float sel = f0; sel = h == 1 ? f1 : sel; sel = h == 2 ? f2 : sel; sel = h == 3 ? f3 : sel; sel = h == 4 ? f4 : sel; sel = h == 5 ? f5 : sel; sel = h == 6 ? f6 : sel; sel = h == 7 ? f7 : sel;
                        myf = ((lane >> 3) == rr) ? sel : myf;
#pragma unroll
                        for (int j = 0; j < 4; ++j) cur[j] = nxt[j];
                    }
                    const float z = myf + bbl; const float ls = -__builtin_amdgcn_logf(1.f + __builtin_amdgcn_exp2f(-z * LOG2E));
                    lw[lane] = ls; asm volatile("s_waitcnt lgkmcnt(0)" ::: "memory");
                    float cum = 0.f;
#pragma unroll
                    for (int r2 = 0; r2 < 8; ++r2) { const float o_ = lw[r2 * 8 + (lane & 7)]; cum += (r2 <= (lane >> 3)) ? o_ : 0.f; }
                    asm volatile("s_waitcnt lgkmcnt(0)" ::: "memory");
                    CL[(size_t)gi * 64 + lane] = cum;
                    if (lane >= 56) GT[(size_t)gi * 8 + (lane & 7)] = cum;
                }
            }
            GSYNC();
            STAMP(1);
            for (int rep_ = 0; rep_ < 1 + (int)((REPMASK >> 2) & 1u); ++rep_) { PHASE_IDS
                pg8::Gemm g{HN, (const bf16_t*)(ws + WS_WIN) + (size_t)e * 2560 * 1024, 1024, 1024, 256};
                pg8::StaticOrder so; so.init(64, 10, G, bid);
                pg8::EpiStore E{(bf16_t*)(R + R_Z), ZW, 1};
                pg8::gemm_phase(lds, g, so, E, wid);
            }
            GSYNC();
            STAMP(2);
            for (int rep_ = 0; rep_ < 1 + (int)((REPMASK >> 3) & 1u); ++rep_) { PHASE_IDS
                bf16_t* Z = (bf16_t*)(R + R_Z);
                const float* gq = in_ptr(P, 6) + e * 64; const float* gk = in_ptr(P, 7) + e * 64;
                LAS float* CT = (LAS float*)(lds + 98304); LAS float* BT = CT + 2048; LAS float* OFF = BT + 512;
                __syncthreads();
                { const int ckk = tid >> 1, hq = (tid & 1) * 4; f32x4 s = (f32x4){0.f, 0.f, 0.f, 0.f};
#pragma unroll
                  for (int i = 0; i < 8; ++i) s += *(const f32x4*)(GT + (size_t)(8 * ckk + i) * 8 + hq);
                  *(LAS f32x4*)(CT + ckk * 8 + hq) = s; }
                __syncthreads();
                { const int h = tid & 7, b4 = tid >> 3; BT[b4 * 8 + h] = (CT[(4 * b4) * 8 + h] + CT[(4 * b4 + 1) * 8 + h]) + (CT[(4 * b4 + 2) * 8 + h] + CT[(4 * b4 + 3) * 8 + h]); }
                __syncthreads();
                { const int h = tid & 7, b4 = tid >> 3; float o_ = 0.f;
                  for (int i = 0; i < b4; ++i) o_ += BT[i * 8 + h];
#pragma unroll
                  for (int i = 0; i < 4; ++i) { OFF[(4 * b4 + i) * 8 + h] = o_; o_ += CT[(4 * b4 + i) * 8 + h]; } }
                __syncthreads();
                for (int ck = bid; ck < 256; ck += G) {
                    { const int h = tid & 7, tok = tid >> 3; float off = OFF[ck * 8 + h];
                      const int gl = tok >> 3;
                      for (int i2 = 0; i2 < gl; ++i2) off += GT[(size_t)(8 * ck + i2) * 8 + h];
                      const int t = 64 * ck + tok; CGm[(size_t)t * 8 + h] = CL[(size_t)t * 8 + h] + off; }
#pragma unroll 1
                    for (int ps4 = 0; ps4 < 16; ps4 += 4) {
                        u32x4 wq[4];
#pragma unroll
                        for (int q = 0; q < 4; ++q) { const int pair = (ps4 + q) * 64 + (tid >> 3); const int tok = pair >> 4, hh = (pair >> 1) & 7, isk = pair & 1;
                            wq[q] = *(const u32x4*)(Z + (size_t)(64 * ck + tok) * ZW + (isk ? 1536 : 512) + hh * 64 + (tid & 7) * 8); }
#pragma unroll
                        for (int q = 0; q < 4; ++q) { const int pair = (ps4 + q) * 64 + (tid >> 3), sub = tid & 7; const int tok = pair >> 4, hh = (pair >> 1) & 7, isk = pair & 1;
                            bf16_t* ptr = Z + (size_t)(64 * ck + tok) * ZW + (isk ? 1536 : 512) + hh * 64 + sub * 8;
                            const u32x4 w = wq[q]; float v[8];
                            v[0] = bf2f(w.x & 0xffffu); v[1] = bf2f(w.x >> 16); v[2] = bf2f(w.y & 0xffffu); v[3] = bf2f(w.y >> 16); v[4] = bf2f(w.z & 0xffffu); v[5] = bf2f(w.z >> 16); v[6] = bf2f(w.w & 0xffffu); v[7] = bf2f(w.w >> 16);
                            float ss = 0.f;
#pragma unroll
                            for (int i = 0; i < 8; ++i) ss += v[i] * v[i];
                            ss = x3_sum(ss);
                            const float rs = (__builtin_amdgcn_rsqf(ss * (1.f / 64.f) + EPS)) * (isk ? 1.f : 0.125f * LOG2E);
                            const float* gp = (isk ? gk : gq) + sub * 8;
#pragma unroll
                            for (int i = 0; i < 8; ++i) v[i] = v[i] * rs * gp[i];
                            u32x4 o; o.x = cvt_pk_bf16(v[0], v[1]); o.y = cvt_pk_bf16(v[2], v[3]); o.z = cvt_pk_bf16(v[4], v[5]); o.w = cvt_pk_bf16(v[6], v[7]);
                            { int rp_ = rep_; asm volatile("" : "+v"(rp_)); if (rp_) o = w; }
                            *(u32x4*)ptr = o; }
                    }
                    { LAS bf16_t* LT = (LAS bf16_t*)(lds + 1024); bf16_t* VTg = (bf16_t*)(R + 80 * MiB);
                      __syncthreads();
#pragma unroll 1
                      for (int k = 0; k < 8; ++k) { const int idx = tid + 512 * k; const int tok = idx & 63, cc = idx >> 6;
                          const u32x4 w = *(const u32x4*)(Z + (size_t)(64 * ck + tok) * ZW + 2048 + cc * 8); LAS bf16_t* lt = LT + (cc * 8) * 72 + tok;
                          lt[0 * 72] = (bf16_t)(w.x & 0xffffu); lt[1 * 72] = (bf16_t)(w.x >> 16); lt[2 * 72] = (bf16_t)(w.y & 0xffffu); lt[3 * 72] = (bf16_t)(w.y >> 16);
                          lt[4 * 72] = (bf16_t)(w.z & 0xffffu); lt[5 * 72] = (bf16_t)(w.z >> 16); lt[6 * 72] = (bf16_t)(w.w & 0xffffu); lt[7 * 72] = (bf16_t)(w.w >> 16); }
                      __syncthreads();
#pragma unroll 1
                      for (int k = 0; k < 8; ++k) { const int idx = tid + 512 * k; const int c = idx >> 3, part = idx & 7;
                          *(u32x4*)(VTg + (size_t)c * S + 64 * ck + part * 8) = *(const LAS u32x4*)(LT + c * 72 + part * 8); }
                    }
                }
                LAS bf16_t* Wsm = (LAS bf16_t*)lds; LAS bf16_t* VT = (LAS bf16_t*)(lds + 34816);
                const float* wsp = in_ptr(P, 9) + (size_t)e * 4 * 128 * 128; const float* bsp = in_ptr(P, 10) + e * 512; const float* vg = in_ptr(P, 8) + e * 512;
                for (int it = bid; it < 512; it += G) {
                    const int n = it >> 2, g = it & 3;
                    __syncthreads();
                    for (int idx = tid; idx < 128 * 32; idx += 512) { const int t = idx >> 5, s4 = (idx & 31) * 4; f32x4 w = *(const f32x4*)(wsp + ((size_t)g * 128 + t) * 128 + s4);
#pragma unroll
                        for (int i = 0; i < 4; ++i) if (s4 + i > t) w[i] = 0.f;
                        *(LAS u32x2*)(Wsm + t * 136 + s4) = pack4(w); }
                    { const int tok = tid >> 2, part = tid & 3; const bf16_t* vp = Z + (size_t)(128 * n + tok) * ZW + 1024 + g * 128 + part * 32;
                      float v[32]; float ss = 0.f;
#pragma unroll
                      for (int q = 0; q < 4; ++q) { const u32x4 w = *(const u32x4*)(vp + q * 8);
                          v[q * 8 + 0] = bf2f(w.x & 0xffffu); v[q * 8 + 1] = bf2f(w.x >> 16); v[q * 8 + 2] = bf2f(w.y & 0xffffu); v[q * 8 + 3] = bf2f(w.y >> 16);
                          v[q * 8 + 4] = bf2f(w.z & 0xffffu); v[q * 8 + 5] = bf2f(w.z >> 16); v[q * 8 + 6] = bf2f(w.w & 0xffffu); v[q * 8 + 7] = bf2f(w.w >> 16); }
#pragma unroll
                      for (int i = 0; i < 32; ++i) ss += v[i] * v[i];
                      ss = x2_sum(ss);
                      const float rs = __builtin_amdgcn_rsqf(ss * (1.f / 128.f) + EPS);
#pragma unroll
                      for (int i = 0; i < 32; ++i) { const int c = part * 32 + i; const float y = v[i] * rs * vg[g * 128 + c]; VT[c * 136 + tok] = (bf16_t)(cvt_pk_bf16(y, 0.f) & 0xffffu); } }
                    __syncthreads();
                    const int l15 = lane & 15, quad = lane >> 4;
                    f32x4 acc[8];
#pragma unroll
                    for (int cb = 0; cb < 8; ++cb) acc[cb] = (f32x4){0.f, 0.f, 0.f, 0.f};
                    for (int ks = 0; ks <= (wid >> 1); ++ks) {
                        const bf16x8 a = *(const LAS bf16x8*)(Wsm + (16 * wid + l15) * 136 + 32 * ks + quad * 8);
#pragma unroll
                        for (int cb = 0; cb < 8; ++cb) { const bf16x8 b = *(const LAS bf16x8*)(VT + (16 * cb + l15) * 136 + 32 * ks + quad * 8);
                            acc[cb] = __builtin_amdgcn_mfma_f32_16x16x32_bf16(b, a, acc[cb], 0, 0, 0); }
                    }
                    const int t = 16 * wid + l15; const float bs = bsp[g * 128 + t];
                    bf16_t* up = Z + (size_t)(128 * n + t) * ZW + g * 128 + quad * 4;
#pragma unroll
                    for (int cb = 0; cb < 8; ++cb) { const f32x4 uu = unpack4(*(const u32x2*)(up + 16 * cb)); f32x4 y = uu * (acc[cb] + bs); { int rp_ = rep_; asm volatile("" : "+v"(rp_)); if (rp_) y = uu; } *(u32x2*)(up + 16 * cb) = pack4(y); }
                }
            }
            GSYNC();
            STAMP(1);
            for (int rep_ = 0; rep_ < 1 + (int)((REPMASK >> 4) & 1u); ++rep_) { PHASE_IDS
                bf16_t* Z = (bf16_t*)(R + R_Z); const bf16_t* VTg = (const bf16_t*)(R + 80 * MiB);
                const int l15 = lane & 15, quad = lane >> 4;
                const float Gq = wave_max(fabsf(in_ptr(P, 6)[e * 64 + lane])), Gk = wave_max(fabsf(in_ptr(P, 7)[e * 64 + lane]));
                const float B2l = 8.f * Gq * Gk * LOG2E;
                int hord = 0;
                { float tot[8];
#pragma unroll
                  for (int hh = 0; hh < 8; ++hh) tot[hh] = CGm[(size_t)(S - 1) * 8 + hh];
#pragma unroll
                  for (int hh = 0; hh < 8; ++hh) { int rank = 0;
#pragma unroll
                      for (int h2 = 0; h2 < 8; ++h2) rank += (tot[h2] > tot[hh] || (tot[h2] == tot[hh] && h2 < hh)) ? 1 : 0;
                      hord |= hh << (4 * rank); } }
                for (int item = bid; item < 512; item += G) {
                    const int half = (item >> 8) & 1, rk = half ? 7 - (item & 7) : (item & 7);
                    const int qb2 = 63 - (item >> 3), h = (hord >> (4 * rk)) & 7; const int q0 = 256 * qb2, qw = q0 + 32 * wid;
                    bf16x8 qf[2][2];
#pragma unroll
                    for (int rb = 0; rb < 2; ++rb) { const bf16_t* Qp = Z + (size_t)(qw + 16 * rb + l15) * ZW + 512 + 64 * h;
                        qf[rb][0] = *(const bf16x8*)(Qp + quad * 8); qf[rb][1] = *(const bf16x8*)(Qp + 32 + quad * 8); }
                    float rminv = 0.f;
                    float mrun[2] = {-1e30f, -1e30f}, lrun[2] = {0.f, 0.f}; f32x4 o[2][4];
#pragma unroll
                    for (int rb = 0; rb < 2; ++rb)
#pragma unroll
                        for (int db = 0; db < 4; ++db) o[rb][db] = (f32x4){0.f, 0.f, 0.f, 0.f};
                    const bf16_t* kbase = Z + (size_t)(tid >> 3) * ZW + 1536 + 64 * h + (tid & 7) * 8;
                    const bf16_t* vbase = VTg + (size_t)(h * 64 + (tid >> 3)) * S + (tid & 7) * 8;
                    const float* cbase = CGm + (size_t)lane * 8 + h;
                    u32x4 kreg, vreg; float ckreg;
#define ATT_LOAD(jj) do { kreg = *(const u32x4*)(kbase + (size_t)(64 * (jj)) * ZW); vreg = *(const u32x4*)(vbase + 64 * (jj)); ckreg = cbase[(size_t)(64 * (jj)) * 8]; } while (0)
#define ATT_STORE(bb) do { LAS unsigned char* lb = lds + (bb) * 18688; *(LAS u32x4*)(lb + ((tid >> 3) * 72 + (tid & 7) * 8) * 2) = kreg; *(LAS u32x4*)(lb + 9216 + ((tid >> 3) * 72 + (tid & 7) * 8) * 2) = vreg; if (wid == 0) ((LAS float*)(lb + 18432))[lane] = -ckreg; } while (0)
                    int j = 4 * qb2 + 3;
                    ATT_LOAD(j); ATT_STORE(j & 1); ATT_LOAD(j - 1);
                    __syncthreads();
                    for (; j >= 0; --j) {
                        const int b = j & 1;
                        if (j > 0) { ATT_STORE(b ^ 1); if (j > 1) ATT_LOAD(j - 2); }
                        const LAS bf16_t* Ks = (const LAS bf16_t*)(lds + b * 18688); const LAS bf16_t* VT = (const LAS bf16_t*)(lds + b * 18688 + 9216); const LAS float* Ck = (const LAS float*)(lds + b * 18688 + 18432);
                        if (j == 4 * qb2 - 1) { const float mm = wave_min(fminf(mrun[0], mrun[1])); LAS float* rmn = (LAS float*)(lds + 37376);
                            if (lane == 0) rmn[wid] = mm;
                            __syncthreads();
                            rminv = fminf(fminf(fminf(rmn[0], rmn[1]), fminf(rmn[2], rmn[3])), fminf(fminf(rmn[4], rmn[5]), fminf(rmn[6], rmn[7]))); }
                        const bool stop = (64 * j + 63 < q0) && ((B2l + Ck[63] - rminv) < -40.f);
                        if (!stop && !(64 * j > qw + 31)) {
                            f32x4 s[2][4];
#pragma unroll
                            for (int kb = 0; kb < 4; ++kb) {
                                const LAS bf16_t* kp = Ks + (16 * kb + l15) * 72 + quad * 8;
                                const bf16x8 k0 = *(const LAS bf16x8*)kp, k1 = *(const LAS bf16x8*)(kp + 32);
                                const f32x4 nck4 = *(const LAS f32x4*)(Ck + 16 * kb + quad * 4);
#pragma unroll
                                for (int rb = 0; rb < 2; ++rb) {
                                    f32x4 z = __builtin_amdgcn_mfma_f32_16x16x32_bf16(k0, qf[rb][0], nck4, 0, 0, 0);
                                    s[rb][kb] = __builtin_amdgcn_mfma_f32_16x16x32_bf16(k1, qf[rb][1], z, 0, 0, 0);
                                }
                            }
                            if (64 * j + 63 > qw) {
#pragma unroll
                                for (int rb = 0; rb < 2; ++rb)
#pragma unroll
                                    for (int kb = 0; kb < 4; ++kb)
#pragma unroll
                                        for (int jj = 0; jj < 4; ++jj) if (64 * j + 16 * kb + 4 * quad + jj > qw + 16 * rb + l15) s[rb][kb][jj] = -1e30f;
                            }
                            asm volatile("s_nop 15\n\ts_nop 7" : "+v"(s[0][0]), "+v"(s[0][1]), "+v"(s[0][2]), "+v"(s[0][3]), "+v"(s[1][0]), "+v"(s[1][1]), "+v"(s[1][2]), "+v"(s[1][3]));
                            bf16x8 pb[2][2];
#pragma unroll
                            for (int rb = 0; rb < 2; ++rb) {
                                float mx = max3f(s[rb][0][0], s[rb][0][1], s[rb][0][2]); mx = max3f(mx, s[rb][0][3], s[rb][1][0]); mx = max3f(mx, s[rb][1][1], s[rb][1][2]); mx = max3f(mx, s[rb][1][3], s[rb][2][0]);
                                mx = max3f(mx, s[rb][2][1], s[rb][2][2]); mx = max3f(mx, s[rb][2][3], s[rb][3][0]); mx = max3f(mx, s[rb][3][1], s[rb][3][2]); mx = max3f(mx, s[rb][3][3], mx);
                                mx = quad_max(mx);
                                if (__builtin_amdgcn_ballot_w64(mx > mrun[rb]) != 0ull) {
                                    const float mn_ = fmaxf(mrun[rb], mx); const float alpha = __builtin_amdgcn_exp2f(mrun[rb] - mn_); mrun[rb] = mn_; lrun[rb] *= alpha;
#pragma unroll
                                    for (int db = 0; db < 4; ++db) o[rb][db] = o[rb][db] * alpha;
                                }
                                const float mn = mrun[rb];
                                float ls = 0.f;
#pragma unroll
                                for (int kb = 0; kb < 4; ++kb)
#pragma unroll
                                    for (int jj = 0; jj < 4; ++jj) { s[rb][kb][jj] = __builtin_amdgcn_exp2f(s[rb][kb][jj] - mn); ls += s[rb][kb][jj]; }
                                lrun[rb] += ls;
#pragma unroll
                                for (int kk = 0; kk < 2; ++kk) { u32x4 pw; pw.x = cvt_pk_bf16(s[rb][2 * kk][0], s[rb][2 * kk][1]); pw.y = cvt_pk_bf16(s[rb][2 * kk][2], s[rb][2 * kk][3]);
                                    pw.z = cvt_pk_bf16(s[rb][2 * kk + 1][0], s[rb][2 * kk + 1][1]); pw.w = cvt_pk_bf16(s[rb][2 * kk + 1][2], s[rb][2 * kk + 1][3]); pb[rb][kk] = __builtin_bit_cast(bf16x8, pw); }
                            }
#pragma unroll
                            for (int kk = 0; kk < 2; ++kk)
#pragma unroll
                                for (int db = 0; db < 4; ++db) {
                                    const LAS bf16_t* vp = VT + (16 * db + l15) * 72 + 32 * kk + quad * 4;
                                    u32x4 vw; const u32x2 va = *(const LAS u32x2*)vp, vb = *(const LAS u32x2*)(vp + 16); vw.x = va.x; vw.y = va.y; vw.z = vb.x; vw.w = vb.y;
                                    const bf16x8 vf = __builtin_bit_cast(bf16x8, vw);
                                    o[0][db] = __builtin_amdgcn_mfma_f32_16x16x32_bf16(vf, pb[0][kk], o[0][db], 0, 0, 0);
                                    o[1][db] = __builtin_amdgcn_mfma_f32_16x16x32_bf16(vf, pb[1][kk], o[1][db], 0, 0, 0);
                                }
                        }
                        __syncthreads();
                        if (stop) break;
                    }
#undef ATT_LOAD
#undef ATT_STORE
#pragma unroll
                    for (int rb = 0; rb < 2; ++rb) {
                        const float lr = quad_sum(lrun[rb]);
                        const float inv = 1.0f / lr;
                        bf16_t* Op = Z + (size_t)(qw + 16 * rb + l15) * ZW + 512 + 64 * h + 4 * quad;
#pragma unroll
                        for (int db = 0; db < 4; ++db) *(u32x2*)(Op + 16 * db) = pack4(o[rb][db] * inv);
                    }
                }
            }
            GSYNC();
            STAMP(3);
            for (int rep_ = 0; rep_ < 1 + (int)((REPMASK >> 5) & 1u); ++rep_) { PHASE_IDS
            { const float* pin = in_ptr(P, 1) + (size_t)L * S * 256; bf16_t* PB = (bf16_t*)(R + R_PB);
              for (int t = gw; t < S; t += NGW) { const f32x4 pv = *((const f32x4*)(pin + (size_t)t * 256) + lane); *((u32x2*)(PB + (size_t)t * 256) + lane) = pack4(pv); } }
                pg8::Gemm g{(const bf16_t*)(R + R_Z), (const bf16_t*)(ws + WS_WOUT) + (size_t)e * 1024 * 1024, 1024, ZW, 256};
                pg8::StaticOrder so; so.init(64, 4, G, bid);
                pg8::EpiRes E{X, HN, (float*)(ws + WS_SS), (LAS float*)(lds + XL_OFF + 8448)};
                pg8::gemm_phase(lds, g, so, E, wid);
            }
            GSYNC();
            STAMP(2);
        } else {
            for (int rep_ = 0; rep_ < 1 + (int)((REPMASK >> 6) & 1u); ++rep_) { PHASE_IDS
                bf16_t* AG = (bf16_t*)(R + R_AG); bf16_t* TS = (bf16_t*)(R + R_TS); bf16_t* PS = (bf16_t*)(R + R_PS);
                const float* gmix = in_ptr(P, 2) + L * D;
                { LAS bf16_t* ST = (LAS bf16_t*)lds;
                  for (int n = bid; n < 512; n += G) {
                      __syncthreads();
#pragma unroll 1
                      for (int r4 = 0; r4 < 4; ++r4) { const int s = 4 * wid + r4, t = 32 * n + s; f32x4 v[4]; const float rs = load_row(X + (size_t)t * D, lane, v);
#pragma unroll
                          for (int j = 0; j < 4; ++j) { const f32x4 gg = *((const f32x4*)gmix + lane + 64 * j); *(LAS u32x2*)(ST + s * 1032 + 4 * lane + 256 * j) = pack4(v[j] * rs * gg); } }
                      __syncthreads();
#pragma unroll
                      for (int k = 0; k < 8; ++k) { const int i = tid + 512 * k; const int g = i >> 6, s = (i & 63) >> 1, half = i & 1;
                          *(u32x4*)(AG + (size_t)(g * 512 + n) * 640 + s * 16 + half * 8) = *(const LAS u32x4*)(ST + s * 1032 + g * 16 + half * 8); }
                  } }
                const float* a_re = in_ptr(P, 12) + e * 4096; const float* a_im = in_ptr(P, 13) + e * 4096; const float* ldt = in_ptr(P, 14) + e * 64;
                const float* b_re = in_ptr(P, 15) + (size_t)e * 65536; const float* b_im = in_ptr(P, 16) + (size_t)e * 65536; const float* c_re = in_ptr(P, 17) + (size_t)e * 65536; const float* c_im = in_ptr(P, 18) + (size_t)e * 65536;
                LAS float* Wr = (LAS float*)lds; LAS float* Wi = Wr + 512; LAS float* Pr = Wi + 512; LAS float* Pi = Pr + 512; LAS float* Cl = Pi + 512; LAS float* Bl = Cl + 2048;
                for (int it = bid; it < 256; it += G) {
                    const int g = it >> 2, to = it & 3;
                    __syncthreads();
                    { const int tl = tid >> 6, p = tid & 63, tau = 8 * to + tl; const float dt = expf(ldt[g]), lr = a_re[g * 64 + p], li = a_im[g * 64 + p];
                      float s1, c1; sincosf(li * dt, &s1, &c1); const float e1 = expf(lr * dt); const float abr = e1 * c1, abi = e1 * s1;
                      const float den = lr * lr + li * li, nr = abr - 1.0f, ni = abi; const float cr = (nr * lr + ni * li) / den, ci = (ni * lr - nr * li) / den;
                      float sj, cj; sincosf((float)tau * (li * dt), &sj, &cj); const float ej = expf((float)tau * (lr * dt)); const float ajr = ej * cj, aji = ej * sj;
                      Wr[tid] = ajr * cr - aji * ci; Wi[tid] = ajr * ci + aji * cr;
                      float sp, cp; sincosf((float)(tau + 1) * (li * dt), &sp, &cp); const float ep = expf((float)(tau + 1) * (lr * dt)); Pr[tid] = ep * cp; Pi[tid] = ep * sp;
                      const int q4 = (tid & 255) * 4;
                      *(LAS f32x4*)(Cl + (tid >> 8) * 1024 + q4) = *(const f32x4*)((tid < 256 ? c_re : c_im) + (size_t)g * 1024 + q4);
                      *(LAS f32x4*)(Bl + (tid >> 8) * 1024 + q4) = *(const f32x4*)((tid < 256 ? b_re : b_im) + (size_t)g * 1024 + q4); }
                    __syncthreads();
                    { const int tl = tid >> 6, c = (tid >> 2) & 15, cq = tid & 3, tau = 8 * to + tl; f32x4 acc = (f32x4){0.f, 0.f, 0.f, 0.f};
                      for (int p = 0; p < 64; ++p) { const float Cr = Cl[c * 64 + p], Ci = Cl[1024 + c * 64 + p], wr_ = Wr[tl * 64 + p], wi_ = Wi[tl * 64 + p];
                          const float cwr = Cr * wr_ - Ci * wi_, cwi = Cr * wi_ + Ci * wr_; const f32x4 br = *(const LAS f32x4*)(Bl + p * 16 + 4 * cq), bi = *(const LAS f32x4*)(Bl + 1024 + p * 16 + 4 * cq);
                          acc += br * cwr - bi * cwi; }
                      const u32x2 kv = pack4(acc); const u32x2 zz = (u32x2){0u, 0u};
                      for (int s = 0; s + tau < 32; ++s) { *(u32x2*)(TS + (size_t)(g * 512 + (tau + s) * 16 + c) * 640 + s * 16 + 4 * cq) = kv;
                          if (tau >= 1) *(u32x2*)(TS + (size_t)(g * 512 + s * 16 + c) * 640 + (s + tau) * 16 + 4 * cq) = zz; } }
                    { const int tl = tid >> 6, c = (tid >> 2) & 15, part = tid & 3, t = 8 * to + tl;
#pragma unroll 1
                      for (int q4 = 0; q4 < 4; ++q4) { const int rp0 = 32 * part + 8 * q4; float v[8];
#pragma unroll
                          for (int i = 0; i < 8; ++i) { const int p = (rp0 + i) & 63; const float Cr = Cl[c * 64 + p], Ci = Cl[1024 + c * 64 + p], pr = Pr[tl * 64 + p], pi = Pi[tl * 64 + p];
                              v[i] = (rp0 < 64) ? (Cr * pr - Ci * pi) : -(Cr * pi + Ci * pr); }
                          u32x4 o; o.x = cvt_pk_bf16(v[0], v[1]); o.y = cvt_pk_bf16(v[2], v[3]); o.z = cvt_pk_bf16(v[4], v[5]); o.w = cvt_pk_bf16(v[6], v[7]);
                          *(u32x4*)(TS + (size_t)(g * 512 + t * 16 + c) * 640 + 512 + rp0) = o; } }
                    { const int rp = tid >> 2, sq = tid & 3, p = rp & 63;
#pragma unroll 1
                      for (int k = 0; k < 2; ++k) { const int jj = 2 * sq + k, s = 24 - 8 * to + jj, tl = 7 - jj; const float wr_ = Wr[tl * 64 + p], wi_ = Wi[tl * 64 + p]; float v[16];
#pragma unroll
                          for (int i = 0; i < 16; ++i) { const float br = Bl[p * 16 + i], bi = Bl[1024 + p * 16 + i]; v[i] = (rp < 64) ? (wr_ * br - wi_ * bi) : (wr_ * bi + wi_ * br); }
                          u32x4 o0, o1; o0.x = cvt_pk_bf16(v[0], v[1]); o0.y = cvt_pk_bf16(v[2], v[3]); o0.z = cvt_pk_bf16(v[4], v[5]); o0.w = cvt_pk_bf16(v[6], v[7]);
                          o1.x = cvt_pk_bf16(v[8], v[9]); o1.y = cvt_pk_bf16(v[10], v[11]); o1.z = cvt_pk_bf16(v[12], v[13]); o1.w = cvt_pk_bf16(v[14], v[15]);
                          bf16_t* pr_ = PS + (size_t)(g * 256 + rp) * 512 + s * 16; *(u32x4*)pr_ = o0; *(u32x4*)(pr_ + 8) = o1;
                          const u32x4 z4 = (u32x4){0u, 0u, 0u, 0u}; bf16_t* pz = PS + (size_t)(g * 256 + 128 + rp) * 512 + s * 16; *(u32x4*)pz = z4; *(u32x4*)(pz + 8) = z4; } }
                }
            }
            GSYNC();
            STAMP(4);
            for (int rep_ = 0; rep_ < 1 + (int)((REPMASK >> 7) & 1u); ++rep_) { PHASE_IDS
                pg8::Gemm g{(const bf16_t*)(R + R_AG), (const bf16_t*)(R + R_PS), 512, 640, 256};
                pg8::OrderS5E so{G, bid};
                pg8::EpiE E{(float*)(R + R_E)};
                pg8::gemm_phase(lds, g, so, E, wid);
            }
            GSYNC();
            STAMP(5);
            for (int rep_ = 0; rep_ < 1 + (int)((REPMASK >> 8) & 1u); ++rep_) { PHASE_IDS
                bf16_t* AG = (bf16_t*)(R + R_AG); const float* Eb = (const float*)(R + R_E);
                const float* a_re = in_ptr(P, 12) + e * 4096; const float* a_im = in_ptr(P, 13) + e * 4096; const float* ldt = in_ptr(P, 14) + e * 64;
                LAS float* Tr = (LAS float*)lds; LAS float* Ti = Tr + 512;
                for (int it = bid; it < 256; it += G) {
                    const int g = it >> 2, q = it & 3, pl = lane & 15, p = 16 * q + pl, seg = wid * 4 + (lane >> 4);
                    const float dt = expf(ldt[g]), lr = a_re[g * 64 + p], li = a_im[g * 64 + p];
                    float sA, cA; sincosf(32.f * (li * dt), &sA, &cA); const float eA = expf(32.f * (lr * dt)); const float ar = eA * cA, ai = eA * sA;
                    float sB, cB; sincosf(512.f * (li * dt), &sB, &cB); const float eB = expf(512.f * (lr * dt)); const float br = eB * cB, bi = eB * sB;
                    const float* ep = Eb + (size_t)(g * 512 + 16 * seg) * 128 + p;
                    float er[16], ei[16];
#pragma unroll
                    for (int k = 0; k < 16; ++k) { er[k] = ep[(size_t)k * 128]; ei[k] = ep[(size_t)k * 128 + 64]; }
                    float xr = 0.f, xi = 0.f;
#pragma unroll
                    for (int k = 0; k < 16; ++k) { const float nr = ar * xr - ai * xi + er[k], ni = ar * xi + ai * xr + ei[k]; xr = nr; xi = ni; }
                    __syncthreads();
                    Tr[seg * 16 + pl] = xr; Ti[seg * 16 + pl] = xi;
                    __syncthreads();
                    xr = 0.f; xi = 0.f;
                    for (int s2 = 0; s2 < seg; ++s2) { const float nr = br * xr - bi * xi + Tr[s2 * 16 + pl], ni = br * xi + bi * xr + Ti[s2 * 16 + pl]; xr = nr; xi = ni; }
                    bf16_t* sp = AG + (size_t)(g * 512 + 16 * seg) * 640 + 512 + p;
#pragma unroll
                    for (int k = 0; k < 16; ++k) { sp[(size_t)k * 640] = (bf16_t)(cvt_pk_bf16(xr, 0.f) & 0xffffu); sp[(size_t)k * 640 + 64] = (bf16_t)(cvt_pk_bf16(xi, 0.f) & 0xffffu);
                        const float nr = ar * xr - ai * xi + er[k], ni = ar * xi + ai * xr + ei[k]; xr = nr; xi = ni; }
                }
            }
            GSYNC();
            STAMP(5);
            for (int rep_ = 0; rep_ < 1 + (int)((REPMASK >> 9) & 1u); ++rep_) { PHASE_IDS
                pg8::Gemm g{(const bf16_t*)(R + R_AG), (const bf16_t*)(R + R_TS), 640, 640, 256};
                pg8::OrderS5Y so{G, bid};
                pg8::EpiY E{(const bf16_t*)(R + R_AG), in_ptr(P, 19) + e * D, (bf16_t*)(R + R_G)};
                pg8::gemm_phase(lds, g, so, E, wid);
            }
            GSYNC();
            STAMP(5);
            for (int rep_ = 0; rep_ < 1 + (int)((REPMASK >> 10) & 1u); ++rep_) { PHASE_IDS
            { const float* pin = in_ptr(P, 1) + (size_t)L * S * 256; bf16_t* PB = (bf16_t*)(R + R_PB);
              for (int t = gw; t < S; t += NGW) { const f32x4 pv = *((const f32x4*)(pin + (size_t)t * 256) + lane); *((u32x2*)(PB + (size_t)t * 256) + lane) = pack4(pv); } }
                pg8::Gemm g{(const bf16_t*)(R + R_G), (const bf16_t*)(ws + WS_WGLU) + (size_t)e * 2048 * 1024, 1024, 1024, 256};
                pg8::StaticOrder so; so.init(64, 8, G, bid);
                pg8::EpiGlu E{X, HN, (float*)(ws + WS_SS), (LAS float*)(lds + XL_OFF + 8448)};
                pg8::gemm_phase(lds, g, so, E, wid);
            }
            GSYNC();
            STAMP(5);
        }
        for (int rep_ = 0; rep_ < 1 + (int)((REPMASK >> 12) & 1u); ++rep_) { PHASE_IDS
            pg8::Gemm g{HNA, (const bf16_t*)(ws + WS_WUP) + (size_t)L * 5632 * 1024, 1024, 1024, 254};
            pg8::StaticOrder so; so.init(65, 22, G, bid);
            pg8::EpiConv E{(bf16_t*)(R + R_ACT), in_ptr(P, 22) + (size_t)L * 3 * 5632, in_ptr(P, 23) + (size_t)L * 5632, lds + XL_OFF, (const float*)(ws + WS_SS), (L & 1) ? 8 : 4};
            pg8::gemm_phase(lds, g, so, E, wid);
        }
        GSYNC();
        STAMP(6);
        for (int rep_ = 0; rep_ < 1 + (int)((REPMASK >> 13) & 1u); ++rep_) { PHASE_IDS
            pg8::Gemm g{(const bf16_t*)(R + R_ACT), (const bf16_t*)(ws + WS_WDN) + (size_t)L * 1024 * 2816, 2816, 2816, 256};
            pg8::StaticOrder so; so.init(64, 4, G, bid);
            pg8::EpiRes E{X, HN, (float*)(ws + WS_SS) + (size_t)S * 8, (LAS float*)(lds + XL_OFF + 8448)};
            pg8::gemm_phase(lds, g, so, E, wid);
        }
        GSYNC();
        STAMP(7);
        for (int rep_ = 0; rep_ < 1 + (int)((REPMASK >> 15) & 1u); ++rep_) { PHASE_IDS
            pg8::StaticOrder so; so.init(64, 4, G, bid);
            { pg8::Gemm g{(const bf16_t*)(R + R_PB), (const bf16_t*)(ws + WS_WPR) + (size_t)L * 1024 * 256, 256, 256, 256};
              pg8::EpiStore E{(bf16_t*)(R + R_PP), D, 0};
              pg8::gemm_phase(lds, g, so, E, wid); }
            asm volatile("s_waitcnt vmcnt(0)" ::: "memory"); __syncthreads();
            { pg8::Gemm g{HN, (const bf16_t*)(ws + WS_WGT) + (size_t)L * 1024 * 1024, 1024, 1024, 256};
              pg8::EpiGate E{X, (const bf16_t*)(R + R_PP), (const float*)(ws + WS_SS) + (size_t)S * 8};
              pg8::gemm_phase(lds, g, so, E, wid); }
        }
        GSYNC();
        STAMP(8);
        for (int xs = 0; xs < XSYNC; ++xs) GSYNC();
    }
#ifdef PROBE_SEL
    if (bid == 0) { __syncthreads(); float tot = 0.f; for (int i = 0; i < 16; ++i) tot += tacc[i];
        const float f = (PROBE_SEL < 0) ? 1.f : tacc[PROBE_SEL < 0 ? 0 : PROBE_SEL] / tot;
        for (int i = threadIdx.x; i < 524288; i += 512) X[i] += 0.2f * f; }
#endif
}

extern "C" void kernel_launch(void* const* d_in, const int* in_sizes, int n_in, void* d_out, int out_size, void* d_ws, size_t ws_size, hipStream_t stream) {
    static int grid = 0;
    if (grid == 0) {
        if (n_in != 27 || out_size != S * D || ws_size < WS_END) { fprintf(stderr, "kernel_launch: unexpected shapes (n_in %d out %d ws %zu need %zu)\n", n_in, out_size, ws_size, (size_t)WS_END); grid = -1; return; }
        int dev = 0, cus = 0, per_cu = 0;
        hipGetDevice(&dev); hipDeviceGetAttribute(&cus, hipDeviceAttributeMultiprocessorCount, dev);
        hipFuncSetAttribute((const void*)mega, hipFuncAttributeMaxDynamicSharedMemorySize, LDS_BYTES);
        hipOccupancyMaxActiveBlocksPerMultiprocessor(&per_cu, (const void*)mega, 512, LDS_BYTES);
        if (per_cu < 1) per_cu = 1;
        grid = cus * per_cu;
    }
    if (grid < 0) return;
    Params p{};
    for (int i = 0; i < 27; ++i) p.in[i] = (const float*)d_in[i];
    p.out = (float*)d_out; p.ws = (unsigned char*)d_ws;
    hipMemsetAsync((char*)d_ws + WS_BAR, 0, ZERO_BYTES, stream);
    void* args[] = {&p};
    hipError_t err = hipLaunchCooperativeKernel((const void*)mega, dim3(grid), dim3(512), args, LDS_BYTES, stream);
    if (err != hipSuccess) fprintf(stderr, "cooperative launch failed: %s (grid %d)\n", hipGetErrorString(err), grid);
}
```
